# Optimizing an MI355X kernel written in HIP

```python
import jax, jax.numpy as jnp
from jax import lax
import numpy as np

D_MODEL = 1024
BATCH = 8
SEQ = 4096
DEPTH = 2

CHUNK = 64
NORM_EPS = 1e-5

RWKV_HEAD_DIM = 64
RWKV_WIDTH = D_MODEL
RWKV_HEADS = RWKV_WIDTH // RWKV_HEAD_DIM
RWKV_DECAY_RANK = 64
RWKV_ICL_RANK = 64
RWKV_GATE_RANK = 160
RWKV_GN_EPS = 64e-5

HGRN_HEAD_DIM = 128
HGRN_WIDTH = D_MODEL
HGRN_HEADS = HGRN_WIDTH // HGRN_HEAD_DIM

SSM_WIDTH = 2 * D_MODEL
SSM_HEAD_DIM = 64
SSM_HEADS = SSM_WIDTH // SSM_HEAD_DIM
SSM_GROUPS = 4
SSM_HEADS_PER_GROUP = SSM_HEADS // SSM_GROUPS
SSM_STATE = 128
SSM_CONV_WIDTH = 4
SSM_CONV_DIM = SSM_WIDTH + 2 * SSM_GROUPS * SSM_STATE

N_BRANCHES = 3
FFN_HIDDEN = ((8 * D_MODEL + 3 * 256 - 1) // (3 * 256)) * 256

RWKV_COLS = 3 * RWKV_WIDTH + RWKV_DECAY_RANK + RWKV_ICL_RANK + RWKV_GATE_RANK
HGRN_COLS = 4 * HGRN_WIDTH
SSM_COLS = SSM_WIDTH + SSM_CONV_DIM + SSM_HEADS
GATE_COLS = N_BRANCHES * D_MODEL
OFF_HGRN = RWKV_COLS
OFF_SSM = OFF_HGRN + HGRN_COLS
OFF_GATE = OFF_SSM + SSM_COLS
IN_COLS = OFF_GATE + GATE_COLS
BRANCH_ROWS = RWKV_WIDTH + HGRN_WIDTH + SSM_WIDTH

kernel_name = 'hybrid_rwkv7_hgrn2_mamba2_gated_merge'


def rmsnorm(x, gain):
    xf = x.astype(jnp.float32)
    y = xf * lax.rsqrt(jnp.mean(xf * xf, axis=-1, keepdims=True) + NORM_EPS)
    return (y * gain.astype(jnp.float32)).astype(x.dtype)


def to_chunks(t):
    b, s = t.shape[:2]
    return jnp.swapaxes(t.reshape(b, s // CHUNK, CHUNK, *t.shape[2:]), 0, 1)


def from_chunks(t):
    n, b = t.shape[:2]
    return jnp.swapaxes(t, 0, 1).reshape(b, n * CHUNK, *t.shape[3:])


def causal_mask():
    return jnp.tril(jnp.ones((CHUNK, CHUNK), dtype=bool))


def rwkv7_mixer(u, mu, w0, w_up, a0, a_up, g_up, k_k, k_a, r_k, gn_w, gn_b):
    b, s, _ = u.shape
    f32 = jnp.float32
    hd = (RWKV_HEADS, RWKV_HEAD_DIM)
    u_prev = jnp.pad(u, ((0, 0), (1, 0), (0, 0)))[:, :-1]
    u = u + (u_prev - u) * mu
    bounds = np.cumsum([RWKV_WIDTH, RWKV_WIDTH, RWKV_WIDTH, RWKV_DECAY_RANK, RWKV_ICL_RANK]).tolist()
    r, k, v, xw, xa, xg = jnp.split(u, bounds, axis=-1)
    log_w = -jnp.exp(-jax.nn.softplus(-(w0 + jnp.tanh(xw) @ w_up)) - 0.5)
    a = jax.nn.sigmoid(a0 + xa @ a_up)
    g = jax.nn.sigmoid(xg) @ g_up
    heads = lambda t: t.astype(f32).reshape(b, s, *hd)
    r, k, v, a, log_w = heads(r), heads(k), heads(v), heads(a), heads(log_w)
    kk = k * k_k.astype(f32).reshape(hd)
    kk = kk / jnp.maximum(jnp.sqrt(jnp.sum(kk * kk, axis=-1, keepdims=True)), 1e-12)
    k = k * (1.0 + (a - 1.0) * k_a.astype(f32).reshape(hd))

    def step(state, inp):
        r_t, w_t, k_t, v_t, ka_t, kb_t = inp
        sa = jnp.einsum('bhvk,bhk->bhv', state, ka_t)
        state = (state * w_t[:, :, None, :] + sa[..., None] * kb_t[:, :, None, :]
                 + v_t[..., None] * k_t[:, :, None, :])
        return state, jnp.einsum('bhvk,bhk->bhv', state, r_t)

    xs = tuple(jnp.moveaxis(t, 1, 0) for t in (r, jnp.exp(log_w), k, v, -kk, kk * a))
    state0 = jnp.zeros((b, RWKV_HEADS, RWKV_HEAD_DIM, RWKV_HEAD_DIM), f32)
    _, o = lax.scan(step, state0, xs)
    o = jnp.moveaxis(o, 0, 1)
    mean = jnp.mean(o, axis=-1, keepdims=True)
    var = jnp.mean(jnp.square(o - mean), axis=-1, keepdims=True)
    o = (o - mean) * lax.rsqrt(var + RWKV_GN_EPS) * gn_w.astype(f32).reshape(hd) + gn_b.astype(f32).reshape(hd)
    o = o + jnp.sum(r * k * r_k.astype(f32), axis=-1, keepdims=True) * v
    return o.reshape(b, s, RWKV_WIDTH).astype(u.dtype) * g


def hgrn2_mixer(u, lb, gn_w):
    b, s, _ = u.shape
    f32 = jnp.float32
    hd = (HGRN_HEADS, HGRN_HEAD_DIM)
    q, f_pre, i, g = jnp.split(u, 4, axis=-1)
    heads = lambda t: t.astype(f32).reshape(b, s, *hd)
    lb = lb.astype(f32).reshape(hd)
    log_f = jnp.logaddexp(jnp.log(lb), jnp.log1p(-lb) + jax.nn.log_sigmoid(heads(f_pre)))
    k = -jnp.expm1(log_f)
    q = jax.nn.silu(heads(q))
    v = heads(i)
    mask = causal_mask()[None, :, :, None, None]

    def step(state, inp):
        q_c, k_c, v_c, lf_c = inp
        cum = jnp.cumsum(lf_c, axis=1)
        decay = jnp.exp(jnp.where(mask, cum[:, :, None] - cum[:, None, :], -jnp.inf))
        scores = jnp.einsum('bthd,btshd,bshd->bths', q_c, decay, k_c)
        o = (jnp.einsum('bths,bshv->bthv', scores, v_c)
             + jnp.einsum('bthd,bhdv->bthv', q_c * jnp.exp(cum), state))
        last = cum[:, -1]
        state = (jnp.exp(last)[..., None] * state
                 + jnp.einsum('bshd,bshv->bhdv', k_c * jnp.exp(last[:, None] - cum), v_c))
        return state, o

    state0 = jnp.zeros((b, HGRN_HEADS, HGRN_HEAD_DIM, HGRN_HEAD_DIM), f32)
    _, o = lax.scan(step, state0, tuple(to_chunks(t) for t in (q, k, v, log_f)))
    o = from_chunks(o)
    o = o * lax.rsqrt(jnp.mean(o * o, axis=-1, keepdims=True) + NORM_EPS) * gn_w.astype(f32).reshape(hd)
    return o.reshape(b, s, HGRN_WIDTH).astype(u.dtype) * jax.nn.sigmoid(g)


def mamba2_mixer(u, conv_w, conv_b, dt_bias, a_log, d_skip, gn_w):
    b, s, _ = u.shape
    f32 = jnp.float32
    gh = (SSM_GROUPS, SSM_HEADS_PER_GROUP)
    z, xbc, dt = jnp.split(u, [SSM_WIDTH, SSM_WIDTH + SSM_CONV_DIM], axis=-1)
    xpad = jnp.pad(xbc, ((0, 0), (SSM_CONV_WIDTH - 1, 0), (0, 0)))
    conv = conv_b + sum(xpad[:, j:j + s] * conv_w[:, j] for j in range(SSM_CONV_WIDTH))
    xbc = jax.nn.silu(conv)
    x, bm, cm = jnp.split(xbc, [SSM_WIDTH, SSM_WIDTH + SSM_GROUPS * SSM_STATE], axis=-1)
    x = x.astype(f32).reshape(b, s, *gh, SSM_HEAD_DIM)
    bm = bm.astype(f32).reshape(b, s, SSM_GROUPS, SSM_STATE)
    cm = cm.astype(f32).reshape(b, s, SSM_GROUPS, SSM_STATE)
    dt = jax.nn.softplus(dt.astype(f32) + dt_bias.astype(f32)).reshape(b, s, *gh)
    log_a = dt * (-jnp.exp(a_log.astype(f32))).reshape(gh)
    mask = causal_mask()[None, :, :, None, None]

    def step(state, inp):
        x_c, b_c, c_c, dt_c, la_c = inp
        cum = jnp.cumsum(la_c, axis=1)
        decay = jnp.exp(jnp.where(mask, cum[:, :, None] - cum[:, None, :], -jnp.inf))
        cb = jnp.einsum('btgn,bsgn->btsg', c_c, b_c)
        y = jnp.einsum('btsg,btsgh,bsgh,bsghp->btghp', cb, decay, dt_c, x_c)
        y = y + jnp.einsum('btgn,bghpn->btghp', c_c, state) * jnp.exp(cum)[..., None]
        last = cum[:, -1]
        w_s = jnp.exp(last[:, None] - cum) * dt_c
        state = (jnp.exp(last)[..., None, None] * state
                 + jnp.einsum('bsgn,bsgh,bsghp->bghpn', b_c, w_s, x_c))
        return state, y

    state0 = jnp.zeros((b, *gh, SSM_HEAD_DIM, SSM_STATE), f32)
    _, y = lax.scan(step, state0, tuple(to_chunks(t) for t in (x, bm, cm, dt, log_a)))
    y = from_chunks(y) + d_skip.astype(f32).reshape(*gh, 1) * x
    y = y.reshape(b, s, SSM_WIDTH) * jax.nn.silu(z.astype(f32))
    y = y.reshape(b, s, SSM_GROUPS, SSM_WIDTH // SSM_GROUPS)
    y = y * lax.rsqrt(jnp.mean(y * y, axis=-1, keepdims=True) + NORM_EPS)
    return (y.reshape(b, s, SSM_WIDTH) * gn_w.astype(f32)).astype(u.dtype)


def setup_inputs(seed: int = 0) -> dict:
    key = jax.random.key(seed)
    ks = iter(jax.random.split(key, 40))
    L, D = DEPTH, D_MODEL
    nrm = lambda shape, scale: scale * jax.random.normal(next(ks), shape, jnp.float32)
    unif = lambda shape, lo, hi: jax.random.uniform(next(ks), shape, jnp.float32, lo, hi)
    x = nrm((BATCH, SEQ, D), 1.0)
    norm_mix = 1.0 + nrm((L, D), 0.02)
    w_in = nrm((L, D, IN_COLS), D ** -0.5)
    rwkv_mu = unif((L, RWKV_COLS), 0.0, 1.0)
    rwkv_w0 = unif((L, RWKV_WIDTH), -4.0, 0.0)
    rwkv_w_up = nrm((L, RWKV_DECAY_RANK, RWKV_WIDTH), 0.5 * RWKV_DECAY_RANK ** -0.5)
    rwkv_a0 = nrm((L, RWKV_WIDTH), 0.5)
    rwkv_a_up = nrm((L, RWKV_ICL_RANK, RWKV_WIDTH), 0.5 * RWKV_ICL_RANK ** -0.5)
    rwkv_g_up = nrm((L, RWKV_GATE_RANK, RWKV_WIDTH), RWKV_GATE_RANK ** -0.5)
    rwkv_k_k = 0.85 + nrm((L, RWKV_WIDTH), 0.02)
    rwkv_k_a = 1.0 + nrm((L, RWKV_WIDTH), 0.02)
    rwkv_r_k = nrm((L, RWKV_HEADS, RWKV_HEAD_DIM), 0.1)
    rwkv_gn_w = 1.0 + nrm((L, RWKV_WIDTH), 0.02)
    rwkv_gn_b = nrm((L, RWKV_WIDTH), 0.02)
    hgrn_lb_logits = nrm((L, HGRN_WIDTH), 0.5)
    hgrn_gn_w = 1.0 + nrm((L, HGRN_WIDTH), 0.02)
    ssm_conv_w = nrm((L, SSM_CONV_DIM, SSM_CONV_WIDTH), SSM_CONV_WIDTH ** -0.5)
    ssm_conv_b = nrm((L, SSM_CONV_DIM), 0.02)
    dt0 = jnp.exp(unif((L, SSM_HEADS), float(np.log(1e-3)), float(np.log(1e-1))))
    ssm_dt_bias = dt0 + jnp.log(-jnp.expm1(-dt0))
    ssm_a_log = jnp.log(unif((L, SSM_HEADS), 1.0, 16.0))
    ssm_d = 1.0 + nrm((L, SSM_HEADS), 0.1)
    ssm_gn_w = 1.0 + nrm((L, SSM_WIDTH), 0.02)
    w_branch = jnp.concatenate([nrm((L, RWKV_WIDTH, D), RWKV_WIDTH ** -0.5),
                                nrm((L, HGRN_WIDTH, D), HGRN_WIDTH ** -0.5),
                                nrm((L, SSM_WIDTH, D), SSM_WIDTH ** -0.5)], axis=1)
    w_out = nrm((L, D, D), D ** -0.5)
    norm_ffn = 1.0 + nrm((L, D), 0.02)
    w_ffn_in = nrm((L, D, 2 * FFN_HIDDEN), D ** -0.5)
    w_ffn_out = nrm((L, FFN_HIDDEN, D), FFN_HIDDEN ** -0.5)
    norm_final = 1.0 + nrm((D,), 0.02)
    return {'x': x, 'norm_mix': norm_mix, 'w_in': w_in,
            'rwkv_mu': rwkv_mu, 'rwkv_w0': rwkv_w0, 'rwkv_w_up': rwkv_w_up, 'rwkv_a0': rwkv_a0,
            'rwkv_a_up': rwkv_a_up, 'rwkv_g_up': rwkv_g_up, 'rwkv_k_k': rwkv_k_k, 'rwkv_k_a': rwkv_k_a,
            'rwkv_r_k': rwkv_r_k, 'rwkv_gn_w': rwkv_gn_w, 'rwkv_gn_b': rwkv_gn_b,
            'hgrn_lb_logits': hgrn_lb_logits, 'hgrn_gn_w': hgrn_gn_w,
            'ssm_conv_w': ssm_conv_w, 'ssm_conv_b': ssm_conv_b, 'ssm_dt_bias': ssm_dt_bias,
            'ssm_a_log': ssm_a_log, 'ssm_d': ssm_d, 'ssm_gn_w': ssm_gn_w,
            'w_branch': w_branch, 'w_out': w_out, 'norm_ffn': norm_ffn,
            'w_ffn_in': w_ffn_in, 'w_ffn_out': w_ffn_out, 'norm_final': norm_final}


def reference(x, norm_mix, w_in, rwkv_mu, rwkv_w0, rwkv_w_up, rwkv_a0, rwkv_a_up, rwkv_g_up,
              rwkv_k_k, rwkv_k_a, rwkv_r_k, rwkv_gn_w, rwkv_gn_b, hgrn_lb_logits, hgrn_gn_w,
              ssm_conv_w, ssm_conv_b, ssm_dt_bias, ssm_a_log, ssm_d, ssm_gn_w,
              w_branch, w_out, norm_ffn, w_ffn_in, w_ffn_out, norm_final):
    b, s, _ = x.shape
    cs = jnp.cumsum(jax.nn.softmax(hgrn_lb_logits.astype(jnp.float32), axis=0), axis=0)
    lbs = cs - cs[:1]
    for l in range(DEPTH):
        h = rmsnorm(x, norm_mix[l])
        wi = w_in[l]
        y_a = rwkv7_mixer(h @ wi[:, :OFF_HGRN], rwkv_mu[l], rwkv_w0[l], rwkv_w_up[l], rwkv_a0[l],
                          rwkv_a_up[l], rwkv_g_up[l], rwkv_k_k[l], rwkv_k_a[l], rwkv_r_k[l],
                          rwkv_gn_w[l], rwkv_gn_b[l])
        y_b = hgrn2_mixer(h @ wi[:, OFF_HGRN:OFF_SSM], lbs[l], hgrn_gn_w[l])
        y_c = mamba2_mixer(h @ wi[:, OFF_SSM:OFF_GATE], ssm_conv_w[l], ssm_conv_b[l], ssm_dt_bias[l],
                           ssm_a_log[l], ssm_d[l], ssm_gn_w[l])
        gates = jax.nn.sigmoid(h @ wi[:, OFF_GATE:]).reshape(b, s, N_BRANCHES, D_MODEL)
        wb = w_branch[l]
        merged = (gates[:, :, 0] * (y_a @ wb[:RWKV_WIDTH])
                  + gates[:, :, 1] * (y_b @ wb[RWKV_WIDTH:RWKV_WIDTH + HGRN_WIDTH])
                  + gates[:, :, 2] * (y_c @ wb[RWKV_WIDTH + HGRN_WIDTH:]))
        x = x + merged @ w_out[l]
        h = rmsnorm(x, norm_ffn[l])
        gate, up = jnp.split(h @ w_ffn_in[l], 2, axis=-1)
        x = x + (jax.nn.silu(gate) * up) @ w_ffn_out[l]
    return rmsnorm(x, norm_final)
```

```cpp
#include <hip/hip_runtime.h>
#include <hip/hip_cooperative_groups.h>
#include <stdint.h>
#include <stdio.h>
namespace cg = cooperative_groups;

typedef unsigned short u16;
using bf16x8 = __attribute__((ext_vector_type(8))) short;
using f32x4  = __attribute__((ext_vector_type(4))) float;
using u32x4 = __attribute__((ext_vector_type(4))) unsigned int;
using u32x2 = __attribute__((ext_vector_type(2))) unsigned int;

#define DM 1024
#define SEQ 4096
#define TTOK 32768
#define SL 512
#define NSEG 8
#define RS 4096
#define NTHR 256

constexpr size_t al(size_t x) { return (x + 255) & ~(size_t)255; }
constexpr size_t WIN = 0;
constexpr size_t WWUP = WIN + (size_t)15872 * 1024;
constexpr size_t WAUP = WWUP + 65536;
constexpr size_t WGUP = WAUP + 65536;
constexpr size_t WBR = WGUP + 196608;
constexpr size_t WOUT = WBR + 4194304;
constexpr size_t WFFI = WOUT + 1048576;
constexpr size_t WFFO = WFFI + 5767168;
constexpr size_t W_LAYER = WFFO + 2883584;
constexpr size_t O_W = 0;
constexpr size_t O_H = al(O_W + 2 * W_LAYER * 2);
constexpr size_t O_URW = al(O_H + (size_t)RS * 1024 * 2);
constexpr size_t O_HQ = al(O_URW + (size_t)8 * 513 * 3456 * 2);
constexpr size_t O_HV = al(O_HQ + (size_t)RS * 1024 * 2);
constexpr size_t O_HG = al(O_HV + (size_t)RS * 1024 * 2);
constexpr size_t O_HW = al(O_HG + (size_t)RS * 1024 * 2);
constexpr size_t O_SZ = al(O_HW + (size_t)RS * 1024 * 4);
constexpr size_t O_SXBC = al(O_SZ + (size_t)RS * 2048 * 2);
constexpr size_t O_SDT = al(O_SXBC + (size_t)8 * 515 * 3072 * 2);
constexpr size_t O_SWD = al(O_SDT + (size_t)RS * 32 * 4);
constexpr size_t O_GATES = al(O_SWD + (size_t)RS * 32 * 4);
constexpr size_t O_LAW = al(O_GATES + (size_t)RS * 3072 * 2);
constexpr size_t O_LAA = al(O_LAW + (size_t)RS * 64 * 2);
constexpr size_t O_LAG = al(O_LAA + (size_t)RS * 64 * 2);
constexpr size_t O_SX2 = al(O_LAG + (size_t)RS * 192 * 2);
constexpr size_t O_RWW = al(O_SX2 + (size_t)RS * 3072 * 2);
constexpr size_t O_RWA = al(O_RWW + (size_t)RS * 1024 * 4);
constexpr size_t O_RWG = al(O_RWA + (size_t)RS * 1024 * 2);
constexpr size_t O_PR = al(O_RWG + (size_t)RS * 1024 * 2);
constexpr size_t O_PK = al(O_PR + (size_t)RS * 1024 * 2);
constexpr size_t O_PV = al(O_PK + (size_t)RS * 1024 * 2);
constexpr size_t O_PKA = al(O_PV + (size_t)RS * 1024 * 2);
constexpr size_t O_PKB = al(O_PKA + (size_t)RS * 1024 * 2);
constexpr size_t O_BONUS = al(O_PKB + (size_t)RS * 1024 * 2);
constexpr size_t O_SO = al(O_BONUS + (size_t)RS * 16 * 4);
constexpr size_t O_Y = al(O_SO + (size_t)RS * 4096 * 4);
constexpr size_t O_MERGED = al(O_Y + (size_t)RS * 4096 * 2);
constexpr size_t O_STRW = al(O_MERGED + (size_t)RS * 1024 * 2);
constexpr size_t O_STHG = al(O_STRW + (size_t)128 * 64 * 64 * 4);
constexpr size_t O_STSS = al(O_STHG + (size_t)64 * 128 * 128 * 4);
constexpr size_t O_END = al(O_STSS + (size_t)256 * 64 * 128 * 4);
constexpr size_t O_H2 = O_H;
constexpr size_t O_HID = al(O_H2 + (size_t)TTOK * 1024 * 2);
constexpr size_t O_END2 = al(O_HID + (size_t)TTOK * 2816 * 2);
static_assert(O_END <= (size_t)536870912, "ws overflow");
static_assert(O_END2 <= (size_t)536870912, "ws overflow2");

struct Params { const float* in[28]; float* out; char* ws; };

enum { PH_WCONV = 0, PH_NORM1, PH_INPROJ, PH_ELEM, PH_LORA, PH_RPREP, PH_SCAN, PH_POST, PH_MERGE, PH_OUT,
       PH_NORM2, PH_FFI, PH_FFO, PH_FINAL };

__device__ __forceinline__ float bf2f(u16 u) { return __uint_as_float(((unsigned)u) << 16); }
__device__ __forceinline__ u16 f2bf(float f) { unsigned u = __float_as_uint(f); u += 0x7fffu + ((u >> 16) & 1u); return (u16)(u >> 16); }
__device__ __forceinline__ float sigm(float x) { return 1.f / (1.f + __expf(-x)); }
__device__ __forceinline__ float wave_sum(float x) {
#pragma unroll
  for (int o = 32; o; o >>= 1) x += __shfl_xor(x, o);
  return x;
}
__device__ __forceinline__ f32x4 cvt4(u32x2 v) {
  f32x4 r; r.x = __uint_as_float(v.x << 16); r.y = __uint_as_float(v.x & 0xffff0000u);
  r.z = __uint_as_float(v.y << 16); r.w = __uint_as_float(v.y & 0xffff0000u); return r;
}
template <int CTRL> __device__ __forceinline__ float dppf(float x) {
  return __int_as_float(__builtin_amdgcn_update_dpp(0, __float_as_int(x), CTRL, 0xF, 0xF, true));
}
__device__ __forceinline__ float red8(float x) {
  x += dppf<0xB1>(x); x += dppf<0x4E>(x); x += dppf<0x141>(x); return x;
}

__device__ __forceinline__ int remap_col(int kind, int n, int nsrc) {
  if (kind == 0) return n < nsrc ? n : -1;
  if (kind == 1) {
    if (n < 3456) return n < 3360 ? n : -1;
    if (n < 7552) return 3360 + (n - 3456);
    if (n < 12800) { int c = n - 7552; return c < 5152 ? 7456 + c : -1; }
    return 12608 + (n - 12800);
  }
  int blk = n >> 5, w = n & 31;
  return w < 16 ? blk * 16 + w : 2816 + blk * 16 + (w - 16);
}
__device__ void tconv(const float* __restrict__ src, int K, int Nsrc, u16* __restrict__ dst, int Kpad, int Npad,
                      int kind, int bid, int nb, char* smem) {
  float(*tile)[65] = (float(*)[65])smem;
  const int tn = Npad >> 6, tk = Kpad >> 6, tid = threadIdx.x;
  for (int t = bid; t < tn * tk; t += nb) {
    const int n0 = (t % tn) << 6, k0 = (t / tn) << 6;
    const int nn = tid & 63, c = remap_col(kind, n0 + nn, Nsrc);
#pragma unroll
    for (int i = 0; i < 16; i++) {
      int kk = (tid >> 6) + 4 * i, k = k0 + kk;
      tile[kk][nn] = (k < K && c >= 0) ? src[(size_t)k * Nsrc + c] : 0.f;
    }
    __syncthreads();
#pragma unroll
    for (int i = 0; i < 16; i++) {
      int n2 = (tid >> 6) + 4 * i, kk = tid & 63;
      dst[(size_t)(n0 + n2) * Kpad + k0 + kk] = f2bf(tile[kk][n2]);
    }
    __syncthreads();
  }
}
__device__ void ph_wconv(const Params& p, int bid, int nb, char* smem) {
  for (int l = 0; l < 2; l++) {
    u16* W = (u16*)(p.ws + O_W) + (size_t)l * W_LAYER;
    tconv(p.in[2] + (size_t)l * 1024 * 15680, 1024, 15680, W + WIN, 1024, 15872, 1, bid, nb, smem);
    tconv(p.in[5] + (size_t)l * 64 * 1024, 64, 1024, W + WWUP, 64, 1024, 0, bid, nb, smem);
    tconv(p.in[7] + (size_t)l * 64 * 1024, 64, 1024, W + WAUP, 64, 1024, 0, bid, nb, smem);
    tconv(p.in[8] + (size_t)l * 160 * 1024, 160, 1024, W + WGUP, 192, 1024, 0, bid, nb, smem);
    tconv(p.in[22] + (size_t)l * 4096 * 1024, 4096, 1024, W + WBR, 4096, 1024, 0, bid, nb, smem);
    tconv(p.in[23] + (size_t)l * 1024 * 1024, 1024, 1024, W + WOUT, 1024, 1024, 0, bid, nb, smem);
    tconv(p.in[25] + (size_t)l * 1024 * 5632, 1024, 5632, W + WFFI, 1024, 5632, 2, bid, nb, smem);
    tconv(p.in[26] + (size_t)l * 2816 * 1024, 2816, 1024, W + WFFO, 2816, 1024, 0, bid, nb, smem);
  }
}

__device__ void rmsnorm_rows(const float* __restrict__ xs, const float* __restrict__ gain, u16* dst, float* dstf,
                             int nrows, int mode, int seg, int bid, int nb) {
  const int lane = threadIdx.x & 63, wv = threadIdx.x >> 6;
  for (int r = bid * 4 + wv; r < nrows; r += nb * 4) {
    size_t srow = (mode == 0) ? ((size_t)(r >> 9) * SEQ + seg * SL + (r & 511)) : (size_t)r;
    const float4* xp = (const float4*)(xs + srow * DM);
    float4 v[4]; float ss = 0.f;
#pragma unroll
    for (int i = 0; i < 4; i++) { v[i] = xp[lane + 64 * i]; ss += v[i].x * v[i].x + v[i].y * v[i].y + v[i].z * v[i].z + v[i].w * v[i].w; }
    ss = wave_sum(ss);
    float rstd = rsqrtf(ss * (1.f / DM) + 1e-5f);
#pragma unroll
    for (int i = 0; i < 4; i++) {
      float4 g = ((const float4*)gain)[lane + 64 * i];
      float a = v[i].x * rstd * g.x, b = v[i].y * rstd * g.y, c = v[i].z * rstd * g.z, d = v[i].w * rstd * g.w;
      if (mode == 2) { float4 o; o.x = a; o.y = b; o.z = c; o.w = d; ((float4*)(dstf + (size_t)r * DM))[lane + 64 * i] = o; }
      else { uint2 o; o.x = (unsigned)f2bf(a) | ((unsigned)f2bf(b) << 16); o.y = (unsigned)f2bf(c) | ((unsigned)f2bf(d) << 16);
             ((uint2*)(dst + (size_t)r * DM))[lane + 64 * i] = o; }
    }
  }
}

#define LDT 72
__device__ __forceinline__ void gemm_kloop(const u16* __restrict__ A, int lda, const u16* __restrict__ B, int ldb, int nkt,
                                           f32x4 (&acc)[4][4], char* smem) {
  u16* sa = (u16*)smem; u16* sb = sa + 2 * 128 * LDT;
  const int tid = threadIdx.x, lane = tid & 63, wave = tid >> 6, wm = wave >> 1, wn = wave & 1;
  const int lrow = tid >> 3, lkc = tid & 7;
  const u16* ag = A + (size_t)lrow * lda + lkc * 8;
  const u16* bg = B + (size_t)lrow * ldb + lkc * 8;
  u32x4 ra[4], rb[4];
#pragma unroll
  for (int i = 0; i < 4; i++) { ra[i] = *(const u32x4*)(ag + (size_t)i * 32 * lda); rb[i] = *(const u32x4*)(bg + (size_t)i * 32 * ldb); }
  __syncthreads();
#pragma unroll
  for (int i = 0; i < 4; i++) { *(u32x4*)(sa + (lrow + 32 * i) * LDT + lkc * 8) = ra[i]; *(u32x4*)(sb + (lrow + 32 * i) * LDT + lkc * 8) = rb[i]; }
  __syncthreads();
  const int frow = lane & 15, fk = (lane >> 4) * 8;
  for (int kt = 0; kt < nkt; kt++) {
    const int cur = kt & 1;
    if (kt + 1 < nkt) {
#pragma unroll
      for (int i = 0; i < 4; i++) { ra[i] = *(const u32x4*)(ag + (size_t)i * 32 * lda + (kt + 1) * 64); rb[i] = *(const u32x4*)(bg + (size_t)i * 32 * ldb + (kt + 1) * 64); }
    }
    const u16* ca = sa + cur * 128 * LDT + (wm * 64 + frow) * LDT + fk;
    const u16* cb = sb + cur * 128 * LDT + (wn * 64 + frow) * LDT + fk;
#pragma unroll
    for (int ks = 0; ks < 2; ks++) {
      bf16x8 af[4], bfr[4];
#pragma unroll
      for (int i = 0; i < 4; i++) { af[i] = *(const bf16x8*)(ca + i * 16 * LDT + ks * 32); bfr[i] = *(const bf16x8*)(cb + i * 16 * LDT + ks * 32); }
#pragma unroll
      for (int i = 0; i < 4; i++)
#pragma unroll
        for (int j = 0; j < 4; j++) acc[i][j] = __builtin_amdgcn_mfma_f32_16x16x32_bf16(af[i], bfr[j], acc[i][j], 0, 0, 0);
    }
    if (kt + 1 < nkt) {
      const int nx = cur ^ 1;
#pragma unroll
      for (int i = 0; i < 4; i++) { *(u32x4*)(sa + nx * 128 * LDT + (lrow + 32 * i) * LDT + lkc * 8) = ra[i]; *(u32x4*)(sb + nx * 128 * LDT + (lrow + 32 * i) * LDT + lkc * 8) = rb[i]; }
    }
    __syncthreads();
  }
}
#define ACC_ZERO(acc) { _Pragma("unroll") for (int i = 0; i < 4; i++) _Pragma("unroll") for (int j = 0; j < 4; j++) acc[i][j] = (f32x4){0.f, 0.f, 0.f, 0.f}; }
#define EPI_LOOP(BODY) { const int lane_ = threadIdx.x & 63, wave_ = threadIdx.x >> 6, wm_ = wave_ >> 1, wn_ = wave_ & 1; \
  _Pragma("unroll") for (int i = 0; i < 4; i++) _Pragma("unroll") for (int j = 0; j < 4; j++) _Pragma("unroll") for (int r = 0; r < 4; r++) { \
    const int row = m0 + wm_ * 64 + i * 16 + (lane_ >> 4) * 4 + r; const int col = n0 + wn_ * 64 + j * 16 + (lane_ & 15); const float v = acc[i][j][r]; BODY } }

__device__ void ph_inproj(const Params& p, int layer, int seg, int bid, int nb, char* smem) {
  const u16* W = (const u16*)(p.ws + O_W) + (size_t)layer * W_LAYER + WIN;
  const u16* H = (const u16*)(p.ws + O_H);
  u16* urw = (u16*)(p.ws + O_URW); u16* hq = (u16*)(p.ws + O_HQ); u16* hv = (u16*)(p.ws + O_HV); u16* hg = (u16*)(p.ws + O_HG);
  float* hw = (float*)(p.ws + O_HW); u16* sz = (u16*)(p.ws + O_SZ); u16* sxbc = (u16*)(p.ws + O_SXBC);
  float* sdt = (float*)(p.ws + O_SDT); u16* gates = (u16*)(p.ws + O_GATES);
  const float* lbl = p.in[14];
  const float* dtb = p.in[18] + layer * 32;
  for (int t = bid; t < 32 * 124; t += nb) {
    const int m0 = (t & 31) * 128, n0 = (t >> 5) * 128;
    f32x4 acc[4][4]; ACC_ZERO(acc);
    gemm_kloop(H + (size_t)m0 * 1024, 1024, W + (size_t)n0 * 1024, 1024, 16, acc, smem);
    if (n0 < 3456) {
      EPI_LOOP({ if (col < 3360) urw[((size_t)((row >> 9) * 513 + 1 + (row & 511))) * 3456 + col] = f2bf(v); })
    } else if (n0 < 7552) {
      const int which = (n0 - 3456) >> 10;
      if (which == 0) { EPI_LOOP({ int cc = (col - 3456) & 1023; hq[(size_t)row * 1024 + cc] = f2bf(v * sigm(v)); }) }
      else if (which == 1) {
        EPI_LOOP({ int cc = (col - 3456) & 1023; float lb = layer == 0 ? 0.f : 1.f / (1.f + __expf(lbl[cc] - lbl[1024 + cc]));
                   hw[(size_t)row * 1024 + cc] = lb + (1.f - lb) * sigm(v); })
      } else if (which == 2) { EPI_LOOP({ int cc = (col - 3456) & 1023; hv[(size_t)row * 1024 + cc] = f2bf(v); }) }
      else { EPI_LOOP({ int cc = (col - 3456) & 1023; hg[(size_t)row * 1024 + cc] = f2bf(sigm(v)); }) }
    } else if (n0 < 12800) {
      const int c0 = n0 - 7552;
      if (c0 < 2048) { EPI_LOOP({ int c = col - 7552; sz[(size_t)row * 2048 + c] = f2bf(v * sigm(v)); }) }
      else if (c0 < 5120) { EPI_LOOP({ int c = col - 7552 - 2048; sxbc[((size_t)((row >> 9) * 515 + 3 + (row & 511))) * 3072 + c] = f2bf(v); }) }
      else { EPI_LOOP({ int c = col - 7552 - 5120; if (c < 32) { float xx = v + dtb[c]; sdt[(size_t)row * 32 + c] = xx > 20.f ? xx : log1pf(__expf(xx)); } }) }
    } else {
      EPI_LOOP({ int c = col - 12800; gates[(size_t)row * 3072 + c] = f2bf(sigm(v)); })
    }
  }
}

__device__ void ph_elem(const Params& p, int layer, int seg, int bid, int nb) {
  const u16* urw = (const u16*)(p.ws + O_URW);
  const float* mu = p.in[3] + layer * 3360;
  u16* law = (u16*)(p.ws + O_LAW); u16* laa = (u16*)(p.ws + O_LAA); u16* lag = (u16*)(p.ws + O_LAG);
  const int gt = bid * NTHR + threadIdx.x, gs = nb * NTHR;
  for (int idx = gt; idx < RS * 320; idx += gs) {
    int r = idx / 320, c = idx - r * 320;
    int col = c < 128 ? 3072 + c : 3200 + (c - 128);
    float val = 0.f;
    if (c < 288) {
      size_t ro = (size_t)((r >> 9) * 513 + 1 + (r & 511)) * 3456;
      float cur = bf2f(urw[ro + col]), prev = bf2f(urw[ro - 3456 + col]);
      val = cur + (prev - cur) * mu[col];
    }
    if (c < 64) law[(size_t)r * 64 + c] = f2bf(tanhf(val));
    else if (c < 128) laa[(size_t)r * 64 + c - 64] = f2bf(val);
    else lag[(size_t)r * 192 + c - 128] = (c < 288) ? f2bf(sigm(val)) : (u16)0;
  }
  const u16* sxbc = (const u16*)(p.ws + O_SXBC); u16* sx2 = (u16*)(p.ws + O_SX2);
  const float* cw = p.in[16] + (size_t)layer * 3072 * 4; const float* cb = p.in[17] + layer * 3072;
  for (int idx = gt; idx < RS * 3072; idx += gs) {
    int r = idx / 3072, ch = idx - r * 3072;
    size_t ro = (size_t)((r >> 9) * 515 + (r & 511)) * 3072 + ch;
    float4 w4 = *(const float4*)(cw + ch * 4);
    float cv = cb[ch] + bf2f(sxbc[ro]) * w4.x + bf2f(sxbc[ro + 3072]) * w4.y + bf2f(sxbc[ro + 2 * 3072]) * w4.z + bf2f(sxbc[ro + 3 * 3072]) * w4.w;
    sx2[idx] = f2bf(cv * sigm(cv));
  }
  const float* sdt = (const float*)(p.ws + O_SDT); float* swd = (float*)(p.ws + O_SWD);
  const float* alog = p.in[19] + layer * 32;
  for (int idx = gt; idx < RS * 32; idx += gs) swd[idx] = __expf(-sdt[idx] * __expf(alog[idx & 31]));
}

__device__ void ph_lora(const Params& p, int layer, int bid, int nb, char* smem) {
  const u16* W = (const u16*)(p.ws + O_W) + (size_t)layer * W_LAYER;
  float* rww = (float*)(p.ws + O_RWW); u16* rwa = (u16*)(p.ws + O_RWA); u16* rwg = (u16*)(p.ws + O_RWG);
  const float* w0 = p.in[4] + layer * 1024; const float* a0 = p.in[6] + layer * 1024;
  for (int t = bid; t < 3 * 256; t += nb) {
    const int job = t >> 8, tt = t & 255, m0 = (tt & 31) * 128, n0 = (tt >> 5) * 128;
    f32x4 acc[4][4]; ACC_ZERO(acc);
    if (job == 0) {
      gemm_kloop((const u16*)(p.ws + O_LAW) + (size_t)m0 * 64, 64, W + WWUP + (size_t)n0 * 64, 64, 1, acc, smem);
      EPI_LOOP({ rww[(size_t)row * 1024 + col] = __expf(-0.60653066f * sigm(w0[col] + v)); })
    } else if (job == 1) {
      gemm_kloop((const u16*)(p.ws + O_LAA) + (size_t)m0 * 64, 64, W + WAUP + (size_t)n0 * 64, 64, 1, acc, smem);
      EPI_LOOP({ rwa[(size_t)row * 1024 + col] = f2bf(sigm(a0[col] + v)); })
    } else {
      gemm_kloop((const u16*)(p.ws + O_LAG) + (size_t)m0 * 192, 192, W + WGUP + (size_t)n0 * 192, 192, 3, acc, smem);
      EPI_LOOP({ rwg[(size_t)row * 1024 + col] = f2bf(v); })
    }
  }
}

__device__ void ph_rprep(const Params& p, int layer, int bid, int nb) {
  const u16* urw = (const u16*)(p.ws + O_URW); const u16* rwa = (const u16*)(p.ws + O_RWA);
  u16* pr = (u16*)(p.ws + O_PR); u16* pk = (u16*)(p.ws + O_PK); u16* pv = (u16*)(p.ws + O_PV);
  u16* pka = (u16*)(p.ws + O_PKA); u16* pkb = (u16*)(p.ws + O_PKB); float* bonus = (float*)(p.ws + O_BONUS);
  const float* mu = p.in[3] + layer * 3360; const float* kk_ = p.in[9] + layer * 1024; const float* ka_ = p.in[10] + layer * 1024;
  const float* rk_ = p.in[11] + layer * 1024;
  const int lane = threadIdx.x & 63, wv = threadIdx.x >> 6;
  for (int task = bid * 4 + wv; task < RS * 16; task += nb * 4) {
    const int r = task >> 4, h = task & 15, col = h * 64 + lane;
    size_t ro = (size_t)((r >> 9) * 513 + 1 + (r & 511)) * 3456;
    float rc = bf2f(urw[ro + col]), rp = bf2f(urw[ro - 3456 + col]);
    float kc = bf2f(urw[ro + 1024 + col]), kp = bf2f(urw[ro - 3456 + 1024 + col]);
    float vc = bf2f(urw[ro + 2048 + col]), vp = bf2f(urw[ro - 3456 + 2048 + col]);
    float rr = rc + (rp - rc) * mu[col], k = kc + (kp - kc) * mu[1024 + col], vv = vc + (vp - vc) * mu[2048 + col];
    float a = bf2f(rwa[(size_t)r * 1024 + col]);
    float kkv = k * kk_[col];
    float n2 = wave_sum(kkv * kkv);
    float kkn = kkv / fmaxf(sqrtf(n2), 1e-12f);
    float kmod = k * (1.f + (a - 1.f) * ka_[col]);
    float bn = wave_sum(rr * kmod * rk_[col]);
    size_t o = (size_t)r * 1024 + col;
    pr[o] = f2bf(rr); pk[o] = f2bf(kmod); pv[o] = f2bf(vv); pka[o] = f2bf(-kkn); pkb[o] = f2bf(kkn * a);
    if (lane == 0) bonus[r * 16 + h] = bn;
  }
}

struct ScanArgs {
  const u16 *pr, *pk, *pka, *pkb, *pv;
  const float *pw, *pvs;
  float *po, *state;
  int sr, sk, sab, sv, sw, svs, so;
};
#define TB 16
template <int KD, bool DELTA, bool WSCALAR, bool KFROMW>
__device__ void scan_task(const ScanArgs& a, bool first, char* smem) {
  constexpr int KE = KD / 8, NQ = KE / 4, NG = KD / 64, G4 = KD / 4;
  constexpr int OFF_R = 0, OFF_K = KD;
  constexpr int OFF_W = KFROMW ? KD : 2 * KD;
  constexpr int OFF_KA = OFF_W + (WSCALAR ? 0 : KD);
  constexpr int OFF_KB = OFF_KA + (DELTA ? KD : 0);
  constexpr int OFF_V = OFF_KB + (DELTA ? KD : 0);
  constexpr int OFF_S = OFF_V + 32;
  constexpr int STR = OFF_S + 4;
  float* buf0 = (float*)smem; float* buf1 = buf0 + TB * STR; float* obuf = buf1 + TB * STR;
  const int tid = threadIdx.x, ks = tid & 7, vr = tid >> 3;
  u32x2 gr[NG], gk[NG], gka[NG], gkb[NG], gv; f32x4 gw[NG]; float gsw = 0.f, gsv = 0.f;
  gv.x = gv.y = 0;
  auto load_blk = [&](int blk) {
    const int row = blk * TB;
#pragma unroll
    for (int i = 0; i < NG; i++) {
      const int g = tid + 256 * i, step = g / G4, e4 = g % G4;
      gr[i] = *(const u32x2*)(a.pr + (size_t)(row + step) * a.sr + e4 * 4);
      if (!KFROMW) gk[i] = *(const u32x2*)(a.pk + (size_t)(row + step) * a.sk + e4 * 4);
      if (!WSCALAR) gw[i] = *(const f32x4*)(a.pw + (size_t)(row + step) * a.sw + e4 * 4);
      if (DELTA) { gka[i] = *(const u32x2*)(a.pka + (size_t)(row + step) * a.sab + e4 * 4); gkb[i] = *(const u32x2*)(a.pkb + (size_t)(row + step) * a.sab + e4 * 4); }
    }
    if (tid < 128) { const int step = tid >> 3, e4 = tid & 7; gv = *(const u32x2*)(a.pv + (size_t)(row + step) * a.sv + e4 * 4); }
    if (WSCALAR && tid < TB) { gsw = a.pw[(size_t)(row + tid) * a.sw]; gsv = a.pvs[(size_t)(row + tid) * a.svs]; }
  };
  auto store_blk = [&](float* buf) {
#pragma unroll
    for (int i = 0; i < NG; i++) {
      const int g = tid + 256 * i, step = g / G4, e4 = g % G4;
      float* d = buf + step * STR + e4 * 4;
      *(f32x4*)(d + OFF_R) = cvt4(gr[i]);
      if (!KFROMW) *(f32x4*)(d + OFF_K) = cvt4(gk[i]);
      if (!WSCALAR) *(f32x4*)(d + OFF_W) = gw[i];
      if (DELTA) { *(f32x4*)(d + OFF_KA) = cvt4(gka[i]); *(f32x4*)(d + OFF_KB) = cvt4(gkb[i]); }
    }
    if (tid < 128) { const int step = tid >> 3, e4 = tid & 7; *(f32x4*)(buf + step * STR + OFF_V + e4 * 4) = cvt4(gv); }
    if (WSCALAR && tid < TB) { buf[tid * STR + OFF_S] = gsw; buf[tid * STR + OFF_S + 1] = gsv; }
  };
  float S[KE];
  if (first) {
#pragma unroll
    for (int e = 0; e < KE; e++) S[e] = 0.f;
  } else {
#pragma unroll
    for (int q = 0; q < NQ; q++) { float4 t = *(const float4*)(a.state + (size_t)vr * KD + q * 32 + ks * 4); S[q * 4] = t.x; S[q * 4 + 1] = t.y; S[q * 4 + 2] = t.z; S[q * 4 + 3] = t.w; }
  }
  load_blk(0);
  __syncthreads();
  store_blk(buf0);
  __syncthreads();
  constexpr int NBLK = SL / TB;
  for (int blk = 0; blk < NBLK; blk++) {
    float* buf = (blk & 1) ? buf1 : buf0;
    if (blk + 1 < NBLK) load_blk(blk + 1);
#pragma unroll 2
    for (int step = 0; step < TB; step++) {
      const float* sp = buf + step * STR;
      float rv[KE], kv[KE], wv[KE];
#pragma unroll
      for (int q = 0; q < NQ; q++) {
        float4 t = *(const float4*)(sp + OFF_R + q * 32 + ks * 4); rv[q * 4] = t.x; rv[q * 4 + 1] = t.y; rv[q * 4 + 2] = t.z; rv[q * 4 + 3] = t.w;
        if (!WSCALAR) { float4 u = *(const float4*)(sp + OFF_W + q * 32 + ks * 4); wv[q * 4] = u.x; wv[q * 4 + 1] = u.y; wv[q * 4 + 2] = u.z; wv[q * 4 + 3] = u.w; }
        if (!KFROMW) { float4 u = *(const float4*)(sp + OFF_K + q * 32 + ks * 4); kv[q * 4] = u.x; kv[q * 4 + 1] = u.y; kv[q * 4 + 2] = u.z; kv[q * 4 + 3] = u.w; }
      }
      float vt = sp[OFF_V + vr];
      float wsc = 1.f;
      if (WSCALAR) { wsc = sp[OFF_S]; vt *= sp[OFF_S + 1]; }
      if (DELTA) {
        float kav[KE], kbv[KE];
#pragma unroll
        for (int q = 0; q < NQ; q++) {
          float4 t = *(const float4*)(sp + OFF_KA + q * 32 + ks * 4); kav[q * 4] = t.x; kav[q * 4 + 1] = t.y; kav[q * 4 + 2] = t.z; kav[q * 4 + 3] = t.w;
          float4 u = *(const float4*)(sp + OFF_KB + q * 32 + ks * 4); kbv[q * 4] = u.x; kbv[q * 4 + 1] = u.y; kbv[q * 4 + 2] = u.z; kbv[q * 4 + 3] = u.w;
        }
        float sa0 = 0.f, sa1 = 0.f;
#pragma unroll
        for (int e = 0; e < KE; e += 2) { sa0 = fmaf(S[e], kav[e], sa0); sa1 = fmaf(S[e + 1], kav[e + 1], sa1); }
        float sa = red8(sa0 + sa1);
#pragma unroll
        for (int e = 0; e < KE; e++) S[e] = fmaf(S[e], wv[e], fmaf(sa, kbv[e], vt * kv[e]));
      } else {
#pragma unroll
        for (int e = 0; e < KE; e++) {
          float w = WSCALAR ? wsc : wv[e];
          float k = KFROMW ? (1.f - wv[e]) : kv[e];
          S[e] = fmaf(S[e], w, vt * k);
        }
      }
      float o0 = 0.f, o1 = 0.f;
#pragma unroll
      for (int e = 0; e < KE; e += 2) { o0 = fmaf(S[e], rv[e], o0); o1 = fmaf(S[e + 1], rv[e + 1], o1); }
      float o = red8(o0 + o1);
      if (ks == 0) obuf[step * 32 + vr] = o;
    }
    __syncthreads();
    {
      const int row = blk * TB;
#pragma unroll
      for (int i = 0; i < 2; i++) { const int step = (tid >> 5) + 8 * i, v2 = tid & 31; a.po[(size_t)(row + step) * a.so + v2] = obuf[step * 32 + v2]; }
    }
    if (blk + 1 < NBLK) store_blk((blk & 1) ? buf0 : buf1);
    __syncthreads();
  }
#pragma unroll
  for (int q = 0; q < NQ; q++) { float4 t; t.x = S[q * 4]; t.y = S[q * 4 + 1]; t.z = S[q * 4 + 2]; t.w = S[q * 4 + 3]; *(float4*)(a.state + (size_t)vr * KD + q * 32 + ks * 4) = t; }
}

__device__ void ph_scan(const Params& p, int seg, int bid, int nb, char* smem) {
  const bool first = (seg == 0);
  float* so = (float*)(p.ws + O_SO);
  for (int task = bid; task < 1024; task += nb) {
    ScanArgs a;
    if (task < 256) {
      const int vh = task & 1, h = (task >> 1) & 15, b = task >> 5;
      const size_t ro = (size_t)b * SL * 1024 + h * 64;
      a.pr = (const u16*)(p.ws + O_PR) + ro; a.pk = (const u16*)(p.ws + O_PK) + ro; a.pka = (const u16*)(p.ws + O_PKA) + ro; a.pkb = (const u16*)(p.ws + O_PKB) + ro;
      a.pv = (const u16*)(p.ws + O_PV) + ro + vh * 32; a.pw = (const float*)(p.ws + O_RWW) + ro; a.pvs = nullptr;
      a.po = so + (size_t)b * SL * 4096 + h * 64 + vh * 32; a.state = (float*)(p.ws + O_STRW) + ((size_t)(b * 16 + h) * 64 + vh * 32) * 64;
      a.sr = a.sk = a.sab = a.sv = a.sw = 1024; a.svs = 0; a.so = 4096;
      scan_task<64, true, false, false>(a, first, smem);
    } else if (task < 512) {
      const int t2 = task - 256, vq = t2 & 3, h = (t2 >> 2) & 7, b = t2 >> 5;
      const size_t ro = (size_t)b * SL * 1024 + h * 128;
      a.pr = (const u16*)(p.ws + O_HQ) + ro; a.pk = nullptr; a.pka = a.pkb = nullptr;
      a.pv = (const u16*)(p.ws + O_HV) + ro + vq * 32; a.pw = (const float*)(p.ws + O_HW) + ro; a.pvs = nullptr;
      a.po = so + (size_t)b * SL * 4096 + 1024 + h * 128 + vq * 32; a.state = (float*)(p.ws + O_STHG) + ((size_t)(b * 8 + h) * 128 + vq * 32) * 128;
      a.sr = a.sk = a.sab = a.sv = a.sw = 1024; a.svs = 0; a.so = 4096;
      scan_task<128, false, false, true>(a, first, smem);
    } else {
      const int t2 = task - 512, vh = t2 & 1, hd = (t2 >> 1) & 31, b = t2 >> 6, g = hd >> 3;
      const u16* x2 = (const u16*)(p.ws + O_SX2) + (size_t)b * SL * 3072;
      a.pr = x2 + 2560 + g * 128; a.pk = x2 + 2048 + g * 128; a.pka = a.pkb = nullptr;
      a.pv = x2 + hd * 64 + vh * 32; a.pw = (const float*)(p.ws + O_SWD) + (size_t)b * SL * 32 + hd; a.pvs = (const float*)(p.ws + O_SDT) + (size_t)b * SL * 32 + hd;
      a.po = so + (size_t)b * SL * 4096 + 2048 + hd * 64 + vh * 32; a.state = (float*)(p.ws + O_STSS) + ((size_t)(b * 32 + hd) * 64 + vh * 32) * 128;
      a.sr = a.sk = a.sv = 3072; a.sab = 0; a.sw = 32; a.svs = 32; a.so = 4096;
      scan_task<128, false, true, false>(a, first, smem);
    }
    __syncthreads();
  }
}

__device__ void ph_post(const Params& p, int layer, int bid, int nb) {
  const float* so = (const float*)(p.ws + O_SO); u16* y = (u16*)(p.ws + O_Y);
  const int lane = threadIdx.x & 63, wv = threadIdx.x >> 6;
  {
    u16* urw = (u16*)(p.ws + O_URW); u16* sxbc = (u16*)(p.ws + O_SXBC);
    const int gt = bid * NTHR + threadIdx.x, gs = nb * NTHR;
    for (int idx = gt; idx < 8 * 3456; idx += gs) { int b = idx / 3456, c = idx - b * 3456; urw[(size_t)(b * 513) * 3456 + c] = urw[(size_t)(b * 513 + 512) * 3456 + c]; }
    for (int idx = gt; idx < 8 * 3 * 3072; idx += gs) { int b = idx / 9216, c = idx - b * 9216; sxbc[(size_t)(b * 515) * 3072 + c] = sxbc[(size_t)(b * 515 + 512) * 3072 + c]; }
  }
  const u16* pv = (const u16*)(p.ws + O_PV); const u16* rwg = (const u16*)(p.ws + O_RWG); const float* bonus = (const float*)(p.ws + O_BONUS);
  const float* gnw = p.in[12] + layer * 1024; const float* gnb = p.in[13] + layer * 1024;
  const u16* hg = (const u16*)(p.ws + O_HG); const float* hgn = p.in[15] + layer * 1024;
  const u16* sx2 = (const u16*)(p.ws + O_SX2); const u16* sz = (const u16*)(p.ws + O_SZ);
  const float* dsk = p.in[20] + layer * 32; const float* sgn = p.in[21] + layer * 2048;
  for (int task = bid * 4 + wv; task < RS * 28; task += nb * 4) {
    const int r = task / 28, s = task - r * 28;
    if (s < 16) {
      const int col = s * 64 + lane;
      float o = so[(size_t)r * 4096 + col];
      float mean = wave_sum(o) * (1.f / 64.f);
      float d = o - mean;
      float var = wave_sum(d * d) * (1.f / 64.f);
      float on = d * rsqrtf(var + 64e-5f) * gnw[col] + gnb[col];
      on += bonus[r * 16 + s] * bf2f(pv[(size_t)r * 1024 + col]);
      y[(size_t)r * 4096 + col] = f2bf(on * bf2f(rwg[(size_t)r * 1024 + col]));
    } else if (s < 24) {
      const int h = s - 16;
      float ov[2]; float ss = 0.f;
#pragma unroll
      for (int e = 0; e < 2; e++) { ov[e] = so[(size_t)r * 4096 + 1024 + h * 128 + e * 64 + lane]; ss += ov[e] * ov[e]; }
      ss = wave_sum(ss);
      float rstd = rsqrtf(ss * (1.f / 128.f) + 1e-5f);
#pragma unroll
      for (int e = 0; e < 2; e++) { int c = h * 128 + e * 64 + lane; y[(size_t)r * 4096 + 1024 + c] = f2bf(ov[e] * rstd * hgn[c] * bf2f(hg[(size_t)r * 1024 + c])); }
    } else {
      const int g = s - 24;
      float yv[8]; float ss = 0.f;
#pragma unroll
      for (int e = 0; e < 8; e++) {
        int ch = g * 512 + e * 64 + lane;
        float t = so[(size_t)r * 4096 + 2048 + ch] + dsk[g * 8 + e] * bf2f(sx2[(size_t)r * 3072 + ch]);
        t *= bf2f(sz[(size_t)r * 2048 + ch]);
        yv[e] = t; ss += t * t;
      }
      ss = wave_sum(ss);
      float rstd = rsqrtf(ss * (1.f / 512.f) + 1e-5f);
#pragma unroll
      for (int e = 0; e < 8; e++) { int ch = g * 512 + e * 64 + lane; y[(size_t)r * 4096 + 2048 + ch] = f2bf(yv[e] * rstd * sgn[ch]); }
    }
  }
}

__device__ void ph_merge(const Params& p, int layer, int bid, int nb, char* smem) {
  const u16* W = (const u16*)(p.ws + O_W) + (size_t)layer * W_LAYER + WBR;
  const u16* Y = (const u16*)(p.ws + O_Y); const u16* gates = (const u16*)(p.ws + O_GATES); u16* mg = (u16*)(p.ws + O_MERGED);
  for (int t = bid; t < 256; t += nb) {
    const int m0 = (t & 31) * 128, n0 = (t >> 5) * 128;
    f32x4 tot[4][4]; ACC_ZERO(tot);
#pragma unroll 1
    for (int br = 0; br < 3; br++) {
      f32x4 acc[4][4]; ACC_ZERO(acc);
      const int k0 = br == 0 ? 0 : (br == 1 ? 1024 : 2048), nkt = br == 2 ? 32 : 16;
      gemm_kloop(Y + (size_t)m0 * 4096 + k0, 4096, W + (size_t)n0 * 4096 + k0, 4096, nkt, acc, smem);
      EPI_LOOP({ tot[i][j][r] += bf2f(gates[(size_t)row * 3072 + br * 1024 + col]) * v; })
    }
    { f32x4 (&acc)[4][4] = tot; EPI_LOOP({ mg[(size_t)row * 1024 + col] = f2bf(v); }) }
  }
}
__device__ void ph_out(const Params& p, int layer, int seg, int bid, int nb, char* smem) {
  const u16* W = (const u16*)(p.ws + O_W) + (size_t)layer * W_LAYER + WOUT;
  const u16* mg = (const u16*)(p.ws + O_MERGED);
  const float* xs = layer == 0 ? p.in[0] : p.out;
  for (int t = bid; t < 256; t += nb) {
    const int m0 = (t & 31) * 128, n0 = (t >> 5) * 128;
    f32x4 acc[4][4]; ACC_ZERO(acc);
    gemm_kloop(mg + (size_t)m0 * 1024, 1024, W + (size_t)n0 * 1024, 1024, 16, acc, smem);
    EPI_LOOP({ size_t gr = (size_t)(row >> 9) * SEQ + seg * SL + (row & 511); p.out[gr * 1024 + col] = xs[gr * 1024 + col] + v; })
  }
}
__device__ void ph_ffi(const Params& p, int layer, int bid, int nb, char* smem) {
  const u16* W = (const u16*)(p.ws + O_W) + (size_t)layer * W_LAYER + WFFI;
  const u16* H2 = (const u16*)(p.ws + O_H2); u16* hid = (u16*)(p.ws + O_HID);
  for (int t = bid; t < 256 * 44; t += nb) {
    const int m0 = (t & 255) * 128, n0 = (t >> 8) * 128;
    f32x4 acc[4][4]; ACC_ZERO(acc);
    gemm_kloop(H2 + (size_t)m0 * 1024, 1024, W + (size_t)n0 * 1024, 1024, 16, acc, smem);
    const int lane = threadIdx.x & 63, wave = threadIdx.x >> 6, wm = wave >> 1, wn = wave & 1;
#pragma unroll
    for (int i = 0; i < 4; i++)
#pragma unroll
      for (int j = 0; j < 4; j += 2)
#pragma unroll
        for (int r = 0; r < 4; r++) {
          const int row = m0 + wm * 64 + i * 16 + (lane >> 4) * 4 + r;
          const int ng = n0 + wn * 64 + j * 16 + (lane & 15);
          const int hc = (ng >> 5) * 16 + (ng & 15);
          const float g = acc[i][j][r], u = acc[i][j + 1][r];
          hid[(size_t)row * 2816 + hc] = f2bf(g * sigm(g) * u);
        }
  }
}
__device__ void ph_ffo(const Params& p, int layer, int bid, int nb, char* smem) {
  const u16* W = (const u16*)(p.ws + O_W) + (size_t)layer * W_LAYER + WFFO;
  const u16* hid = (const u16*)(p.ws + O_HID);
  for (int t = bid; t < 256 * 8; t += nb) {
    const int m0 = (t & 255) * 128, n0 = (t >> 8) * 128;
    f32x4 acc[4][4]; ACC_ZERO(acc);
    gemm_kloop(hid + (size_t)m0 * 2816, 2816, W + (size_t)n0 * 2816, 2816, 44, acc, smem);
    EPI_LOOP({ p.out[(size_t)row * 1024 + col] += v; })
  }
}

__device__ void ph_norm1(const Params& p, int layer, int seg, int bid, int nb) {
  if (seg == 0) {
    u16* urw = (u16*)(p.ws + O_URW); u16* sxbc = (u16*)(p.ws + O_SXBC);
    const int gt = bid * NTHR + threadIdx.x, gs = nb * NTHR;
    for (int idx = gt; idx < 8 * 3456; idx += gs) { int b = idx / 3456, c = idx - b * 3456; urw[(size_t)(b * 513) * 3456 + c] = 0; }
    for (int idx = gt; idx < 8 * 9216; idx += gs) { int b = idx / 9216, c = idx - b * 9216; sxbc[(size_t)(b * 515) * 3072 + c] = 0; }
  }
  rmsnorm_rows(layer == 0 ? p.in[0] : p.out, p.in[1] + layer * 1024, (u16*)(p.ws + O_H), nullptr, RS, 0, seg, bid, nb);
}

template <int PH> __device__ __forceinline__ void run_phase(const Params& p, int layer, int seg, int bid, int nb, char* smem) {
  if (PH == PH_WCONV) ph_wconv(p, bid, nb, smem);
  else if (PH == PH_NORM1) ph_norm1(p, layer, seg, bid, nb);
  else if (PH == PH_INPROJ) ph_inproj(p, layer, seg, bid, nb, smem);
  else if (PH == PH_ELEM) ph_elem(p, layer, seg, bid, nb);
  else if (PH == PH_LORA) ph_lora(p, layer, bid, nb, smem);
  else if (PH == PH_RPREP) ph_rprep(p, layer, bid, nb);
  else if (PH == PH_SCAN) ph_scan(p, seg, bid, nb, smem);
  else if (PH == PH_POST) ph_post(p, layer, bid, nb);
  else if (PH == PH_MERGE) ph_merge(p, layer, bid, nb, smem);
  else if (PH == PH_OUT) ph_out(p, layer, seg, bid, nb, smem);
  else if (PH == PH_NORM2) rmsnorm_rows(p.out, p.in[24] + layer * 1024, (u16*)(p.ws + O_H2), nullptr, TTOK, 1, 0, bid, nb);
  else if (PH == PH_FFI) ph_ffi(p, layer, bid, nb, smem);
  else if (PH == PH_FFO) ph_ffo(p, layer, bid, nb, smem);
  else if (PH == PH_FINAL) rmsnorm_rows(p.out, p.in[27], nullptr, p.out, TTOK, 2, 0, bid, nb);
}

#define SMEM_BYTES 73728
template <int PH> __global__ void __launch_bounds__(NTHR) k_phase(Params p, int layer, int seg) {
  __shared__ __attribute__((aligned(16))) char smem[SMEM_BYTES];
  run_phase<PH>(p, layer, seg, blockIdx.x, gridDim.x, smem);
}

extern "C" void kernel_launch(void* const* d_in, const int* in_sizes, int n_in, void* d_out, int out_size, void* d_ws,
                              size_t ws_size, hipStream_t stream) {
  Params p{};
  for (int i = 0; i < 28; i++) p.in[i] = (const float*)d_in[i];
  p.out = (float*)d_out; p.ws = (char*)d_ws;
  const int G = 1024;
  k_phase<PH_WCONV><<<G, NTHR, 0, stream>>>(p, 0, 0);
  for (int l = 0; l < 2; l++) {
    for (int s = 0; s < NSEG; s++) {
      k_phase<PH_NORM1><<<G, NTHR, 0, stream>>>(p, l, s);
      k_phase<PH_INPROJ><<<G, NTHR, 0, stream>>>(p, l, s);
      k_phase<PH_ELEM><<<G, NTHR, 0, stream>>>(p, l, s);
      k_phase<PH_LORA><<<768, NTHR, 0, stream>>>(p, l, s);
      k_phase<PH_RPREP><<<G, NTHR, 0, stream>>>(p, l, s);
      k_phase<PH_SCAN><<<1024, NTHR, 0, stream>>>(p, l, s);
      k_phase<PH_POST><<<G, NTHR, 0, stream>>>(p, l, s);
      k_phase<PH_MERGE><<<256, NTHR, 0, stream>>>(p, l, s);
      k_phase<PH_OUT><<<256, NTHR, 0, stream>>>(p, l, s);
    }
    k_phase<PH_NORM2><<<G, NTHR, 0, stream>>>(p, l, 0);
    k_phase<PH_FFI><<<2048, NTHR, 0, stream>>>(p, l, 0);
    k_phase<PH_FFO><<<2048, NTHR, 0, stream>>>(p, l, 0);
  }
  k_phase<PH_FINAL><<<G, NTHR, 0, stream>>>(p, 0, 0);
}
```

```cpp
#include <hip/hip_runtime.h>
#include <hip/hip_cooperative_groups.h>
#include <stdint.h>
#include <stdio.h>
namespace cg = cooperative_groups;

typedef unsigned short u16;
using bf16x8 = __attribute__((ext_vector_type(8))) short;
using f32x4  = __attribute__((ext_vector_type(4))) float;
using u32x4 = __attribute__((ext_vector_type(4))) unsigned int;
using u32x2 = __attribute__((ext_vector_type(2))) unsigned int;

#define DM 1024
#define SEQ 4096
#define TTOK 32768
#define SL 512
#define NSEG 8
#define RS 4096
#define NTHR 256
#ifndef SCANPROBE
#define SCANPROBE 0
#endif

constexpr size_t al(size_t x) { return (x + 255) & ~(size_t)255; }
constexpr size_t WIN = 0;
constexpr size_t WWUP = WIN + (size_t)15872 * 1024;
constexpr size_t WAUP = WWUP + 65536;
constexpr size_t WGUP = WAUP + 65536;
constexpr size_t WBR = WGUP + 196608;
constexpr size_t WOUT = WBR + 4194304;
constexpr size_t WFFI = WOUT + 1048576;
constexpr size_t WFFO = WFFI + 5767168;
constexpr size_t W_LAYER = WFFO + 2883584;
constexpr size_t O_W = 0;
constexpr size_t O_H = al(O_W + 2 * W_LAYER * 2);
constexpr size_t O_URW = al(O_H + (size_t)RS * 1024 * 2);
constexpr size_t O_HQ = al(O_URW + (size_t)8 * 513 * 3456 * 2);
constexpr size_t O_HV = al(O_HQ + (size_t)RS * 1024 * 2);
constexpr size_t O_HG = al(O_HV + (size_t)RS * 1024 * 2);
constexpr size_t O_HW = al(O_HG + (size_t)RS * 1024 * 2);
constexpr size_t O_SZ = al(O_HW + (size_t)RS * 1024 * 4);
constexpr size_t O_SXBC = al(O_SZ + (size_t)RS * 2048 * 2);
constexpr size_t O_SDT = al(O_SXBC + (size_t)8 * 515 * 3072 * 2);
constexpr size_t O_SWD = al(O_SDT + (size_t)RS * 32 * 4);
constexpr size_t O_GATES = al(O_SWD + (size_t)RS * 32 * 4);
constexpr size_t O_LAW = al(O_GATES + (size_t)RS * 3072 * 2);
constexpr size_t O_LAA = al(O_LAW + (size_t)RS * 64 * 2);
constexpr size_t O_LAG = al(O_LAA + (size_t)RS * 64 * 2);
constexpr size_t O_SX2 = al(O_LAG + (size_t)RS * 192 * 2);
constexpr size_t O_RWW = al(O_SX2 + (size_t)RS * 3072 * 2);
constexpr size_t O_RWA = al(O_RWW + (size_t)RS * 1024 * 4);
constexpr size_t O_RWG = al(O_RWA + (size_t)RS * 1024 * 2);
constexpr size_t O_PR = al(O_RWG + (size_t)RS * 1024 * 2);
constexpr size_t O_PK = al(O_PR + (size_t)RS * 1024 * 2);
constexpr size_t O_PV = al(O_PK + (size_t)RS * 1024 * 2);
constexpr size_t O_PKA = al(O_PV + (size_t)RS * 1024 * 2);
constexpr size_t O_PKB = al(O_PKA + (size_t)RS * 1024 * 2);
constexpr size_t O_BONUS = al(O_PKB + (size_t)RS * 1024 * 2);
constexpr size_t O_SO = al(O_BONUS + (size_t)RS * 16 * 4);
constexpr size_t O_Y = al(O_SO + (size_t)RS * 4096 * 4);
constexpr size_t O_MERGED = al(O_Y + (size_t)RS * 4096 * 2);
constexpr size_t O_STRW = al(O_MERGED + (size_t)RS * 1024 * 2);
constexpr size_t O_STHG = al(O_STRW + (size_t)128 * 64 * 64 * 4);
constexpr size_t O_STSS = al(O_STHG + (size_t)64 * 128 * 128 * 4);
constexpr size_t O_END = al(O_STSS + (size_t)256 * 64 * 128 * 4);
constexpr size_t O_H2 = O_H;
constexpr size_t O_HID = al(O_H2 + (size_t)TTOK * 1024 * 2);
constexpr size_t O_END2 = al(O_HID + (size_t)TTOK * 2816 * 2);
constexpr size_t O_HK = O_END;
constexpr size_t O_GATES2 = al(O_HK + (size_t)RS * 1024 * 2);
constexpr size_t O_BAR = al(O_GATES2 + (size_t)RS * 3072 * 2);
static_assert(O_BAR + 16384 <= (size_t)536870912, "ws overflow");
static_assert(O_END2 <= (size_t)536870912, "ws overflow2");

#define LAS __attribute__((address_space(3)))
struct Params { const float* in[28]; float* out; char* ws; };
typedef const __attribute__((address_space(4))) Params* PP;

enum { PH_WCONV = 0, PH_NORM1, PH_INPROJ, PH_ELEM, PH_LORA, PH_RPREP, PH_SCAN, PH_POST, PH_MERGE, PH_OUT,
       PH_NORM2, PH_FFI, PH_FFO, PH_FINAL };

__device__ __forceinline__ float bf2f(u16 u) { return __uint_as_float(((unsigned)u) << 16); }
__device__ __forceinline__ u16 f2bf(float f) { unsigned u = __float_as_uint(f); u += 0x7fffu + ((u >> 16) & 1u); return (u16)(u >> 16); }
__device__ __forceinline__ float sigm(float x) { return 1.f / (1.f + __expf(-x)); }
__device__ __forceinline__ float wave_sum(float x) {
#pragma unroll
  for (int o = 32; o; o >>= 1) x += __shfl_xor(x, o);
  return x;
}
__device__ __forceinline__ f32x4 cvt4(u32x2 v) {
  f32x4 r; r.x = __uint_as_float(v.x << 16); r.y = __uint_as_float(v.x & 0xffff0000u);
  r.z = __uint_as_float(v.y << 16); r.w = __uint_as_float(v.y & 0xffff0000u); return r;
}
template <int CTRL> __device__ __forceinline__ float dppf(float x) {
  return __int_as_float(__builtin_amdgcn_update_dpp(0, __float_as_int(x), CTRL, 0xF, 0xF, true));
}
__device__ __forceinline__ float red16(float x) {
  x += dppf<0xB1>(x); x += dppf<0x4E>(x); x += dppf<0x141>(x); x += dppf<0x140>(x); return x;
}
__device__ __forceinline__ unsigned pk2(float a, float b) { return (unsigned)f2bf(a) | ((unsigned)f2bf(b) << 16); }
__device__ __forceinline__ u32x2 pack4(float a, float b, float c, float d) {
  u32x2 r; r.x = (unsigned)f2bf(a) | ((unsigned)f2bf(b) << 16); r.y = (unsigned)f2bf(c) | ((unsigned)f2bf(d) << 16); return r;
}
__device__ __forceinline__ f32x4 f4z() { return (f32x4){0.f, 0.f, 0.f, 0.f}; }
__device__ __forceinline__ f32x4 sigm4(f32x4 x) { f32x4 r; r[0] = sigm(x[0]); r[1] = sigm(x[1]); r[2] = sigm(x[2]); r[3] = sigm(x[3]); return r; }
__device__ __forceinline__ u32x2 pack4v(f32x4 x) { return pack4(x[0], x[1], x[2], x[3]); }
__device__ __forceinline__ float red4(float x) { x += dppf<0xB1>(x); x += dppf<0x4E>(x); return x; }
__device__ __forceinline__ float red8(float x) {
  x += dppf<0xB1>(x); x += dppf<0x4E>(x); x += dppf<0x141>(x); return x;
}

__device__ __forceinline__ int tidx() { int t = threadIdx.x; asm volatile("" : "+v"(t)); return t; }
__device__ __forceinline__ int remap_col(int kind, int n, int nsrc) {
  if (kind == 0) return n < nsrc ? n : -1;
  if (kind == 1) {
    if (n < 3456) return n < 3360 ? n : -1;
    if (n < 7552) return 3360 + (n - 3456);
    if (n < 12800) { int c = n - 7552; return c < 5152 ? 7456 + c : -1; }
    return 12608 + (n - 12800);
  }
  int blk = n >> 5, w = n & 31;
  return w < 16 ? blk * 16 + w : 2816 + blk * 16 + (w - 16);
}
__device__ __forceinline__ void tconv(const float* __restrict__ src, int K, int Nsrc, u16* __restrict__ dst, int Kpad, int Npad,
                      int kind, int bid, int nb, char* smem) {
  float(*tile)[65] = (float(*)[65])smem;
  const int tn = Npad >> 6, tk = Kpad >> 6, tid = tidx();
  for (int t = bid; t < tn * tk; t += nb) {
    const int n0 = (t % tn) << 6, k0 = (t / tn) << 6;
    const int nn = tid & 63, c = remap_col(kind, n0 + nn, Nsrc);
#pragma unroll
    for (int i = 0; i < 16; i++) {
      int kk = (tid >> 6) + 4 * i, k = k0 + kk;
      tile[kk][nn] = (k < K && c >= 0) ? src[(size_t)k * Nsrc + c] : 0.f;
    }
    __syncthreads();
#pragma unroll
    for (int i = 0; i < 16; i++) {
      int n2 = (tid >> 6) + 4 * i, kk = tid & 63;
      dst[(size_t)(n0 + n2) * Kpad + k0 + kk] = f2bf(tile[kk][n2]);
    }
    __syncthreads();
  }
}
__device__ __forceinline__ void ph_wconv(PP p, int bid, int nb, char* smem) {
  for (int l = 0; l < 2; l++) {
    u16* W = (u16*)(p->ws + O_W) + (size_t)l * W_LAYER;
    tconv(p->in[2] + (size_t)l * 1024 * 15680, 1024, 15680, W + WIN, 1024, 15872, 1, bid, nb, smem);
    tconv(p->in[5] + (size_t)l * 64 * 1024, 64, 1024, W + WWUP, 64, 1024, 0, bid, nb, smem);
    tconv(p->in[7] + (size_t)l * 64 * 1024, 64, 1024, W + WAUP, 64, 1024, 0, bid, nb, smem);
    tconv(p->in[8] + (size_t)l * 160 * 1024, 160, 1024, W + WGUP, 192, 1024, 0, bid, nb, smem);
    tconv(p->in[22] + (size_t)l * 4096 * 1024, 4096, 1024, W + WBR, 4096, 1024, 0, bid, nb, smem);
    tconv(p->in[23] + (size_t)l * 1024 * 1024, 1024, 1024, W + WOUT, 1024, 1024, 0, bid, nb, smem);
    tconv(p->in[25] + (size_t)l * 1024 * 5632, 1024, 5632, W + WFFI, 1024, 5632, 2, bid, nb, smem);
    tconv(p->in[26] + (size_t)l * 2816 * 1024, 2816, 1024, W + WFFO, 2816, 1024, 0, bid, nb, smem);
  }
}

__device__ __forceinline__ void rmsnorm_rows(const float* __restrict__ xs, const float* __restrict__ gain, u16* dst, float* dstf,
                             int nrows, int mode, int seg, int bid, int nb) {
  const int lane = tidx() & 63, wv = tidx() >> 6;
  for (int r = bid * 4 + wv; r < nrows; r += nb * 4) {
    size_t srow = (mode == 0) ? ((size_t)(r >> 9) * SEQ + seg * SL + (r & 511)) : (size_t)r;
    const float4* xp = (const float4*)(xs + srow * DM);
    float4 v[4]; float ss = 0.f;
#pragma unroll
    for (int i = 0; i < 4; i++) { v[i] = xp[lane + 64 * i]; ss += v[i].x * v[i].x + v[i].y * v[i].y + v[i].z * v[i].z + v[i].w * v[i].w; }
    ss = wave_sum(ss);
    float rstd = rsqrtf(ss * (1.f / DM) + 1e-5f);
#pragma unroll
    for (int i = 0; i < 4; i++) {
      float4 g = ((const float4*)gain)[lane + 64 * i];
      float a = v[i].x * rstd * g.x, b = v[i].y * rstd * g.y, c = v[i].z * rstd * g.z, d = v[i].w * rstd * g.w;
      if (mode == 2) { float4 o; o.x = a; o.y = b; o.z = c; o.w = d; ((float4*)(dstf + (size_t)r * DM))[lane + 64 * i] = o; }
      else { uint2 o; o.x = (unsigned)f2bf(a) | ((unsigned)f2bf(b) << 16); o.y = (unsigned)f2bf(c) | ((unsigned)f2bf(d) << 16);
             ((uint2*)(dst + (size_t)r * DM))[lane + 64 * i] = o; }
    }
  }
}

#define WAIT_V(n) asm volatile("s_waitcnt vmcnt(%0)" ::"n"(n) : "memory")
#define WAIT_L(n) asm volatile("s_waitcnt lgkmcnt(%0)" ::"n"(n) : "memory")
#define RAW_BARRIER() do { WAIT_L(0); __builtin_amdgcn_s_barrier(); } while (0)
template <int MI>
__device__ __forceinline__ void gemm_kloop(const u16* __restrict__ A, int lda, const u16* __restrict__ B, int ldb, int nkt,
                                           f32x4 (&acc)[MI][4], char* smem) {
  constexpr int NA = MI / 2, ABYTES = MI * 32 * 64, STB = ABYTES + 8192, NST = (MI == 4) ? 4 : 3, LPT = NA + 2;
  const int tid = tidx(), lane = tid & 63, wave = tid >> 6, wm = wave >> 1, wn = wave & 1;
  const int wu = __builtin_amdgcn_readfirstlane(wave);
  const u16* ga[NA]; const u16* gb[2];
#pragma unroll
  for (int i = 0; i < NA; i++) {
    const int r = (wu * NA + i) * 16 + (lane >> 2), kc = (lane & 3) ^ ((r >> 2) & 3);
    ga[i] = A + (size_t)r * lda + kc * 8;
  }
#pragma unroll
  for (int i = 0; i < 2; i++) {
    const int r = (wu * 2 + i) * 16 + (lane >> 2), kc = (lane & 3) ^ ((r >> 2) & 3);
    gb[i] = B + (size_t)r * ldb + kc * 8;
  }
  LAS char* sm = (LAS char*)smem;
#define GSTAGE(st_, kt_) { \
    _Pragma("unroll") for (int i = 0; i < NA; i++) \
      __builtin_amdgcn_global_load_lds((const unsigned*)(ga[i] + (kt_) * 32), (LAS unsigned*)(sm + (st_) * STB + (wu * NA + i) * 1024), 16, 0, 0); \
    _Pragma("unroll") for (int i = 0; i < 2; i++) \
      __builtin_amdgcn_global_load_lds((const unsigned*)(gb[i] + (kt_) * 32), (LAS unsigned*)(sm + (st_) * STB + ABYTES + (wu * 2 + i) * 1024), 16, 0, 0); }
  __syncthreads();
#pragma unroll
  for (int s0 = 0; s0 < NST - 1; s0++) if (s0 < nkt) GSTAGE(s0, s0)
  const int frow = lane & 15, fg = lane >> 4;
  const int fo = (frow * 4 + (fg ^ ((frow >> 2) & 3))) * 16;
  const int offA = (wm * MI * 16) * 64 + fo, offB = ABYTES + (wn * 64) * 64 + fo;
  int st = 0;
#pragma unroll 1
  for (int kt = 0; kt < nkt; kt++) {
    if (NST == 4) { if (kt + 2 < nkt) WAIT_V(2 * LPT); else if (kt + 1 < nkt) WAIT_V(LPT); else WAIT_V(0); }
    else { if (kt + 1 < nkt) WAIT_V(LPT); else WAIT_V(0); }
    RAW_BARRIER();
    if (kt + NST - 1 < nkt) { const int sn = (st + NST - 1 >= NST) ? st - 1 : st + NST - 1; GSTAGE(sn, kt + NST - 1) }
    const LAS char* sp = sm + st * STB;
    bf16x8 af[MI], bfr[4];
#pragma unroll
    for (int i = 0; i < MI; i++) af[i] = *(const LAS bf16x8*)(sp + offA + i * 1024);
#pragma unroll
    for (int i = 0; i < 4; i++) bfr[i] = *(const LAS bf16x8*)(sp + offB + i * 1024);
#pragma unroll
    for (int i = 0; i < MI; i++)
#pragma unroll
      for (int j = 0; j < 4; j++) acc[i][j] = __builtin_amdgcn_mfma_f32_16x16x32_bf16(bfr[j], af[i], acc[i][j], 0, 0, 0);
    st = (st + 1 == NST) ? 0 : st + 1;
  }
  RAW_BARRIER();
}
#define ACC_ZERO(acc) { _Pragma("unroll") for (int i = 0; i < (int)(sizeof(acc) / sizeof(acc[0])); i++) _Pragma("unroll") for (int j = 0; j < 4; j++) acc[i][j] = (f32x4){0.f, 0.f, 0.f, 0.f}; }
#define EPI_LOOP(BODY) { constexpr int MI_ = (int)(sizeof(acc) / sizeof(acc[0])); const int lane_ = tidx() & 63, wave_ = tidx() >> 6, wm_ = wave_ >> 1, wn_ = wave_ & 1; \
  _Pragma("unroll") for (int i = 0; i < MI_; i++) { _Pragma("unroll") for (int j = 0; j < 4; j++) { \
    const int row = m0 + wm_ * (MI_ * 16) + i * 16 + (lane_ & 15); const int col = n0 + wn_ * 64 + j * 16 + (lane_ >> 4) * 4; const f32x4 v = acc[i][j]; BODY } \
    asm volatile("" ::: "memory"); } }
#define EPI_LOOP2(LOAD, STORE) { constexpr int MI_ = (int)(sizeof(acc) / sizeof(acc[0])); const int lane_ = tidx() & 63, wave_ = tidx() >> 6, wm_ = wave_ >> 1, wn_ = wave_ & 1; \
  _Pragma("unroll") for (int i = 0; i < MI_; i++) { f32x4 l0[4], l1[4]; \
    _Pragma("unroll") for (int j = 0; j < 4; j++) { \
      const int row = m0 + wm_ * (MI_ * 16) + i * 16 + (lane_ & 15); const int col = n0 + wn_ * 64 + j * 16 + (lane_ >> 4) * 4; LOAD } \
    asm volatile("" ::: "memory"); \
    _Pragma("unroll") for (int j = 0; j < 4; j++) { \
      const int row = m0 + wm_ * (MI_ * 16) + i * 16 + (lane_ & 15); const int col = n0 + wn_ * 64 + j * 16 + (lane_ >> 4) * 4; const f32x4 v = acc[i][j]; STORE } \
    asm volatile("" ::: "memory"); } }
#define COLJ(j) (n0 + ((tidx() >> 6) & 1) * 64 + (j) * 16 + ((tidx() & 63) >> 4) * 4)
__device__ __forceinline__ void ph_inproj(PP p, int layer, int seg, int bid, int nb, char* smem) {
  const u16* W = (const u16*)(p->ws + O_W) + (size_t)layer * W_LAYER + WIN;
  const u16* H = (const u16*)(p->ws + O_H);
  u16* urw = (u16*)(p->ws + O_URW); u16* hq = (u16*)(p->ws + O_HQ); u16* hv = (u16*)(p->ws + O_HV); u16* hg = (u16*)(p->ws + O_HG);
  float* hw = (float*)(p->ws + O_HW); u16* hk = (u16*)(p->ws + O_HK); u16* sz = (u16*)(p->ws + O_SZ); u16* sxbc = (u16*)(p->ws + O_SXBC);
  float* sdt = (float*)(p->ws + O_SDT); u16* gates = (u16*)(p->ws + ((seg & 1) ? O_GATES2 : O_GATES));
  const float* lbl = p->in[14];
  const float* dtb = p->in[18] + layer * 32;
  for (int t = bid; t < 16 * 124; t += nb) {
    const int m0 = (t & 15) * 256, n0 = (t >> 4) * 128;
    f32x4 acc[8][4]; ACC_ZERO(acc);
    gemm_kloop(H + (size_t)m0 * 1024, 1024, W + (size_t)n0 * 1024, 1024, 32, acc, smem);
    if (n0 < 3456) {
      EPI_LOOP({ if (col < 3360) *(u32x2*)(urw + ((size_t)((row >> 9) * 513 + 1 + (row & 511))) * 3456 + col) = pack4v(v); })
    } else if (n0 < 7552) {
      const int which = (n0 - 3456) >> 10;
      if (which == 0) { EPI_LOOP({ int cc = (col - 3456) & 1023; *(u32x2*)(hq + (size_t)row * 1024 + cc) = pack4v(v * sigm4(v)); }) }
      else if (which == 1) {
        f32x4 lbj[4];
#pragma unroll
        for (int j = 0; j < 4; j++) {
          int cc = (COLJ(j) - 3456) & 1023;
          f32x4 l0 = *(const f32x4*)(lbl + cc), l1 = *(const f32x4*)(lbl + 1024 + cc);
#pragma unroll
          for (int e = 0; e < 4; e++) lbj[j][e] = layer == 0 ? 0.f : 1.f / (1.f + __expf(l0[e] - l1[e]));
        }
        EPI_LOOP({ int cc = (col - 3456) & 1023; const f32x4 lb = lbj[j];
                   f32x4 sg = sigm4(v); f32x4 w = lb + (1.f - lb) * sg; f32x4 lf;
                   lf[0] = fmaxf(__logf(w[0]), -60.f); lf[1] = fmaxf(__logf(w[1]), -60.f); lf[2] = fmaxf(__logf(w[2]), -60.f); lf[3] = fmaxf(__logf(w[3]), -60.f);
                   *(f32x4*)(hw + (size_t)row * 1024 + cc) = lf;
                   *(u32x2*)(hk + (size_t)row * 1024 + cc) = pack4v((1.f - lb) * (1.f - sg)); })
      } else if (which == 2) { EPI_LOOP({ int cc = (col - 3456) & 1023; *(u32x2*)(hv + (size_t)row * 1024 + cc) = pack4v(v); }) }
      else { EPI_LOOP({ int cc = (col - 3456) & 1023; *(u32x2*)(hg + (size_t)row * 1024 + cc) = pack4v(sigm4(v)); }) }
    } else if (n0 < 12800) {
      const int c0 = n0 - 7552;
      if (c0 < 2048) { EPI_LOOP({ int c = col - 7552; *(u32x2*)(sz + (size_t)row * 2048 + c) = pack4v(v * sigm4(v)); }) }
      else if (c0 < 5120) { EPI_LOOP({ int c = col - 7552 - 2048; *(u32x2*)(sxbc + ((size_t)((row >> 9) * 515 + 3 + (row & 511))) * 3072 + c) = pack4v(v); }) }
      else {
        f32x4 dbj[4];
#pragma unroll
        for (int j = 0; j < 4; j++) { int c = COLJ(j) - 7552 - 5120; dbj[j] = c < 32 ? *(const f32x4*)(dtb + c) : (f32x4){0.f, 0.f, 0.f, 0.f}; }
        EPI_LOOP({ int c = col - 7552 - 5120; if (c < 32) { f32x4 xx = v + dbj[j]; f32x4 o;
                   o[0] = xx[0] > 20.f ? xx[0] : log1pf(__expf(xx[0])); o[1] = xx[1] > 20.f ? xx[1] : log1pf(__expf(xx[1]));
                   o[2] = xx[2] > 20.f ? xx[2] : log1pf(__expf(xx[2])); o[3] = xx[3] > 20.f ? xx[3] : log1pf(__expf(xx[3]));
                   *(f32x4*)(sdt + (size_t)row * 32 + c) = o; } })
      }
    } else {
      EPI_LOOP({ int c = col - 12800; *(u32x2*)(gates + (size_t)row * 3072 + c) = pack4v(sigm4(v)); })
    }
  }
}

__device__ __forceinline__ void ph_elem(PP p, int layer, int seg, int bid, int nb) {
  const u16* urw = (const u16*)(p->ws + O_URW);
  const float* mu = p->in[3] + layer * 3360;
  u16* law = (u16*)(p->ws + O_LAW); u16* laa = (u16*)(p->ws + O_LAA); u16* lag = (u16*)(p->ws + O_LAG);
  const int gt = bid * NTHR + tidx(), gs = nb * NTHR;
#pragma unroll 1
  for (int idx = gt; idx < RS * 80; idx += gs) {
    const int r = idx / 80, gq = idx - r * 80;
    if (gq >= 72) { u32x2 z; z.x = 0; z.y = 0; *(u32x2*)(lag + (size_t)r * 192 + 160 + (gq - 72) * 4) = z; continue; }
    const int col = 3072 + gq * 4;
    const size_t ro = (size_t)((r >> 9) * 513 + 1 + (r & 511)) * 3456;
    f32x4 cur = cvt4(*(const u32x2*)(urw + ro + col)), prv = cvt4(*(const u32x2*)(urw + ro - 3456 + col));
    f32x4 m4 = *(const f32x4*)(mu + col);
    f32x4 val = cur + (prv - cur) * m4;
    if (gq < 16) *(u32x2*)(law + (size_t)r * 64 + gq * 4) = pack4(tanhf(val[0]), tanhf(val[1]), tanhf(val[2]), tanhf(val[3]));
    else if (gq < 32) *(u32x2*)(laa + (size_t)r * 64 + (gq - 16) * 4) = pack4(val[0], val[1], val[2], val[3]);
    else *(u32x2*)(lag + (size_t)r * 192 + (gq - 32) * 4) = pack4(sigm(val[0]), sigm(val[1]), sigm(val[2]), sigm(val[3]));
  }
  const u16* sxbc = (const u16*)(p->ws + O_SXBC); u16* sx2 = (u16*)(p->ws + O_SX2);
  const float* cw = p->in[16] + (size_t)layer * 3072 * 4; const float* cb = p->in[17] + layer * 3072;
#pragma unroll 1
  for (int idx = gt; idx < (RS / 4) * 384; idx += gs) {
    const int rb = idx / 384, cg = idx - rb * 384, r = rb * 4, ch = cg * 8;
    const size_t ro = (size_t)((r >> 9) * 515 + (r & 511)) * 3072 + ch;
    u32x4 xin[7];
#pragma unroll
    for (int j = 0; j < 7; j++) xin[j] = *(const u32x4*)(sxbc + ro + (size_t)j * 3072);
    f32x4 w4[8];
#pragma unroll
    for (int c = 0; c < 8; c++) w4[c] = *(const f32x4*)(cw + (size_t)(ch + c) * 4);
    f32x4 b0 = *(const f32x4*)(cb + ch), b1 = *(const f32x4*)(cb + ch + 4);
#pragma unroll
    for (int rr = 0; rr < 4; rr++) {
      float o[8];
#pragma unroll
      for (int c = 0; c < 8; c++) {
        float acc = c < 4 ? b0[c] : b1[c - 4];
#pragma unroll
        for (int j = 0; j < 4; j++) {
          const unsigned wd = xin[rr + j][c >> 1];
          const float xv = (c & 1) ? __uint_as_float(wd & 0xffff0000u) : __uint_as_float(wd << 16);
          acc = fmaf(xv, w4[c][j], acc);
        }
        o[c] = acc * sigm(acc);
      }
      u32x4 ov; ov.x = pk2(o[0], o[1]); ov.y = pk2(o[2], o[3]); ov.z = pk2(o[4], o[5]); ov.w = pk2(o[6], o[7]);
      *(u32x4*)(sx2 + (size_t)(r + rr) * 3072 + ch) = ov;
    }
  }
}

__device__ __forceinline__ void ph_lora(PP p, int layer, int bid, int nb, char* smem) {
  const u16* W = (const u16*)(p->ws + O_W) + (size_t)layer * W_LAYER;
  float* rww = (float*)(p->ws + O_RWW); u16* rwa = (u16*)(p->ws + O_RWA); u16* rwg = (u16*)(p->ws + O_RWG);
  const float* w0 = p->in[4] + layer * 1024; const float* a0 = p->in[6] + layer * 1024;
  for (int t = bid; t < 3 * 256; t += nb) {
    const int job = t >> 8, tt = t & 255, m0 = (tt & 31) * 128, n0 = (tt >> 5) * 128;
    f32x4 acc[4][4]; ACC_ZERO(acc);
    if (job == 0) {
      gemm_kloop((const u16*)(p->ws + O_LAW) + (size_t)m0 * 64, 64, W + WWUP + (size_t)n0 * 64, 64, 2, acc, smem);
      f32x4 pj[4];
#pragma unroll
      for (int j = 0; j < 4; j++) pj[j] = *(const f32x4*)(w0 + COLJ(j));
      EPI_LOOP({ f32x4 sg = sigm4(pj[j] + v); f32x4 o; o[0] = __expf(-0.60653066f * sg[0]); o[1] = __expf(-0.60653066f * sg[1]); o[2] = __expf(-0.60653066f * sg[2]); o[3] = __expf(-0.60653066f * sg[3]);
                 *(f32x4*)(rww + (size_t)row * 1024 + col) = o; })
    } else if (job == 1) {
      gemm_kloop((const u16*)(p->ws + O_LAA) + (size_t)m0 * 64, 64, W + WAUP + (size_t)n0 * 64, 64, 2, acc, smem);
      f32x4 pj[4];
#pragma unroll
      for (int j = 0; j < 4; j++) pj[j] = *(const f32x4*)(a0 + COLJ(j));
      EPI_LOOP({ *(u32x2*)(rwa + (size_t)row * 1024 + col) = pack4v(sigm4(pj[j] + v)); })
    } else {
      gemm_kloop((const u16*)(p->ws + O_LAG) + (size_t)m0 * 192, 192, W + WGUP + (size_t)n0 * 192, 192, 6, acc, smem);
      EPI_LOOP({ *(u32x2*)(rwg + (size_t)row * 1024 + col) = pack4v(v); })
    }
  }
}

__device__ __forceinline__ void ph_rprep(PP p, int layer, int bid, int nb) {
  const u16* urw = (const u16*)(p->ws + O_URW); const u16* rwa = (const u16*)(p->ws + O_RWA);
  u16* pr = (u16*)(p->ws + O_PR); u16* pk = (u16*)(p->ws + O_PK); u16* pv = (u16*)(p->ws + O_PV);
  u16* pka = (u16*)(p->ws + O_PKA); u16* pkb = (u16*)(p->ws + O_PKB); float* bonus = (float*)(p->ws + O_BONUS);
  const float* mu = p->in[3] + layer * 3360; const float* kk_ = p->in[9] + layer * 1024; const float* ka_ = p->in[10] + layer * 1024;
  const float* rk_ = p->in[11] + layer * 1024;
  {
    u16* sxbc = (u16*)(p->ws + O_SXBC);
    const int gt = bid * NTHR + tidx(), gs = nb * NTHR;
    for (int idx = gt; idx < 8 * 3 * 3072; idx += gs) { int b = idx / 9216, c = idx - b * 9216; sxbc[(size_t)(b * 515) * 3072 + c] = sxbc[(size_t)(b * 515 + 512) * 3072 + c]; }
  }
  const int lane = tidx() & 63, wv = tidx() >> 6;
#pragma unroll 1
  for (int task = bid * 4 + wv; task < RS * 4; task += nb * 4) {
    const int r = task >> 2, col = (task & 3) * 256 + lane * 4;
    const size_t ro = (size_t)((r >> 9) * 513 + 1 + (r & 511)) * 3456 + col;
    f32x4 rc = cvt4(*(const u32x2*)(urw + ro)), rp = cvt4(*(const u32x2*)(urw + ro - 3456));
    f32x4 kc = cvt4(*(const u32x2*)(urw + ro + 1024)), kp = cvt4(*(const u32x2*)(urw + ro - 3456 + 1024));
    f32x4 vc = cvt4(*(const u32x2*)(urw + ro + 2048)), vp = cvt4(*(const u32x2*)(urw + ro - 3456 + 2048));
    f32x4 a = cvt4(*(const u32x2*)(rwa + (size_t)r * 1024 + col));
    f32x4 rr = rc + (rp - rc) * *(const f32x4*)(mu + col);
    f32x4 k = kc + (kp - kc) * *(const f32x4*)(mu + 1024 + col);
    f32x4 vv = vc + (vp - vc) * *(const f32x4*)(mu + 2048 + col);
    f32x4 kkv = k * *(const f32x4*)(kk_ + col);
    float n2 = red16(kkv[0] * kkv[0] + kkv[1] * kkv[1] + kkv[2] * kkv[2] + kkv[3] * kkv[3]);
    const float inv = 1.f / fmaxf(sqrtf(n2), 1e-12f);
    f32x4 kkn = kkv * inv;
    f32x4 kmod = k * (1.f + (a - 1.f) * *(const f32x4*)(ka_ + col));
    f32x4 bt = rr * kmod * *(const f32x4*)(rk_ + col);
    float bn = red16(bt[0] + bt[1] + bt[2] + bt[3]);
    const size_t o = (size_t)r * 1024 + col;
    *(u32x2*)(pr + o) = pack4(rr[0], rr[1], rr[2], rr[3]);
    *(u32x2*)(pk + o) = pack4(kmod[0], kmod[1], kmod[2], kmod[3]);
    *(u32x2*)(pv + o) = pack4(vv[0], vv[1], vv[2], vv[3]);
    *(u32x2*)(pka + o) = pack4(-kkn[0], -kkn[1], -kkn[2], -kkn[3]);
    *(u32x2*)(pkb + o) = pack4(kkn[0] * a[0], kkn[1] * a[1], kkn[2] * a[2], kkn[3] * a[3]);
    if ((lane & 15) == 0) bonus[r * 16 + (col >> 6)] = bn;
  }
}

struct ScanArgs {
  const u16 *pr, *pk, *pka, *pkb, *pv;
  const float *pw, *pvs;
  float *po, *state;
  int sr, sk, sab, sv, sw, svs, so;
};
#define TB 16
template <int KD, bool DELTA, bool WSCALAR, bool KFROMW, int LPR>
__device__ __forceinline__ void scan_task(const ScanArgs& a, bool first, bool save, char* smem) {
  constexpr int RB = 256 / LPR, GV = RB / 4; constexpr int KE = KD / LPR, NQ = KE / 4, NG = KD / 64, G4 = KD / 4;
  constexpr int OFF_R = 0, OFF_K = KD;
  constexpr int OFF_W = KFROMW ? KD : 2 * KD;
  constexpr int OFF_KA = OFF_W + (WSCALAR ? 0 : KD);
  constexpr int OFF_KB = OFF_KA + (DELTA ? KD : 0);
  constexpr int OFF_V = OFF_KB + (DELTA ? KD : 0);
  constexpr int OFF_S = OFF_V + RB;
  constexpr int STR = OFF_S + 4;
  float* buf0 = (float*)smem; float* buf1 = buf0 + TB * STR; float* obuf = buf1 + TB * STR;
  const int tid = tidx(), ks = tid & (LPR - 1), vr = tid / LPR;
  u32x2 gr[NG], gk[NG], gka[NG], gkb[NG], gv; f32x4 gw[NG]; float gsw = 0.f, gsv = 0.f;
  gv.x = gv.y = 0;
#define LOAD_BLK(blk_) { \
    const int row = (blk_) * TB; \
    _Pragma("unroll") for (int i = 0; i < NG; i++) { \
      const int g = tid + 256 * i, step = g / G4, e4 = g % G4; \
      gr[i] = *(const u32x2*)(a.pr + (size_t)(row + step) * a.sr + e4 * 4); \
      if (!KFROMW) gk[i] = *(const u32x2*)(a.pk + (size_t)(row + step) * a.sk + e4 * 4); \
      if (!WSCALAR) gw[i] = *(const f32x4*)(a.pw + (size_t)(row + step) * a.sw + e4 * 4); \
      if (DELTA) { gka[i] = *(const u32x2*)(a.pka + (size_t)(row + step) * a.sab + e4 * 4); gkb[i] = *(const u32x2*)(a.pkb + (size_t)(row + step) * a.sab + e4 * 4); } \
    } \
    if (tid < TB * GV) { const int step = tid / GV, e4 = tid % GV; gv = *(const u32x2*)(a.pv + (size_t)(row + step) * a.sv + e4 * 4); } \
    if (WSCALAR && tid < TB) { gsw = a.pw[(size_t)(row + tid) * a.sw]; gsv = a.pvs[(size_t)(row + tid) * a.svs]; } }
#define STORE_BLK(buf_) { \
    float* bufp = (buf_); \
    _Pragma("unroll") for (int i = 0; i < NG; i++) { \
      const int g = tid + 256 * i, step = g / G4, e4 = g % G4; \
      float* d = bufp + step * STR + e4 * 4; \
      *(f32x4*)(d + OFF_R) = cvt4(gr[i]); \
      if (!KFROMW) *(f32x4*)(d + OFF_K) = cvt4(gk[i]); \
      if (!WSCALAR) *(f32x4*)(d + OFF_W) = gw[i]; \
      if (DELTA) { *(f32x4*)(d + OFF_KA) = cvt4(gka[i]); *(f32x4*)(d + OFF_KB) = cvt4(gkb[i]); } \
    } \
    if (tid < TB * GV) { const int step = tid / GV, e4 = tid % GV; *(f32x4*)(bufp + step * STR + OFF_V + e4 * 4) = cvt4(gv); } \
    if (WSCALAR && tid < TB) { bufp[tid * STR + OFF_S] = gsw; bufp[tid * STR + OFF_S + 1] = gsv; } }
  float S[KE];
  if (first) {
#pragma unroll
    for (int e = 0; e < KE; e++) S[e] = 0.f;
  } else {
#pragma unroll
    for (int q = 0; q < NQ; q++) { float4 t = *(const float4*)(a.state + (size_t)vr * KD + q * (LPR * 4) + ks * 4); S[q * 4] = t.x; S[q * 4 + 1] = t.y; S[q * 4 + 2] = t.z; S[q * 4 + 3] = t.w; }
  }
  LOAD_BLK(0)
  __syncthreads();
  STORE_BLK(buf0)
  __syncthreads();
  constexpr int NBLK = SL / TB;
  for (int blk = 0; blk < NBLK; blk++) {
    float* buf = (blk & 1) ? buf1 : buf0;
    if (blk + 1 < NBLK) LOAD_BLK(blk + 1)
    {
      float rv1[KE], kb1[KE], kv[2][KE], wv[2][KE], kav[2][KE], vtv[2], wsv[2], vsv[2];
#define LD_STEP(slot, st_) { const float* sp = buf + (st_) * STR; \
        _Pragma("unroll") for (int q = 0; q < NQ; q++) { \
          if (!WSCALAR) { f32x4 u = *(const f32x4*)(sp + OFF_W + q * (LPR * 4) + ks * 4); wv[slot][q * 4] = u[0]; wv[slot][q * 4 + 1] = u[1]; wv[slot][q * 4 + 2] = u[2]; wv[slot][q * 4 + 3] = u[3]; } \
          if (!KFROMW) { f32x4 u = *(const f32x4*)(sp + OFF_K + q * (LPR * 4) + ks * 4); kv[slot][q * 4] = u[0]; kv[slot][q * 4 + 1] = u[1]; kv[slot][q * 4 + 2] = u[2]; kv[slot][q * 4 + 3] = u[3]; } \
          if (DELTA) { f32x4 u = *(const f32x4*)(sp + OFF_KA + q * (LPR * 4) + ks * 4); kav[slot][q * 4] = u[0]; kav[slot][q * 4 + 1] = u[1]; kav[slot][q * 4 + 2] = u[2]; kav[slot][q * 4 + 3] = u[3]; \
                     } \
        } \
        vtv[slot] = sp[OFF_V + vr]; \
        if (WSCALAR) { wsv[slot] = sp[OFF_S]; vsv[slot] = sp[OFF_S + 1]; } }
      LD_STEP(0, 0)
#define DO_STEP(cs, step_) { \
        { const float* spr = buf + (step_) * STR; _Pragma("unroll") for (int q = 0; q < NQ; q++) { f32x4 t = *(const f32x4*)(spr + OFF_R + q * (LPR * 4) + ks * 4); rv1[q * 4] = t[0]; rv1[q * 4 + 1] = t[1]; rv1[q * 4 + 2] = t[2]; rv1[q * 4 + 3] = t[3]; \
            if (DELTA) { f32x4 x = *(const f32x4*)(spr + OFF_KB + q * (LPR * 4) + ks * 4); kb1[q * 4] = x[0]; kb1[q * 4 + 1] = x[1]; kb1[q * 4 + 2] = x[2]; kb1[q * 4 + 3] = x[3]; } } } \
        float vt = vtv[cs]; \
        if (WSCALAR) vt *= vsv[cs]; \
        if (DELTA) { \
          float sa0 = 0.f, sa1 = 0.f, sa2 = 0.f, sa3 = 0.f; \
          _Pragma("unroll") for (int e = 0; e < KE; e += 2) { sa0 = fmaf(S[e], kav[cs][e], sa0); sa1 = fmaf(S[e + 1], kav[cs][e + 1], sa1); } \
          _Pragma("unroll") for (int e = 0; e < KE; e++) S[e] = fmaf(S[e], wv[cs][e], vt * kv[cs][e]); \
          float sa = (LPR == 8) ? red8((sa0 + sa1) + (sa2 + sa3)) : red4((sa0 + sa1) + (sa2 + sa3)); \
          _Pragma("unroll") for (int e = 0; e < KE; e++) S[e] = fmaf(sa, kb1[e], S[e]); \
        } else { \
          _Pragma("unroll") for (int e = 0; e < KE; e++) { \
            float w = WSCALAR ? wsv[cs] : wv[cs][e]; \
            float k = KFROMW ? (1.f - wv[cs][e]) : kv[cs][e]; \
            S[e] = fmaf(S[e], w, vt * k); } \
        } \
        float o0 = 0.f, o1 = 0.f, o2 = 0.f, o3 = 0.f; \
        _Pragma("unroll") for (int e = 0; e < KE; e += 2) { o0 = fmaf(S[e], rv1[e], o0); o1 = fmaf(S[e + 1], rv1[e + 1], o1); } \
        float o = (LPR == 8) ? red8((o0 + o1) + (o2 + o3)) : red4((o0 + o1) + (o2 + o3)); \
        if (ks == 0) obuf[(step_) * RB + vr] = o; }
#pragma unroll 1
      for (int step = 0; step < TB; step += 2) {
        LD_STEP(1, step + 1)
        DO_STEP(0, step)
        if (step + 2 < TB) LD_STEP(0, step + 2)
        DO_STEP(1, step + 1)
      }
    }
    __syncthreads();
    {
      const int row = blk * TB;
#pragma unroll
      for (int i = 0; i < TB * RB / 256; i++) { const int idx = tid + 256 * i, step = idx / RB, v2 = idx % RB; a.po[(size_t)(row + step) * a.so + v2] = obuf[idx]; }
    }
    if (blk + 1 < NBLK) STORE_BLK((blk & 1) ? buf0 : buf1)
    __syncthreads();
  }
  if (save)
#pragma unroll
  for (int q = 0; q < NQ; q++) { float4 t; t.x = S[q * 4]; t.y = S[q * 4 + 1]; t.z = S[q * 4 + 2]; t.w = S[q * 4 + 3]; *(float4*)(a.state + (size_t)vr * KD + q * (LPR * 4) + ks * 4) = t; }
}


struct ChunkArgs { const u16 *q, *k, *v; const float* lf; float* o; float* state; int ld, ldlf; float expA; };
#define QLD 136
#define KHLD 72
template <bool SSM>
__device__ __forceinline__ void chunk_task(const ChunkArgs& a, bool first, bool save, char* smem) {
  u16* QT = (u16*)smem;
  u16* KT = QT + 64 * QLD;
  u16* KH = KT + 64 * QLD;
  u16* VT = KH + 128 * KHLD;
  u16* ST = VT + 32 * KHLD;
  float* gam = (float*)(ST + 32 * QLD); float* em = gam + 128; float* cum = gam + 256; float* dts = gam + 512;
  const int tid = tidx(), lane = tid & 63, g = lane >> 4, c = lane & 15;
  const int w = __builtin_amdgcn_readfirstlane(tid >> 6);
  f32x4 accS[2][2];
#pragma unroll
  for (int i = 0; i < 2; i++)
#pragma unroll
    for (int j = 0; j < 2; j++)
      accS[i][j] = first ? (f32x4){0.f, 0.f, 0.f, 0.f} : *(const f32x4*)(a.state + (size_t)((i * 2 + j) * 256 + tid) * 4);
  float rcn[32]; u16 qan[32], kan[32]; u32x4 cqn[4], ckn[4], vvn; float dtn = 0.f;
#define CH_PREFETCH(chn_) { const int rp = (chn_) * 64; \
    if (!SSM) { const int d = tid & 127, half = tid >> 7; \
      const float* lfp = a.lf + (size_t)(rp + half * 32) * a.ldlf + d; \
      const u16* qp = a.q + (size_t)(rp + half * 32) * a.ld + d; const u16* kp = a.k + (size_t)(rp + half * 32) * a.ld + d; \
      _Pragma("unroll") for (int i = 0; i < 32; i++) rcn[i] = lfp[(size_t)i * a.ldlf]; \
      _Pragma("unroll") for (int i = 0; i < 32; i++) { qan[i] = qp[(size_t)i * a.ld]; kan[i] = kp[(size_t)i * a.ld]; } \
    } else { \
      _Pragma("unroll") for (int i = 0; i < 4; i++) { const int id = tid + 256 * i, s = id >> 4, cc = id & 15; \
        cqn[i] = *(const u32x4*)(a.q + (size_t)(rp + s) * a.ld + cc * 8); ckn[i] = *(const u32x4*)(a.k + (size_t)(rp + s) * a.ld + cc * 8); } \
      if (tid < 64) dtn = a.lf[(size_t)(rp + tid) * a.ldlf]; \
    } \
    { const int s = tid & 63, vg = tid >> 6; vvn = *(const u32x4*)(a.v + (size_t)(rp + s) * a.ld + vg * 8); } }
  CH_PREFETCH(0)
#pragma unroll 1
  for (int ch = 0; ch < SL / 64; ch++) {
    const int r0 = ch * 64;
    float rc[32]; float kf[32]; float rc63 = 0.f;
    if (!SSM) {
      const int d = tid & 127, half = tid >> 7;
#pragma unroll
      for (int i = 0; i < 32; i++) rc[i] = rcn[i];
      float tot = 0.f;
      if (half == 0) {
        float acc = 0.f;
#pragma unroll
        for (int i = 31; i >= 0; i--) { float l = rc[i]; tot += l; rc[i] = acc; acc -= l; }
        em[d] = __expf(tot);
      } else {
        float acc = 0.f;
#pragma unroll
        for (int i = 0; i < 32; i++) { acc += rc[i]; rc[i] = acc; }
        tot = acc;
      }
      cum[half * 128 + d] = tot;
#pragma unroll
      for (int i = 0; i < 32; i++) {
        const int s = half * 32 + i;
        float qv = bf2f(qan[i]); kf[i] = bf2f(kan[i]);
        float r = rc[i];
        QT[s * QLD + d] = f2bf(qv * __expf(fminf(r, 80.f)));
        KT[s * QLD + d] = f2bf(kf[i] * __expf(fminf(-r, 80.f)));
      }
    } else {
#pragma unroll
      for (int i = 0; i < 4; i++) {
        const int id = tid + 256 * i, s = id >> 4, cc = id & 15;
        *(u32x4*)(QT + s * QLD + cc * 8) = cqn[i];
        *(u32x4*)(KT + s * QLD + cc * 8) = ckn[i];
      }
      if (tid < 64) {
        float dtv = dtn;
        float x = -dtv * a.expA;
#pragma unroll
        for (int o = 1; o < 64; o <<= 1) { float y = __shfl_up(x, o); if (lane >= o) x += y; }
        cum[tid] = x; dts[tid] = dtv;
      }
    }
    {
      const int s = tid & 63, vg = tid >> 6;
      u32x4 vv = vvn;
#pragma unroll
      for (int j = 0; j < 4; j++) { VT[(vg * 8 + 2 * j) * KHLD + s] = (u16)(vv[j] & 0xffffu); VT[(vg * 8 + 2 * j + 1) * KHLD + s] = (u16)(vv[j] >> 16); }
    }
    __syncthreads();
#pragma unroll
    for (int dt2 = 0; dt2 < 2; dt2++) {
      const int d0 = (2 * w + dt2) * 16 + 4 * g;
      f32x4 e4 = (f32x4){1.f, 1.f, 1.f, 1.f};
      if (!SSM) e4 = *(const f32x4*)(em + d0);
#pragma unroll
      for (int vt = 0; vt < 2; vt++) {
        f32x4 sv = accS[dt2][vt] * e4;
        u32x2 pk; pk.x = pk2(sv[0], sv[1]); pk.y = pk2(sv[2], sv[3]);
        *(u32x2*)(ST + (16 * vt + c) * QLD + d0) = pk;
      }
    }
    if (!SSM) {
      const int d = tid & 127, half = tid >> 7;
      const float t0 = cum[d], t1 = cum[128 + d];
      rc63 = t1;
      if (half == 0) gam[d] = __expf(t0 + t1);
#pragma unroll
      for (int i = 0; i < 32; i++) KH[d * KHLD + half * 32 + i] = f2bf(kf[i] * __expf(rc63 - rc[i]));
    }
    if (SSM) {
      const int s = tid & 63, ng = tid >> 6;
      const float sc = __expf(cum[63] - cum[s]) * dts[s];
#pragma unroll
      for (int i = 0; i < 4; i++) {
        u32x4 kk = *(const u32x4*)(KT + s * QLD + ng * 32 + i * 8);
#pragma unroll
        for (int j = 0; j < 4; j++) {
          const int n = ng * 32 + i * 8 + 2 * j;
          KH[n * KHLD + s] = f2bf(__uint_as_float(kk[j] << 16) * sc);
          KH[(n + 1) * KHLD + s] = f2bf(__uint_as_float(kk[j] & 0xffff0000u) * sc);
        }
      }
    }
    __syncthreads();
    if (ch + 1 < SL / 64) CH_PREFETCH(ch + 1)
    {
      const int t = 16 * w + c;
      bf16x8 bq[4];
#pragma unroll
      for (int ks = 0; ks < 4; ks++) bq[ks] = *(const bf16x8*)(QT + t * QLD + ks * 32 + g * 8);
      f32x4 accp[4];
#pragma unroll
      for (int st = 0; st < 4; st++) {
        accp[st] = (f32x4){0.f, 0.f, 0.f, 0.f};
        if (st <= w) {
#pragma unroll
          for (int ks = 0; ks < 4; ks++) {
            bf16x8 ak = *(const bf16x8*)(KT + (16 * st + c) * QLD + ks * 32 + g * 8);
            accp[st] = __builtin_amdgcn_mfma_f32_16x16x32_bf16(ak, bq[ks], accp[st], 0, 0, 0);
          }
        }
      }
      float cumt = 0.f;
      if (SSM) cumt = cum[t];
#pragma unroll
      for (int st = 0; st < 4; st++)
#pragma unroll
        for (int r = 0; r < 4; r++) {
          const int s = 16 * st + 4 * g + r;
          float v = accp[st][r];
          if (SSM) v *= __expf(fminf(cumt - cum[s], 0.f)) * dts[s];
          accp[st][r] = (s <= t) ? v : 0.f;
        }
      bf16x8 bp[2];
#pragma unroll
      for (int a2 = 0; a2 < 2; a2++)
#pragma unroll
        for (int j = 0; j < 4; j++) { bp[a2][j] = (short)f2bf(accp[2 * a2][j]); bp[a2][4 + j] = (short)f2bf(accp[2 * a2 + 1][j]); }
      f32x4 acco[2], acco2[2];
#pragma unroll
      for (int vt = 0; vt < 2; vt++) {
        acco[vt] = (f32x4){0.f, 0.f, 0.f, 0.f}; acco2[vt] = (f32x4){0.f, 0.f, 0.f, 0.f};
#pragma unroll
        for (int a2 = 0; a2 < 2; a2++) {
          if (2 * a2 <= w) {
            const u16* vp = VT + (16 * vt + c) * KHLD + 32 * a2 + 4 * g;
            u32x2 lo = *(const u32x2*)vp, hi = *(const u32x2*)(vp + 16);
            u32x4 cmb; cmb.x = lo.x; cmb.y = lo.y; cmb.z = hi.x; cmb.w = hi.y;
            bf16x8 av = __builtin_bit_cast(bf16x8, cmb);
            acco[vt] = __builtin_amdgcn_mfma_f32_16x16x32_bf16(av, bp[a2], acco[vt], 0, 0, 0);
          }
        }
#pragma unroll
        for (int ks = 0; ks < 4; ks++) {
          bf16x8 as = *(const bf16x8*)(ST + (16 * vt + c) * QLD + ks * 32 + g * 8);
          if (SSM) acco2[vt] = __builtin_amdgcn_mfma_f32_16x16x32_bf16(as, bq[ks], acco2[vt], 0, 0, 0);
          else acco[vt] = __builtin_amdgcn_mfma_f32_16x16x32_bf16(as, bq[ks], acco[vt], 0, 0, 0);
        }
        f32x4 ov = acco[vt];
        if (SSM) ov += __expf(cumt) * acco2[vt];
        *(f32x4*)(a.o + (size_t)(r0 + t) * 4096 + 16 * vt + 4 * g) = ov;
      }
#pragma unroll
      for (int dt2 = 0; dt2 < 2; dt2++) {
        const int d0 = (2 * w + dt2) * 16;
        f32x4 gm;
        if (SSM) { float gs = __expf(cum[63]); gm = (f32x4){gs, gs, gs, gs}; }
        else gm = *(const f32x4*)(gam + d0 + 4 * g);
#pragma unroll
        for (int vt = 0; vt < 2; vt++) accS[dt2][vt] *= gm;
#pragma unroll
        for (int a2 = 0; a2 < 2; a2++) {
          bf16x8 ak = *(const bf16x8*)(KH + (d0 + c) * KHLD + 32 * a2 + 8 * g);
#pragma unroll
          for (int vt = 0; vt < 2; vt++) {
            bf16x8 bv = *(const bf16x8*)(VT + (16 * vt + c) * KHLD + 32 * a2 + 8 * g);
            accS[dt2][vt] = __builtin_amdgcn_mfma_f32_16x16x32_bf16(ak, bv, accS[dt2][vt], 0, 0, 0);
          }
        }
      }
    }
    __syncthreads();
  }
  if (save)
#pragma unroll
  for (int i = 0; i < 2; i++)
#pragma unroll
    for (int j = 0; j < 2; j++) *(f32x4*)(a.state + (size_t)((i * 2 + j) * 256 + tid) * 4) = accS[i][j];
}

__device__ __forceinline__ void chunk_dispatch(PP p, int layer, int ct, bool first, bool save, char* smem) {
  float* so = (float*)(p->ws + O_SO);
  ChunkArgs a;
  if (ct < 256) {
    const int vs = ct & 3, h = (ct >> 2) & 7, b = ct >> 5;
    const size_t ro = (size_t)b * SL * 1024 + h * 128;
    a.q = (const u16*)(p->ws + O_HQ) + ro; a.k = (const u16*)(p->ws + O_HK) + ro; a.v = (const u16*)(p->ws + O_HV) + ro + vs * 32;
    a.lf = (const float*)(p->ws + O_HW) + ro; a.o = so + (size_t)b * SL * 4096 + 1024 + h * 128 + vs * 32;
    a.state = (float*)(p->ws + O_STHG) + (size_t)ct * 4096; a.ld = 1024; a.ldlf = 1024; a.expA = 0.f;
    chunk_task<false>(a, first, save, smem);
  } else {
    const int t2 = ct - 256, vs = t2 & 1, hd = (t2 >> 1) & 31, b = t2 >> 6, g = hd >> 3;
    const u16* x2 = (const u16*)(p->ws + O_SX2) + (size_t)b * SL * 3072;
    a.q = x2 + 2560 + g * 128; a.k = x2 + 2048 + g * 128; a.v = x2 + hd * 64 + vs * 32;
    a.lf = (const float*)(p->ws + O_SDT) + (size_t)b * SL * 32 + hd; a.o = so + (size_t)b * SL * 4096 + 2048 + hd * 64 + vs * 32;
    a.state = (float*)(p->ws + O_STSS) + (size_t)t2 * 4096; a.ld = 3072; a.ldlf = 32; a.expA = __expf(p->in[19][layer * 32 + hd]);
    chunk_task<true>(a, first, save, smem);
  }
}
__device__ __forceinline__ void rwkv_dispatch(PP p, int task, bool first, bool save, char* smem) {
  float* so = (float*)(p->ws + O_SO);
  ScanArgs a;
  const int h = task & 15, b = task >> 4;
  const size_t ro = (size_t)b * SL * 1024 + h * 64;
  a.pr = (const u16*)(p->ws + O_PR) + ro; a.pk = (const u16*)(p->ws + O_PK) + ro; a.pka = (const u16*)(p->ws + O_PKA) + ro; a.pkb = (const u16*)(p->ws + O_PKB) + ro;
  a.pv = (const u16*)(p->ws + O_PV) + ro; a.pw = (const float*)(p->ws + O_RWW) + ro; a.pvs = nullptr;
  a.po = so + (size_t)b * SL * 4096 + h * 64; a.state = (float*)(p->ws + O_STRW) + (size_t)(b * 16 + h) * 4096;
  a.sr = a.sk = a.sab = a.sv = a.sw = 1024; a.svs = 0; a.so = 4096;
  scan_task<64, true, false, false, 4>(a, first, save, smem);
}
template <int BR> __device__ __forceinline__ void merge_tile(PP p, int layer, int seg, int t, char* smem);
__device__ __forceinline__ void merge_item(PP p, int layer, int seg, int t, char* smem);
__device__ __forceinline__ void ph_scan(PP p, int layer, int seg, int bid, int nb, char* smem, volatile LAS unsigned* bw) {
  const bool first = (seg == 0);
  unsigned* ctr = (unsigned*)(p->ws + O_BAR) + 3520;
  const unsigned base = (unsigned)(layer * NSEG + seg) * (unsigned)(1024 + nb);
  if (bid < 128) { rwkv_dispatch(p, bid, first, true, smem); __syncthreads(); }
#pragma unroll 1
  for (;;) {
    if (tidx() == 0) *bw = __hip_atomic_fetch_add(ctr, 1u, __ATOMIC_RELAXED, __HIP_MEMORY_SCOPE_AGENT);
    __syncthreads();
    const unsigned it = *bw - base;
    __syncthreads();
    if (it >= 1024u) break;
    if (it < 256u) { if (seg > 0) merge_item(p, layer, seg - 1, (int)it, smem); }
    else chunk_dispatch(p, layer, (int)it - 256, first, true, smem);
    __syncthreads();
  }
}

__device__ __forceinline__ void ph_post(PP p, int layer, int bid, int nb) {
  const float* so = (const float*)(p->ws + O_SO); u16* y = (u16*)(p->ws + O_Y);
  const int lane = tidx() & 63, wv = tidx() >> 6;
  {
    u16* urw = (u16*)(p->ws + O_URW);
    const int gt = bid * NTHR + tidx(), gs = nb * NTHR;
    for (int idx = gt; idx < 8 * 3456; idx += gs) { int b = idx / 3456, c = idx - b * 3456; urw[(size_t)(b * 513) * 3456 + c] = urw[(size_t)(b * 513 + 512) * 3456 + c]; }
  }
  const u16* pv = (const u16*)(p->ws + O_PV); const u16* rwg = (const u16*)(p->ws + O_RWG); const float* bonus = (const float*)(p->ws + O_BONUS);
  const float* gnw = p->in[12] + layer * 1024; const float* gnb = p->in[13] + layer * 1024;
  const u16* hg = (const u16*)(p->ws + O_HG); const float* hgn = p->in[15] + layer * 1024;
  const u16* sx2 = (const u16*)(p->ws + O_SX2); const u16* sz = (const u16*)(p->ws + O_SZ);
  const float* dsk = p->in[20] + layer * 32; const float* sgn = p->in[21] + layer * 2048;
#pragma unroll 1
  for (int task = bid * 4 + wv; task < RS * 12; task += nb * 4) {
    const int r = task / 12, s = task - r * 12;
    if (s < 4) {
      const int col = s * 256 + lane * 4;
      f32x4 o = *(const f32x4*)(so + (size_t)r * 4096 + col);
      const float mean = red16(o[0] + o[1] + o[2] + o[3]) * (1.f / 64.f);
      f32x4 d = o - mean;
      const float var = red16(d[0] * d[0] + d[1] * d[1] + d[2] * d[2] + d[3] * d[3]) * (1.f / 64.f);
      f32x4 on = d * rsqrtf(var + 64e-5f) * *(const f32x4*)(gnw + col) + *(const f32x4*)(gnb + col);
      on += bonus[r * 16 + (col >> 6)] * cvt4(*(const u32x2*)(pv + (size_t)r * 1024 + col));
      on *= cvt4(*(const u32x2*)(rwg + (size_t)r * 1024 + col));
      *(u32x2*)(y + (size_t)r * 4096 + col) = pack4(on[0], on[1], on[2], on[3]);
    } else if (s < 8) {
      const int c = (s - 4) * 256 + lane * 4;
      f32x4 o = *(const f32x4*)(so + (size_t)r * 4096 + 1024 + c);
      float ss = red16(o[0] * o[0] + o[1] * o[1] + o[2] * o[2] + o[3] * o[3]);
      ss += __shfl_xor(ss, 16);
      const float rstd = rsqrtf(ss * (1.f / 128.f) + 1e-5f);
      f32x4 on = o * rstd * *(const f32x4*)(hgn + c) * cvt4(*(const u32x2*)(hg + (size_t)r * 1024 + c));
      *(u32x2*)(y + (size_t)r * 4096 + 1024 + c) = pack4(on[0], on[1], on[2], on[3]);
    } else {
      const int g = s - 8, ch = g * 512 + lane * 8;
      f32x4 o0 = *(const f32x4*)(so + (size_t)r * 4096 + 2048 + ch), o1 = *(const f32x4*)(so + (size_t)r * 4096 + 2048 + ch + 4);
      u32x4 xr = *(const u32x4*)(sx2 + (size_t)r * 3072 + ch), zr = *(const u32x4*)(sz + (size_t)r * 2048 + ch);
      u32x2 t0; t0.x = xr.x; t0.y = xr.y; u32x2 t1; t1.x = xr.z; t1.y = xr.w;
      u32x2 z0; z0.x = zr.x; z0.y = zr.y; u32x2 z1; z1.x = zr.z; z1.y = zr.w;
      const float dk = dsk[ch >> 6];
      f32x4 y0 = (o0 + dk * cvt4(t0)) * cvt4(z0), y1 = (o1 + dk * cvt4(t1)) * cvt4(z1);
      float ss = y0[0] * y0[0] + y0[1] * y0[1] + y0[2] * y0[2] + y0[3] * y0[3] + y1[0] * y1[0] + y1[1] * y1[1] + y1[2] * y1[2] + y1[3] * y1[3];
      ss = red16(ss); ss += __shfl_xor(ss, 16); ss += __shfl_xor(ss, 32);
      const float rstd = rsqrtf(ss * (1.f / 512.f) + 1e-5f);
      y0 = y0 * rstd * *(const f32x4*)(sgn + ch); y1 = y1 * rstd * *(const f32x4*)(sgn + ch + 4);
      u32x4 ov; ov.x = pk2(y0[0], y0[1]); ov.y = pk2(y0[2], y0[3]); ov.z = pk2(y1[0], y1[1]); ov.w = pk2(y1[2], y1[3]);
      *(u32x4*)(y + (size_t)r * 4096 + 2048 + ch) = ov;
    }
  }
}

#define MT_ROW(row) ((size_t)(((row) >> 9) * 515 + 3 + ((row) & 511)) * 1536)
template <int BR>
__device__ __forceinline__ void merge_tile(PP p, int layer, int seg, int t, char* smem) {
  const u16* W = (const u16*)(p->ws + O_W) + (size_t)layer * W_LAYER + WBR;
  const u16* Y = (const u16*)(p->ws + O_Y); const u16* gp = (const u16*)(p->ws + ((seg & 1) ? O_GATES2 : O_GATES)) + BR * 1024; u16* mg = (u16*)(p->ws + O_MERGED);
  float* mt = (float*)(p->ws + O_SXBC);
  constexpr int k0 = BR * 1024, nkt = BR == 2 ? 64 : 32;
  const int m0 = (t & 31) * 128, n0 = (t >> 5) * 128;
  f32x4 acc[4][4]; ACC_ZERO(acc);
  gemm_kloop(Y + (size_t)m0 * 4096 + k0, 4096, W + (size_t)n0 * 4096 + k0, 4096, nkt, acc, smem);
  EPI_LOOP2({ l0[j] = cvt4(*(const u32x2*)(gp + (size_t)row * 3072 + col)); if (BR > 0) l1[j] = *(const f32x4*)(mt + MT_ROW(row) + col); else l1[j] = f4z(); },
            { const f32x4 gsum = l1[j] + l0[j] * v; if (BR < 2) *(f32x4*)(mt + MT_ROW(row) + col) = gsum; else *(u32x2*)(mg + (size_t)row * 1024 + col) = pack4v(gsum); })
}
__device__ __forceinline__ void merge_item(PP p, int layer, int seg, int t, char* smem) {
  merge_tile<0>(p, layer, seg, t, smem);
  merge_tile<1>(p, layer, seg, t, smem);
  merge_tile<2>(p, layer, seg, t, smem);
}
__device__ __forceinline__ void ph_merge(PP p, int layer, int seg, int bid, int nb, char* smem) {
#pragma unroll 1
  for (int t = bid; t < 256; t += nb) merge_item(p, layer, seg, t, smem);
}
__device__ __forceinline__ void ph_out(PP p, int layer, int seg, int bid, int nb, char* smem) {
  const u16* W = (const u16*)(p->ws + O_W) + (size_t)layer * W_LAYER + WOUT;
  const u16* mg = (const u16*)(p->ws + O_MERGED);
  const float* xs = layer == 0 ? p->in[0] : p->out;
  for (int t = bid; t < 256; t += nb) {
    const int m0 = (t & 31) * 128, n0 = (t >> 5) * 128;
    f32x4 acc[4][4]; ACC_ZERO(acc);
    gemm_kloop(mg + (size_t)m0 * 1024, 1024, W + (size_t)n0 * 1024, 1024, 32, acc, smem);
    EPI_LOOP2({ size_t gr = (size_t)(row >> 9) * SEQ + seg * SL + (row & 511); l0[j] = *(const f32x4*)(xs + gr * 1024 + col); },
              { size_t gr = (size_t)(row >> 9) * SEQ + seg * SL + (row & 511); *(f32x4*)(p->out + gr * 1024 + col) = l0[j] + v; })
  }
}
__device__ __forceinline__ void ph_ffi(PP p, int layer, int bid, int nb, char* smem) {
  const u16* W = (const u16*)(p->ws + O_W) + (size_t)layer * W_LAYER + WFFI;
  const u16* H2 = (const u16*)(p->ws + O_H2); u16* hid = (u16*)(p->ws + O_HID);
  for (int t = bid; t < 128 * 44; t += nb) {
    const int m0 = (t & 127) * 256, n0 = (t >> 7) * 128;
    f32x4 acc[8][4]; ACC_ZERO(acc);
    gemm_kloop(H2 + (size_t)m0 * 1024, 1024, W + (size_t)n0 * 1024, 1024, 32, acc, smem);
    const int lane = tidx() & 63, wave = tidx() >> 6, wm = wave >> 1, wn = wave & 1;
#pragma unroll
    for (int i = 0; i < 8; i++)
#pragma unroll
      for (int j = 0; j < 4; j += 2) {
        const int row = m0 + wm * 128 + i * 16 + (lane & 15);
        const int ng = n0 + wn * 64 + j * 16 + (lane >> 4) * 4;
        const int hc = (ng >> 5) * 16 + (ng & 15);
        const f32x4 g = acc[i][j], u = acc[i][j + 1];
        *(u32x2*)(hid + (size_t)row * 2816 + hc) = pack4v(g * sigm4(g) * u);
      }
  }
}
__device__ __forceinline__ void ph_ffo(PP p, int layer, int bid, int nb, char* smem) {
  const u16* W = (const u16*)(p->ws + O_W) + (size_t)layer * W_LAYER + WFFO;
  const u16* hid = (const u16*)(p->ws + O_HID);
  for (int t = bid; t < 128 * 8; t += nb) {
    const int m0 = (t & 127) * 256, n0 = (t >> 7) * 128;
    f32x4 acc[8][4]; ACC_ZERO(acc);
    gemm_kloop(hid + (size_t)m0 * 2816, 2816, W + (size_t)n0 * 2816, 2816, 88, acc, smem);
    float* outp = p->out;
    EPI_LOOP2({ l0[j] = *(const f32x4*)(outp + (size_t)row * 1024 + col); }, { *(f32x4*)(outp + (size_t)row * 1024 + col) = l0[j] + v; })
  }
}

__device__ __forceinline__ void ph_norm1(PP p, int layer, int seg, int bid, int nb) {
  if (seg == 0) {
    u16* urw = (u16*)(p->ws + O_URW); u16* sxbc = (u16*)(p->ws + O_SXBC);
    const int gt = bid * NTHR + tidx(), gs = nb * NTHR;
    for (int idx = gt; idx < 8 * 3456; idx += gs) { int b = idx / 3456, c = idx - b * 3456; urw[(size_t)(b * 513) * 3456 + c] = 0; }
    for (int idx = gt; idx < 8 * 9216; idx += gs) { int b = idx / 9216, c = idx - b * 9216; sxbc[(size_t)(b * 515) * 3072 + c] = 0; }
  }
  rmsnorm_rows(layer == 0 ? p->in[0] : p->out, p->in[1] + layer * 1024, (u16*)(p->ws + O_H), nullptr, RS, 0, seg, bid, nb);
}

#define XB_TMO      128
#define XB_XCNT(j)  (256  + 64 * (j))
#define XB_XSUB(j)  (1280 + 64 * (j))
#define XB_XGEN(j)  (2304 + 64 * (j))
#define XB_TOP      3328
#define XB_TOPGEN   3392
#define XCD_BAR_WORDS 3456
#define XB_SPIN_CAP (1u << 22)
__device__ __forceinline__ unsigned xb_ld(unsigned* p)              { return __hip_atomic_load(p, __ATOMIC_RELAXED, __HIP_MEMORY_SCOPE_AGENT); }
__device__ __forceinline__ unsigned xb_add(unsigned* p, unsigned v) { return __hip_atomic_fetch_add(p, v, __ATOMIC_RELAXED, __HIP_MEMORY_SCOPE_AGENT); }
__device__ __forceinline__ unsigned xb_xcc_id() { return (unsigned)__builtin_amdgcn_s_getreg((3 << 11) | 20) & 0xFu; }
#define XB_SPIN(cond, bar) do { unsigned _sp = 0; while (cond) { __builtin_amdgcn_s_sleep(1); \
    if ((++_sp & 255u) == 0u) { if (xb_ld(&(bar)[XB_TMO])) break; if (_sp > XB_SPIN_CAP) { atomicAdd(&(bar)[XB_TMO], 1u); break; } } } } while (0)
struct XcdBarrier { unsigned* bar; unsigned x; volatile LAS unsigned* st; };
__device__ __forceinline__ XcdBarrier xcd_barrier_post(unsigned* bar, volatile LAS unsigned* st) {
  XcdBarrier b; b.bar = bar; b.x = xb_xcc_id(); b.st = st;
  if (threadIdx.x == 0) (void)xb_add(&bar[XB_XCNT(b.x)], 1u);
  return b;
}
__device__ __forceinline__ void xcd_barrier_complete(unsigned* bar, unsigned x, unsigned& nloc, unsigned& nx) {
  const unsigned G = gridDim.x * gridDim.y * gridDim.z;
  unsigned sum, cnt, mine, sp = 0u;
  for (;;) {
    sum = 0u; cnt = 0u; mine = 0u;
#pragma unroll
    for (unsigned j = 0; j < 16; ++j) { const unsigned c = xb_ld(&bar[XB_XCNT(j)]); sum += c; cnt += (c > 0u) ? 1u : 0u; mine = (j == x) ? c : mine; }
    if (sum == G) break;
    __builtin_amdgcn_s_sleep(1);
    if ((++sp & 255u) == 0u) { if (xb_ld(&bar[XB_TMO])) break; if (sp > XB_SPIN_CAP) { atomicAdd(&bar[XB_TMO], 1u); break; } }
  }
  nloc = mine > 0u ? mine : 1u; nx = cnt > 0u ? cnt : 1u;
}
__device__ __forceinline__ void xcd_barrier(const XcdBarrier& b) {
  asm volatile("s_waitcnt vmcnt(0)" ::: "memory");
  __syncthreads();
  if (threadIdx.x == 0) {
    unsigned* bar = b.bar;
    __builtin_amdgcn_s_waitcnt(0);
    unsigned nloc = b.st[0], nx = b.st[1];
    if (nloc == 0u) { xcd_barrier_complete(bar, b.x, nloc, nx); b.st[0] = nloc; b.st[1] = nx; }
    const unsigned old = xb_add(&bar[XB_XSUB(b.x)], 1u);
    const unsigned gen = old / nloc;
    if (old + 1u == (gen + 1u) * nloc) {
      __builtin_amdgcn_fence(__ATOMIC_RELEASE, "agent");
      asm volatile("s_waitcnt vmcnt(0)" ::: "memory");
      const unsigned og = xb_add(&bar[XB_TOP], 1u);
      const unsigned tg = og / nx;
      if (og + 1u == (tg + 1u) * nx) xb_add(&bar[XB_TOPGEN], 1u);
      else XB_SPIN(xb_ld(&bar[XB_TOPGEN]) == tg, bar);
      __builtin_amdgcn_fence(__ATOMIC_ACQUIRE, "agent");
      xb_add(&bar[XB_XGEN(b.x)], 1u);
      asm volatile("s_waitcnt vmcnt(0)" ::: "memory");
    } else {
      XB_SPIN(xb_ld(&bar[XB_XGEN(b.x)]) == gen, bar);
      __builtin_amdgcn_fence(__ATOMIC_ACQUIRE, "agent");
      asm volatile("s_waitcnt vmcnt(0)" ::: "memory");
    }
  }
  __syncthreads();
}

#define SMEM_BYTES 73728
#ifndef SCANPROBE
#define SCANPROBE 0
#endif
#ifndef PHMASK
#define PHMASK 0xFFFF
#endif
#ifndef DBLMASK
#define DBLMASK 0
#endif
#define RUN(idx, call) { if ((PHMASK >> (idx)) & 1) { if ((DBLMASK >> (idx)) & 1) { call; __syncthreads(); } call; } }
__global__ void __launch_bounds__(NTHR, 2) mega(Params p_) {
  __shared__ __attribute__((aligned(1024))) char smem[SMEM_BYTES + 16];
  uint4& xb_words = *(uint4*)(smem + SMEM_BYTES);
  cg::grid_group grid = cg::this_grid();
  if (threadIdx.x == 0) xb_words = make_uint4(0u, 0u, 0u, 0u);
  __syncthreads();
  XcdBarrier xb = xcd_barrier_post((unsigned*)(p_.ws + O_BAR), (volatile LAS unsigned*)&xb_words);
  {
    PP p = (PP)__builtin_amdgcn_kernarg_segment_ptr();
    RUN(0, ph_wconv(p, blockIdx.x, gridDim.x, smem))
  }
  if (p_.out == nullptr) grid.sync();
  xcd_barrier(xb);
#pragma unroll 1
  for (int pc = 0; pc < 151; pc++) {
    PP p = (PP)__builtin_amdgcn_kernarg_segment_ptr();
    asm volatile("" : "+s"(p));
    int bid = blockIdx.x, nb = gridDim.x;
    asm volatile("" : "+s"(bid), "+s"(nb));
    const int l = pc / 75, q = pc - l * 75;
    bool did = true;
    if (pc == 150) {
      RUN(13, rmsnorm_rows(p->out, p->in[27], nullptr, p->out, TTOK, 2, 0, bid, nb))
      did = false;
    } else if (q >= 72) {
      if (q == 72) RUN(10, rmsnorm_rows(p->out, p->in[24] + l * 1024, (u16*)(p->ws + O_H2), nullptr, TTOK, 1, 0, bid, nb))
      else if (q == 73) RUN(11, ph_ffi(p, l, bid, nb, smem))
      else RUN(12, ph_ffo(p, l, bid, nb, smem))
    } else {
      const int sg = q / 9, st = q - sg * 9;
      switch (st) {
        case 0: if (sg == 0) RUN(1, ph_norm1(p, l, 0, bid, nb)) else did = false; break;
        case 1: RUN(2, ph_inproj(p, l, sg, bid, nb, smem)) break;
        case 2: RUN(3, ph_elem(p, l, sg, bid, nb)) if (sg + 1 < NSEG) RUN(1, ph_norm1(p, l, sg + 1, bid, nb)) break;
        case 3: RUN(4, ph_lora(p, l, bid, nb, smem)) break;
        case 4: RUN(5, ph_rprep(p, l, bid, nb)) break;
        case 5: ph_scan(p, l, sg, bid, nb, smem, ((volatile LAS unsigned*)&xb_words) + 2); break;
        case 6: RUN(7, ph_post(p, l, bid, nb)) if (sg > 0) RUN(9, ph_out(p, l, sg - 1, bid, nb, smem)) break;
        case 7: if (sg == NSEG - 1) RUN(8, ph_merge(p, l, sg, bid, nb, smem)) else did = false; break;
        default: if (sg == NSEG - 1) RUN(9, ph_out(p, l, sg, bid, nb, smem)) else did = false; break;
      }
    }
    if (did) xcd_barrier(xb);
  }
}

extern "C" void kernel_launch(void* const* d_in, const int* in_sizes, int n_in, void* d_out, int out_size, void* d_ws,
                              size_t ws_size, hipStream_t stream) {
  Params p{};
  for (int i = 0; i < 28; i++) p.in[i] = (const float*)d_in[i];
  p.out = (float*)d_out; p.ws = (char*)d_ws;
  static int grid_blocks = 0;
  if (!grid_blocks) {
    int dev = 0, cus = 0, per_cu = 0;
    hipGetDevice(&dev);
    hipDeviceGetAttribute(&cus, hipDeviceAttributeMultiprocessorCount, dev);
    hipOccupancyMaxActiveBlocksPerMultiprocessor(&per_cu, mega, NTHR, 0);
    if (per_cu > 2) per_cu = 2;
    if (per_cu < 1) per_cu = 1;
    grid_blocks = cus * per_cu;
  }
  hipMemsetAsync((char*)d_ws + O_BAR, 0, 16384, stream);
  void* args[] = {&p};
  hipError_t e = hipLaunchCooperativeKernel((void*)mega, dim3(grid_blocks), dim3(NTHR), args, 0, stream);
  if (e != hipSuccess) fprintf(stderr, "cooperative launch failed: %s (grid %d)\n", hipGetErrorString(e), grid_blocks);
}
```

```cpp
#include <hip/hip_runtime.h>
#include <hip/hip_cooperative_groups.h>
#include <stdint.h>
#include <stdio.h>
namespace cg = cooperative_groups;

typedef unsigned short u16;
using bf16x8 = __attribute__((ext_vector_type(8))) short;
using f32x4  = __attribute__((ext_vector_type(4))) float;
using u32x4 = __attribute__((ext_vector_type(4))) unsigned int;
using u32x2 = __attribute__((ext_vector_type(2))) unsigned int;

#define DM 1024
#define SEQ 4096
#define TTOK 32768
#define SL 512
#define NSEG 8
#define RS 4096
#define NTHR 256
#ifndef SCANPROBE
#define SCANPROBE 0
#endif

constexpr size_t al(size_t x) { return (x + 255) & ~(size_t)255; }
constexpr size_t WIN = 0;
constexpr size_t WWUP = WIN + (size_t)15872 * 1024;
constexpr size_t WAUP = WWUP + 65536;
constexpr size_t WGUP = WAUP + 65536;
constexpr size_t WBR = WGUP + 196608;
constexpr size_t WOUT = WBR + 4194304;
constexpr size_t WFFI = WOUT + 1048576;
constexpr size_t WFFO = WFFI + 5767168;
constexpr size_t W_LAYER = WFFO + 2883584;
constexpr size_t O_W = 0;
constexpr size_t O_H = al(O_W + 2 * W_LAYER * 2);
constexpr size_t O_URW = al(O_H + (size_t)RS * 1024 * 2);
constexpr size_t O_HQ = al(O_URW + (size_t)8 * 513 * 3456 * 2);
constexpr size_t O_HV = al(O_HQ + (size_t)RS * 1024 * 2);
constexpr size_t O_HG = al(O_HV + (size_t)RS * 1024 * 2);
constexpr size_t O_HW = al(O_HG + (size_t)RS * 1024 * 2);
constexpr size_t O_SZ = al(O_HW + (size_t)RS * 1024 * 4);
constexpr size_t O_SXBC = al(O_SZ + (size_t)RS * 2048 * 2);
constexpr size_t O_SDT = al(O_SXBC + (size_t)8 * 515 * 3072 * 2);
constexpr size_t O_SWD = al(O_SDT + (size_t)RS * 32 * 4);
constexpr size_t O_GATES = al(O_SWD + (size_t)RS * 32 * 4);
constexpr size_t O_LAW = al(O_GATES + (size_t)RS * 3072 * 2);
constexpr size_t O_LAA = al(O_LAW + (size_t)RS * 64 * 2);
constexpr size_t O_LAG = al(O_LAA + (size_t)RS * 64 * 2);
constexpr size_t O_SX2 = al(O_LAG + (size_t)RS * 192 * 2);
constexpr size_t O_RWW = al(O_SX2 + (size_t)RS * 3072 * 2);
constexpr size_t O_RWA = al(O_RWW + (size_t)RS * 1024 * 4);
constexpr size_t O_RWG = al(O_RWA + (size_t)RS * 1024 * 2);
constexpr size_t O_PR = al(O_RWG + (size_t)RS * 1024 * 2);
constexpr size_t O_PK = al(O_PR + (size_t)RS * 1024 * 2);
constexpr size_t O_PV = al(O_PK + (size_t)RS * 1024 * 2);
constexpr size_t O_PKA = al(O_PV + (size_t)RS * 1024 * 2);
constexpr size_t O_PKB = al(O_PKA + (size_t)RS * 1024 * 2);
constexpr size_t O_BONUS = al(O_PKB + (size_t)RS * 1024 * 2);
constexpr size_t O_SO = al(O_BONUS + (size_t)RS * 16 * 4);
constexpr size_t O_Y = al(O_SO + (size_t)RS * 4096 * 4);
constexpr size_t O_MERGED = al(O_Y + (size_t)RS * 4096 * 2);
constexpr size_t O_STRW = al(O_MERGED + (size_t)RS * 1024 * 2);
constexpr size_t O_STHG = al(O_STRW + (size_t)128 * 64 * 64 * 4);
constexpr size_t O_STSS = al(O_STHG + (size_t)64 * 128 * 128 * 4);
constexpr size_t O_END = al(O_STSS + (size_t)256 * 64 * 128 * 4);
constexpr size_t O_H2 = O_H;
constexpr size_t O_HID = al(O_H2 + (size_t)TTOK * 1024 * 2);
constexpr size_t O_END2 = al(O_HID + (size_t)TTOK * 2816 * 2);
constexpr size_t O_HK = O_END;
constexpr size_t O_GATES2 = al(O_HK + (size_t)RS * 1024 * 2);
constexpr size_t O_BAR = al(O_GATES2 + (size_t)RS * 3072 * 2);
static_assert(O_BAR + 16384 <= (size_t)536870912, "ws overflow");
static_assert(O_END2 <= (size_t)536870912, "ws overflow2");

#define LAS __attribute__((address_space(3)))
struct Params { const float* in[28]; float* out; char* ws; };
typedef const __attribute__((address_space(4))) Params* PP;

enum { PH_WCONV = 0, PH_NORM1, PH_INPROJ, PH_ELEM, PH_LORA, PH_RPREP, PH_SCAN, PH_POST, PH_MERGE, PH_OUT,
       PH_NORM2, PH_FFI, PH_FFO, PH_FINAL };

__device__ __forceinline__ float bf2f(u16 u) { return __uint_as_float(((unsigned)u) << 16); }
__device__ __forceinline__ u16 f2bf(float f) { unsigned u = __float_as_uint(f); u += 0x7fffu + ((u >> 16) & 1u); return (u16)(u >> 16); }
__device__ __forceinline__ float sigm(float x) { return 1.f / (1.f + __expf(-x)); }
__device__ __forceinline__ float wave_sum(float x) {
#pragma unroll
  for (int o = 32; o; o >>= 1) x += __shfl_xor(x, o);
  return x;
}
__device__ __forceinline__ f32x4 cvt4(u32x2 v) {
  f32x4 r; r.x = __uint_as_float(v.x << 16); r.y = __uint_as_float(v.x & 0xffff0000u);
  r.z = __uint_as_float(v.y << 16); r.w = __uint_as_float(v.y & 0xffff0000u); return r;
}
template <int CTRL> __device__ __forceinline__ float dppf(float x) {
  return __int_as_float(__builtin_amdgcn_update_dpp(0, __float_as_int(x), CTRL, 0xF, 0xF, true));
}
__device__ __forceinline__ float red16(float x) {
  x += dppf<0xB1>(x); x += dppf<0x4E>(x); x += dppf<0x141>(x); x += dppf<0x140>(x); return x;
}
__device__ __forceinline__ unsigned pk2(float a, float b) { return (unsigned)f2bf(a) | ((unsigned)f2bf(b) << 16); }
__device__ __forceinline__ u32x2 pack4(float a, float b, float c, float d) {
  u32x2 r; r.x = (unsigned)f2bf(a) | ((unsigned)f2bf(b) << 16); r.y = (unsigned)f2bf(c) | ((unsigned)f2bf(d) << 16); return r;
}
__device__ __forceinline__ f32x4 f4z() { return (f32x4){0.f, 0.f, 0.f, 0.f}; }
__device__ __forceinline__ f32x4 sigm4(f32x4 x) { f32x4 r; r[0] = sigm(x[0]); r[1] = sigm(x[1]); r[2] = sigm(x[2]); r[3] = sigm(x[3]); return r; }
__device__ __forceinline__ u32x2 pack4v(f32x4 x) { return pack4(x[0], x[1], x[2], x[3]); }
__device__ __forceinline__ float red4(float x) { x += dppf<0xB1>(x); x += dppf<0x4E>(x); return x; }
__device__ __forceinline__ float red8(float x) {
  x += dppf<0xB1>(x); x += dppf<0x4E>(x); x += dppf<0x141>(x); return x;
}

__device__ __forceinline__ int tidx() { int t = threadIdx.x; asm volatile("" : "+v"(t)); return t; }
__device__ __forceinline__ int remap_col(int kind, int n, int nsrc) {
  if (kind == 0) return n < nsrc ? n : -1;
  if (kind == 1) {
    if (n < 3456) return n < 3360 ? n : -1;
    if (n < 7552) return 3360 + (n - 3456);
    if (n < 12800) { int c = n - 7552; return c < 5152 ? 7456 + c : -1; }
    return 12608 + (n - 12800);
  }
  int blk = n >> 5, w = n & 31;
  return w < 16 ? blk * 16 + w : 2816 + blk * 16 + (w - 16);
}
__device__ __forceinline__ void tconv(const float* __restrict__ src, int K, int Nsrc, u16* __restrict__ dst, int Kpad, int Npad,
                      int kind, int bid, int nb, char* smem) {
  float(*tile)[65] = (float(*)[65])smem;
  const int tn = Npad >> 6, tk = Kpad >> 6, tid = tidx();
  for (int t = bid; t < tn * tk; t += nb) {
    const int n0 = (t % tn) << 6, k0 = (t / tn) << 6;
    const int nn = tid & 63, c = remap_col(kind, n0 + nn, Nsrc);
#pragma unroll
    for (int i = 0; i < 16; i++) {
      int kk = (tid >> 6) + 4 * i, k = k0 + kk;
      tile[kk][nn] = (k < K && c >= 0) ? src[(size_t)k * Nsrc + c] : 0.f;
    }
    __syncthreads();
#pragma unroll
    for (int i = 0; i < 16; i++) {
      int n2 = (tid >> 6) + 4 * i, kk = tid & 63;
      dst[(size_t)(n0 + n2) * Kpad + k0 + kk] = f2bf(tile[kk][n2]);
    }
    __syncthreads();
  }
}
__device__ __forceinline__ void ph_wconv(PP p, int bid, int nb, char* smem) {
  for (int l = 0; l < 2; l++) {
    u16* W = (u16*)(p->ws + O_W) + (size_t)l * W_LAYER;
    tconv(p->in[2] + (size_t)l * 1024 * 15680, 1024, 15680, W + WIN, 1024, 15872, 1, bid, nb, smem);
    tconv(p->in[5] + (size_t)l * 64 * 1024, 64, 1024, W + WWUP, 64, 1024, 0, bid, nb, smem);
    tconv(p->in[7] + (size_t)l * 64 * 1024, 64, 1024, W + WAUP, 64, 1024, 0, bid, nb, smem);
    tconv(p->in[8] + (size_t)l * 160 * 1024, 160, 1024, W + WGUP, 192, 1024, 0, bid, nb, smem);
    tconv(p->in[22] + (size_t)l * 4096 * 1024, 4096, 1024, W + WBR, 4096, 1024, 0, bid, nb, smem);
    tconv(p->in[23] + (size_t)l * 1024 * 1024, 1024, 1024, W + WOUT, 1024, 1024, 0, bid, nb, smem);
    tconv(p->in[25] + (size_t)l * 1024 * 5632, 1024, 5632, W + WFFI, 1024, 5632, 2, bid, nb, smem);
    tconv(p->in[26] + (size_t)l * 2816 * 1024, 2816, 1024, W + WFFO, 2816, 1024, 0, bid, nb, smem);
  }
}

__device__ __forceinline__ void rmsnorm_rows(const float* __restrict__ xs, const float* __restrict__ gain, u16* dst, float* dstf,
                             int nrows, int mode, int seg, int bid, int nb) {
  const int lane = tidx() & 63, wv = tidx() >> 6;
  for (int r = bid * 4 + wv; r < nrows; r += nb * 4) {
    size_t srow = (mode == 0) ? ((size_t)(r >> 9) * SEQ + seg * SL + (r & 511)) : (size_t)r;
    const float4* xp = (const float4*)(xs + srow * DM);
    float4 v[4]; float ss = 0.f;
#pragma unroll
    for (int i = 0; i < 4; i++) { v[i] = xp[lane + 64 * i]; ss += v[i].x * v[i].x + v[i].y * v[i].y + v[i].z * v[i].z + v[i].w * v[i].w; }
    ss = wave_sum(ss);
    float rstd = rsqrtf(ss * (1.f / DM) + 1e-5f);
#pragma unroll
    for (int i = 0; i < 4; i++) {
      float4 g = ((const float4*)gain)[lane + 64 * i];
      float a = v[i].x * rstd * g.x, b = v[i].y * rstd * g.y, c = v[i].z * rstd * g.z, d = v[i].w * rstd * g.w;
      if (mode == 2) { float4 o; o.x = a; o.y = b; o.z = c; o.w = d; ((float4*)(dstf + (size_t)r * DM))[lane + 64 * i] = o; }
      else { uint2 o; o.x = (unsigned)f2bf(a) | ((unsigned)f2bf(b) << 16); o.y = (unsigned)f2bf(c) | ((unsigned)f2bf(d) << 16);
             ((uint2*)(dst + (size_t)r * DM))[lane + 64 * i] = o; }
    }
  }
}

#define WAIT_V(n) asm volatile("s_waitcnt vmcnt(%0)" ::"n"(n) : "memory")
#define WAIT_L(n) asm volatile("s_waitcnt lgkmcnt(%0)" ::"n"(n) : "memory")
#define RAW_BARRIER() do { WAIT_L(0); __builtin_amdgcn_s_barrier(); } while (0)
template <int MI>
__device__ __forceinline__ void gemm_kloop(const u16* __restrict__ A, int lda, const u16* __restrict__ B, int ldb, int nkt,
                                           f32x4 (&acc)[MI][4], char* smem) {
  constexpr int NA = MI / 2, ABYTES = MI * 32 * 64, STB = ABYTES + 8192, NST = (MI == 4) ? 4 : 3, LPT = NA + 2;
  const int tid = tidx(), lane = tid & 63, wave = tid >> 6, wm = wave >> 1, wn = wave & 1;
  const int wu = __builtin_amdgcn_readfirstlane(wave);
  const u16* ga[NA]; const u16* gb[2];
#pragma unroll
  for (int i = 0; i < NA; i++) {
    const int r = (wu * NA + i) * 16 + (lane >> 2), kc = (lane & 3) ^ ((r >> 2) & 3);
    ga[i] = A + (size_t)r * lda + kc * 8;
  }
#pragma unroll
  for (int i = 0; i < 2; i++) {
    const int r = (wu * 2 + i) * 16 + (lane >> 2), kc = (lane & 3) ^ ((r >> 2) & 3);
    gb[i] = B + (size_t)r * ldb + kc * 8;
  }
  LAS char* sm = (LAS char*)smem;
#define GSTAGE(st_, kt_) { \
    _Pragma("unroll") for (int i = 0; i < NA; i++) \
      __builtin_amdgcn_global_load_lds((const unsigned*)(ga[i] + (kt_) * 32), (LAS unsigned*)(sm + (st_) * STB + (wu * NA + i) * 1024), 16, 0, 0); \
    _Pragma("unroll") for (int i = 0; i < 2; i++) \
      __builtin_amdgcn_global_load_lds((const unsigned*)(gb[i] + (kt_) * 32), (LAS unsigned*)(sm + (st_) * STB + ABYTES + (wu * 2 + i) * 1024), 16, 0, 0); }
  __syncthreads();
#pragma unroll
  for (int s0 = 0; s0 < NST - 1; s0++) if (s0 < nkt) GSTAGE(s0, s0)
  const int frow = lane & 15, fg = lane >> 4;
  const int fo = (frow * 4 + (fg ^ ((frow >> 2) & 3))) * 16;
  const int offA = (wm * MI * 16) * 64 + fo, offB = ABYTES + (wn * 64) * 64 + fo;
  int st = 0;
#pragma unroll 1
  for (int kt = 0; kt < nkt; kt++) {
    if (NST == 4) { if (kt + 2 < nkt) WAIT_V(2 * LPT); else if (kt + 1 < nkt) WAIT_V(LPT); else WAIT_V(0); }
    else { if (kt + 1 < nkt) WAIT_V(LPT); else WAIT_V(0); }
    RAW_BARRIER();
    if (kt + NST - 1 < nkt) { const int sn = (st + NST - 1 >= NST) ? st - 1 : st + NST - 1; GSTAGE(sn, kt + NST - 1) }
    const LAS char* sp = sm + st * STB;
    bf16x8 af[MI], bfr[4];
#pragma unroll
    for (int i = 0; i < MI; i++) af[i] = *(const LAS bf16x8*)(sp + offA + i * 1024);
#pragma unroll
    for (int i = 0; i < 4; i++) bfr[i] = *(const LAS bf16x8*)(sp + offB + i * 1024);
    __builtin_amdgcn_s_setprio(1);
#pragma unroll
    for (int i = 0; i < MI; i++)
#pragma unroll
      for (int j = 0; j < 4; j++) acc[i][j] = __builtin_amdgcn_mfma_f32_16x16x32_bf16(bfr[j], af[i], acc[i][j], 0, 0, 0);
    __builtin_amdgcn_s_setprio(0);
    st = (st + 1 == NST) ? 0 : st + 1;
  }
  RAW_BARRIER();
}
#define ACC_ZERO(acc) { _Pragma("unroll") for (int i = 0; i < (int)(sizeof(acc) / sizeof(acc[0])); i++) _Pragma("unroll") for (int j = 0; j < 4; j++) acc[i][j] = (f32x4){0.f, 0.f, 0.f, 0.f}; }
#define EPI_LOOP(BODY) { constexpr int MI_ = (int)(sizeof(acc) / sizeof(acc[0])); const int lane_ = tidx() & 63, wave_ = tidx() >> 6, wm_ = wave_ >> 1, wn_ = wave_ & 1; \
  _Pragma("unroll") for (int i = 0; i < MI_; i++) { _Pragma("unroll") for (int j = 0; j < 4; j++) { \
    const int row = m0 + wm_ * (MI_ * 16) + i * 16 + (lane_ & 15); const int col = n0 + wn_ * 64 + j * 16 + (lane_ >> 4) * 4; const f32x4 v = acc[i][j]; BODY } \
    asm volatile("" ::: "memory"); } }
#define EPI_LOOP2(LOAD, STORE) { constexpr int MI_ = (int)(sizeof(acc) / sizeof(acc[0])); const int lane_ = tidx() & 63, wave_ = tidx() >> 6, wm_ = wave_ >> 1, wn_ = wave_ & 1; \
  _Pragma("unroll") for (int i = 0; i < MI_; i++) { f32x4 l0[4], l1[4]; \
    _Pragma("unroll") for (int j = 0; j < 4; j++) { \
      const int row = m0 + wm_ * (MI_ * 16) + i * 16 + (lane_ & 15); const int col = n0 + wn_ * 64 + j * 16 + (lane_ >> 4) * 4; LOAD } \
    asm volatile("" ::: "memory"); \
    _Pragma("unroll") for (int j = 0; j < 4; j++) { \
      const int row = m0 + wm_ * (MI_ * 16) + i * 16 + (lane_ & 15); const int col = n0 + wn_ * 64 + j * 16 + (lane_ >> 4) * 4; const f32x4 v = acc[i][j]; STORE } \
    asm volatile("" ::: "memory"); } }
#define COLJ(j) (n0 + ((tidx() >> 6) & 1) * 64 + (j) * 16 + ((tidx() & 63) >> 4) * 4)
__device__ __forceinline__ void ph_inproj(PP p, int layer, int seg, int bid, int nb, char* smem) {
  const u16* W = (const u16*)(p->ws + O_W) + (size_t)layer * W_LAYER + WIN;
  const u16* H = (const u16*)(p->ws + O_H);
  u16* urw = (u16*)(p->ws + O_URW); u16* hq = (u16*)(p->ws + O_HQ); u16* hv = (u16*)(p->ws + O_HV); u16* hg = (u16*)(p->ws + O_HG);
  float* hw = (float*)(p->ws + O_HW); u16* hk = (u16*)(p->ws + O_HK); u16* sz = (u16*)(p->ws + O_SZ); u16* sxbc = (u16*)(p->ws + O_SXBC);
  float* sdt = (float*)(p->ws + O_SDT); u16* gates = (u16*)(p->ws + ((seg & 1) ? O_GATES2 : O_GATES));
  const float* lbl = p->in[14];
  const float* dtb = p->in[18] + layer * 32;
  for (int t = bid; t < 16 * 124; t += nb) {
    const int m0 = (t & 15) * 256, n0 = (t >> 4) * 128;
    f32x4 acc[8][4]; ACC_ZERO(acc);
    gemm_kloop(H + (size_t)m0 * 1024, 1024, W + (size_t)n0 * 1024, 1024, 32, acc, smem);
    if (n0 < 3456) {
      EPI_LOOP({ if (col < 3360) *(u32x2*)(urw + ((size_t)((row >> 9) * 513 + 1 + (row & 511))) * 3456 + col) = pack4v(v); })
    } else if (n0 < 7552) {
      const int which = (n0 - 3456) >> 10;
      if (which == 0) { EPI_LOOP({ int cc = (col - 3456) & 1023; *(u32x2*)(hq + (size_t)row * 1024 + cc) = pack4v(v * sigm4(v)); }) }
      else if (which == 1) {
        f32x4 lbj[4];
#pragma unroll
        for (int j = 0; j < 4; j++) {
          int cc = (COLJ(j) - 3456) & 1023;
          f32x4 l0 = *(const f32x4*)(lbl + cc), l1 = *(const f32x4*)(lbl + 1024 + cc);
#pragma unroll
          for (int e = 0; e < 4; e++) lbj[j][e] = layer == 0 ? 0.f : 1.f / (1.f + __expf(l0[e] - l1[e]));
        }
        EPI_LOOP({ int cc = (col - 3456) & 1023; const f32x4 lb = lbj[j];
                   f32x4 sg = sigm4(v); f32x4 w = lb + (1.f - lb) * sg; f32x4 lf;
                   lf[0] = fmaxf(__logf(w[0]), -60.f); lf[1] = fmaxf(__logf(w[1]), -60.f); lf[2] = fmaxf(__logf(w[2]), -60.f); lf[3] = fmaxf(__logf(w[3]), -60.f);
                   *(f32x4*)(hw + (size_t)row * 1024 + cc) = lf;
                   *(u32x2*)(hk + (size_t)row * 1024 + cc) = pack4v((1.f - lb) * (1.f - sg)); })
      } else if (which == 2) { EPI_LOOP({ int cc = (col - 3456) & 1023; *(u32x2*)(hv + (size_t)row * 1024 + cc) = pack4v(v); }) }
      else { EPI_LOOP({ int cc = (col - 3456) & 1023; *(u32x2*)(hg + (size_t)row * 1024 + cc) = pack4v(sigm4(v)); }) }
    } else if (n0 < 12800) {
      const int c0 = n0 - 7552;
      if (c0 < 2048) { EPI_LOOP({ int c = col - 7552; *(u32x2*)(sz + (size_t)row * 2048 + c) = pack4v(v * sigm4(v)); }) }
      else if (c0 < 5120) { EPI_LOOP({ int c = col - 7552 - 2048; *(u32x2*)(sxbc + ((size_t)((row >> 9) * 515 + 3 + (row & 511))) * 3072 + c) = pack4v(v); }) }
      else {
        f32x4 dbj[4];
#pragma unroll
        for (int j = 0; j < 4; j++) { int c = COLJ(j) - 7552 - 5120; dbj[j] = c < 32 ? *(const f32x4*)(dtb + c) : (f32x4){0.f, 0.f, 0.f, 0.f}; }
        EPI_LOOP({ int c = col - 7552 - 5120; if (c < 32) { f32x4 xx = v + dbj[j]; f32x4 o;
                   o[0] = xx[0] > 20.f ? xx[0] : log1pf(__expf(xx[0])); o[1] = xx[1] > 20.f ? xx[1] : log1pf(__expf(xx[1]));
                   o[2] = xx[2] > 20.f ? xx[2] : log1pf(__expf(xx[2])); o[3] = xx[3] > 20.f ? xx[3] : log1pf(__expf(xx[3]));
                   *(f32x4*)(sdt + (size_t)row * 32 + c) = o; } })
      }
    } else {
      EPI_LOOP({ int c = col - 12800; *(u32x2*)(gates + (size_t)row * 3072 + c) = pack4v(sigm4(v)); })
    }
  }
}

__device__ __forceinline__ void ph_elem(PP p, int layer, int seg, int bid, int nb) {
  const u16* urw = (const u16*)(p->ws + O_URW);
  const float* mu = p->in[3] + layer * 3360;
  u16* law = (u16*)(p->ws + O_LAW); u16* laa = (u16*)(p->ws + O_LAA); u16* lag = (u16*)(p->ws + O_LAG);
  const int gt = bid * NTHR + tidx(), gs = nb * NTHR;
#pragma unroll 1
  for (int idx = gt; idx < RS * 80; idx += gs) {
    const int r = idx / 80, gq = idx - r * 80;
    if (gq >= 72) { u32x2 z; z.x = 0; z.y = 0; *(u32x2*)(lag + (size_t)r * 192 + 160 + (gq - 72) * 4) = z; continue; }
    const int col = 3072 + gq * 4;
    const size_t ro = (size_t)((r >> 9) * 513 + 1 + (r & 511)) * 3456;
    f32x4 cur = cvt4(*(const u32x2*)(urw + ro + col)), prv = cvt4(*(const u32x2*)(urw + ro - 3456 + col));
    f32x4 m4 = *(const f32x4*)(mu + col);
    f32x4 val = cur + (prv - cur) * m4;
    if (gq < 16) *(u32x2*)(law + (size_t)r * 64 + gq * 4) = pack4(tanhf(val[0]), tanhf(val[1]), tanhf(val[2]), tanhf(val[3]));
    else if (gq < 32) *(u32x2*)(laa + (size_t)r * 64 + (gq - 16) * 4) = pack4(val[0], val[1], val[2], val[3]);
    else *(u32x2*)(lag + (size_t)r * 192 + (gq - 32) * 4) = pack4(sigm(val[0]), sigm(val[1]), sigm(val[2]), sigm(val[3]));
  }
  const u16* sxbc = (const u16*)(p->ws + O_SXBC); u16* sx2 = (u16*)(p->ws + O_SX2);
  const float* cw = p->in[16] + (size_t)layer * 3072 * 4; const float* cb = p->in[17] + layer * 3072;
#pragma unroll 1
  for (int idx = gt; idx < (RS / 4) * 384; idx += gs) {
    const int rb = idx / 384, cg = idx - rb * 384, r = rb * 4, ch = cg * 8;
    const size_t ro = (size_t)((r >> 9) * 515 + (r & 511)) * 3072 + ch;
    u32x4 xin[7];
#pragma unroll
    for (int j = 0; j < 7; j++) xin[j] = *(const u32x4*)(sxbc + ro + (size_t)j * 3072);
    f32x4 w4[8];
#pragma unroll
    for (int c = 0; c < 8; c++) w4[c] = *(const f32x4*)(cw + (size_t)(ch + c) * 4);
    f32x4 b0 = *(const f32x4*)(cb + ch), b1 = *(const f32x4*)(cb + ch + 4);
#pragma unroll
    for (int rr = 0; rr < 4; rr++) {
      float o[8];
#pragma unroll
      for (int c = 0; c < 8; c++) {
        float acc = c < 4 ? b0[c] : b1[c - 4];
#pragma unroll
        for (int j = 0; j < 4; j++) {
          const unsigned wd = xin[rr + j][c >> 1];
          const float xv = (c & 1) ? __uint_as_float(wd & 0xffff0000u) : __uint_as_float(wd << 16);
          acc = fmaf(xv, w4[c][j], acc);
        }
        o[c] = acc * sigm(acc);
      }
      u32x4 ov; ov.x = pk2(o[0], o[1]); ov.y = pk2(o[2], o[3]); ov.z = pk2(o[4], o[5]); ov.w = pk2(o[6], o[7]);
      *(u32x4*)(sx2 + (size_t)(r + rr) * 3072 + ch) = ov;
    }
  }
}

__device__ __forceinline__ void ph_lora(PP p, int layer, int bid, int nb, char* smem) {
  const u16* W = (const u16*)(p->ws + O_W) + (size_t)layer * W_LAYER;
  float* rww = (float*)(p->ws + O_RWW); u16* rwa = (u16*)(p->ws + O_RWA); u16* rwg = (u16*)(p->ws + O_RWG);
  const float* w0 = p->in[4] + layer * 1024; const float* a0 = p->in[6] + layer * 1024;
  for (int t = bid; t < 3 * 256; t += nb) {
    const int job = t >> 8, tt = t & 255, m0 = (tt & 31) * 128, n0 = (tt >> 5) * 128;
    f32x4 acc[4][4]; ACC_ZERO(acc);
    if (job == 0) {
      gemm_kloop((const u16*)(p->ws + O_LAW) + (size_t)m0 * 64, 64, W + WWUP + (size_t)n0 * 64, 64, 2, acc, smem);
      f32x4 pj[4];
#pragma unroll
      for (int j = 0; j < 4; j++) pj[j] = *(const f32x4*)(w0 + COLJ(j));
      EPI_LOOP({ f32x4 sg = sigm4(pj[j] + v); f32x4 o; o[0] = __expf(-0.60653066f * sg[0]); o[1] = __expf(-0.60653066f * sg[1]); o[2] = __expf(-0.60653066f * sg[2]); o[3] = __expf(-0.60653066f * sg[3]);
                 *(f32x4*)(rww + (size_t)row * 1024 + col) = o; })
    } else if (job == 1) {
      gemm_kloop((const u16*)(p->ws + O_LAA) + (size_t)m0 * 64, 64, W + WAUP + (size_t)n0 * 64, 64, 2, acc, smem);
      f32x4 pj[4];
#pragma unroll
      for (int j = 0; j < 4; j++) pj[j] = *(const f32x4*)(a0 + COLJ(j));
      EPI_LOOP({ *(u32x2*)(rwa + (size_t)row * 1024 + col) = pack4v(sigm4(pj[j] + v)); })
    } else {
      gemm_kloop((const u16*)(p->ws + O_LAG) + (size_t)m0 * 192, 192, W + WGUP + (size_t)n0 * 192, 192, 6, acc, smem);
      EPI_LOOP({ *(u32x2*)(rwg + (size_t)row * 1024 + col) = pack4v(v); })
    }
  }
}

__device__ __forceinline__ void ph_rprep(PP p, int layer, int bid, int nb) {
  const u16* urw = (const u16*)(p->ws + O_URW); const u16* rwa = (const u16*)(p->ws + O_RWA);
  u16* pr = (u16*)(p->ws + O_PR); u16* pk = (u16*)(p->ws + O_PK); u16* pv = (u16*)(p->ws + O_PV);
  u16* pka = (u16*)(p->ws + O_PKA); u16* pkb = (u16*)(p->ws + O_PKB); float* bonus = (float*)(p->ws + O_BONUS);
  const float* mu = p->in[3] + layer * 3360; const float* kk_ = p->in[9] + layer * 1024; const float* ka_ = p->in[10] + layer * 1024;
  const float* rk_ = p->in[11] + layer * 1024;
  {
    u16* sxbc = (u16*)(p->ws + O_SXBC);
    const int gt = bid * NTHR + tidx(), gs = nb * NTHR;
    for (int idx = gt; idx < 8 * 3 * 3072; idx += gs) { int b = idx / 9216, c = idx - b * 9216; sxbc[(size_t)(b * 515) * 3072 + c] = sxbc[(size_t)(b * 515 + 512) * 3072 + c]; }
  }
  const int lane = tidx() & 63, wv = tidx() >> 6;
#pragma unroll 1
  for (int task = bid * 4 + wv; task < RS * 4; task += nb * 4) {
    const int r = task >> 2, col = (task & 3) * 256 + lane * 4;
    const size_t ro = (size_t)((r >> 9) * 513 + 1 + (r & 511)) * 3456 + col;
    f32x4 rc = cvt4(*(const u32x2*)(urw + ro)), rp = cvt4(*(const u32x2*)(urw + ro - 3456));
    f32x4 kc = cvt4(*(const u32x2*)(urw + ro + 1024)), kp = cvt4(*(const u32x2*)(urw + ro - 3456 + 1024));
    f32x4 vc = cvt4(*(const u32x2*)(urw + ro + 2048)), vp = cvt4(*(const u32x2*)(urw + ro - 3456 + 2048));
    f32x4 a = cvt4(*(const u32x2*)(rwa + (size_t)r * 1024 + col));
    f32x4 rr = rc + (rp - rc) * *(const f32x4*)(mu + col);
    f32x4 k = kc + (kp - kc) * *(const f32x4*)(mu + 1024 + col);
    f32x4 vv = vc + (vp - vc) * *(const f32x4*)(mu + 2048 + col);
    f32x4 kkv = k * *(const f32x4*)(kk_ + col);
    float n2 = red16(kkv[0] * kkv[0] + kkv[1] * kkv[1] + kkv[2] * kkv[2] + kkv[3] * kkv[3]);
    const float inv = 1.f / fmaxf(sqrtf(n2), 1e-12f);
    f32x4 kkn = kkv * inv;
    f32x4 kmod = k * (1.f + (a - 1.f) * *(const f32x4*)(ka_ + col));
    f32x4 bt = rr * kmod * *(const f32x4*)(rk_ + col);
    float bn = red16(bt[0] + bt[1] + bt[2] + bt[3]);
    const size_t o = (size_t)r * 1024 + col;
    *(u32x2*)(pr + o) = pack4(rr[0], rr[1], rr[2], rr[3]);
    *(u32x2*)(pk + o) = pack4(kmod[0], kmod[1], kmod[2], kmod[3]);
    *(u32x2*)(pv + o) = pack4(vv[0], vv[1], vv[2], vv[3]);
    *(u32x2*)(pka + o) = pack4(-kkn[0], -kkn[1], -kkn[2], -kkn[3]);
    *(u32x2*)(pkb + o) = pack4(kkn[0] * a[0], kkn[1] * a[1], kkn[2] * a[2], kkn[3] * a[3]);
    if ((lane & 15) == 0) bonus[r * 16 + (col >> 6)] = bn;
  }
}

struct ScanArgs {
  const u16 *pr, *pk, *pka, *pkb, *pv;
  const float *pw, *pvs;
  float *po, *state;
  int sr, sk, sab, sv, sw, svs, so;
};
#define TB 16
template <int KD, bool DELTA, bool WSCALAR, bool KFROMW, int LPR>
__device__ __forceinline__ void scan_task(const ScanArgs& a, bool first, bool save, char* smem) {
  constexpr int RB = 256 / LPR, GV = RB / 4; constexpr int KE = KD / LPR, NQ = KE / 4, NG = KD / 64, G4 = KD / 4;
  constexpr int OFF_R = 0, OFF_K = KD;
  constexpr int OFF_W = KFROMW ? KD : 2 * KD;
  constexpr int OFF_KA = OFF_W + (WSCALAR ? 0 : KD);
  constexpr int OFF_KB = OFF_KA + (DELTA ? KD : 0);
  constexpr int OFF_V = OFF_KB + (DELTA ? KD : 0);
  constexpr int OFF_S = OFF_V + RB;
  constexpr int STR = OFF_S + 4;
  float* buf0 = (float*)smem; float* buf1 = buf0 + TB * STR; float* obuf = buf1 + TB * STR;
  const int tid = tidx(), ks = tid & (LPR - 1), vr = tid / LPR;
  u32x2 gr[NG], gk[NG], gka[NG], gkb[NG], gv; f32x4 gw[NG]; float gsw = 0.f, gsv = 0.f;
  gv.x = gv.y = 0;
#define LOAD_BLK(blk_) { \
    const int row = (blk_) * TB; \
    _Pragma("unroll") for (int i = 0; i < NG; i++) { \
      const int g = tid + 256 * i, step = g / G4, e4 = g % G4; \
      gr[i] = *(const u32x2*)(a.pr + (size_t)(row + step) * a.sr + e4 * 4); \
      if (!KFROMW) gk[i] = *(const u32x2*)(a.pk + (size_t)(row + step) * a.sk + e4 * 4); \
      if (!WSCALAR) gw[i] = *(const f32x4*)(a.pw + (size_t)(row + step) * a.sw + e4 * 4); \
      if (DELTA) { gka[i] = *(const u32x2*)(a.pka + (size_t)(row + step) * a.sab + e4 * 4); gkb[i] = *(const u32x2*)(a.pkb + (size_t)(row + step) * a.sab + e4 * 4); } \
    } \
    if (tid < TB * GV) { const int step = tid / GV, e4 = tid % GV; gv = *(const u32x2*)(a.pv + (size_t)(row + step) * a.sv + e4 * 4); } \
    if (WSCALAR && tid < TB) { gsw = a.pw[(size_t)(row + tid) * a.sw]; gsv = a.pvs[(size_t)(row + tid) * a.svs]; } }
#define STORE_BLK(buf_) { \
    float* bufp = (buf_); \
    _Pragma("unroll") for (int i = 0; i < NG; i++) { \
      const int g = tid + 256 * i, step = g / G4, e4 = g % G4; \
      float* d = bufp + step * STR + e4 * 4; \
      *(f32x4*)(d + OFF_R) = cvt4(gr[i]); \
      if (!KFROMW) *(f32x4*)(d + OFF_K) = cvt4(gk[i]); \
      if (!WSCALAR) *(f32x4*)(d + OFF_W) = gw[i]; \
      if (DELTA) { *(f32x4*)(d + OFF_KA) = cvt4(gka[i]); *(f32x4*)(d + OFF_KB) = cvt4(gkb[i]); } \
    } \
    if (tid < TB * GV) { const int step = tid / GV, e4 = tid % GV; *(f32x4*)(bufp + step * STR + OFF_V + e4 * 4) = cvt4(gv); } \
    if (WSCALAR && tid < TB) { bufp[tid * STR + OFF_S] = gsw; bufp[tid * STR + OFF_S + 1] = gsv; } }
  float S[KE];
  if (first) {
#pragma unroll
    for (int e = 0; e < KE; e++) S[e] = 0.f;
  } else {
#pragma unroll
    for (int q = 0; q < NQ; q++) { float4 t = *(const float4*)(a.state + (size_t)vr * KD + q * (LPR * 4) + ks * 4); S[q * 4] = t.x; S[q * 4 + 1] = t.y; S[q * 4 + 2] = t.z; S[q * 4 + 3] = t.w; }
  }
  LOAD_BLK(0)
  __syncthreads();
  STORE_BLK(buf0)
  __syncthreads();
  constexpr int NBLK = SL / TB;
  for (int blk = 0; blk < NBLK; blk++) {
    float* buf = (blk & 1) ? buf1 : buf0;
    if (blk + 1 < NBLK) LOAD_BLK(blk + 1)
    {
      float rv1[KE], kb1[KE], kv[2][KE], wv[2][KE], kav[2][KE], vtv[2], wsv[2], vsv[2];
#define LD_STEP(slot, st_) { const float* sp = buf + (st_) * STR; \
        _Pragma("unroll") for (int q = 0; q < NQ; q++) { \
          if (!WSCALAR) { f32x4 u = *(const f32x4*)(sp + OFF_W + q * (LPR * 4) + ks * 4); wv[slot][q * 4] = u[0]; wv[slot][q * 4 + 1] = u[1]; wv[slot][q * 4 + 2] = u[2]; wv[slot][q * 4 + 3] = u[3]; } \
          if (!KFROMW) { f32x4 u = *(const f32x4*)(sp + OFF_K + q * (LPR * 4) + ks * 4); kv[slot][q * 4] = u[0]; kv[slot][q * 4 + 1] = u[1]; kv[slot][q * 4 + 2] = u[2]; kv[slot][q * 4 + 3] = u[3]; } \
          if (DELTA) { f32x4 u = *(const f32x4*)(sp + OFF_KA + q * (LPR * 4) + ks * 4); kav[slot][q * 4] = u[0]; kav[slot][q * 4 + 1] = u[1]; kav[slot][q * 4 + 2] = u[2]; kav[slot][q * 4 + 3] = u[3]; \
                     } \
        } \
        vtv[slot] = sp[OFF_V + vr]; \
        if (WSCALAR) { wsv[slot] = sp[OFF_S]; vsv[slot] = sp[OFF_S + 1]; } }
      LD_STEP(0, 0)
#define DO_STEP(cs, step_) { \
        { const float* spr = buf + (step_) * STR; _Pragma("unroll") for (int q = 0; q < NQ; q++) { f32x4 t = *(const f32x4*)(spr + OFF_R + q * (LPR * 4) + ks * 4); rv1[q * 4] = t[0]; rv1[q * 4 + 1] = t[1]; rv1[q * 4 + 2] = t[2]; rv1[q * 4 + 3] = t[3]; \
            if (DELTA) { f32x4 x = *(const f32x4*)(spr + OFF_KB + q * (LPR * 4) + ks * 4); kb1[q * 4] = x[0]; kb1[q * 4 + 1] = x[1]; kb1[q * 4 + 2] = x[2]; kb1[q * 4 + 3] = x[3]; } } } \
        float vt = vtv[cs]; \
        if (WSCALAR) vt *= vsv[cs]; \
        if (DELTA) { \
          float sa0 = 0.f, sa1 = 0.f, sa2 = 0.f, sa3 = 0.f; \
          _Pragma("unroll") for (int e = 0; e < KE; e += 2) { sa0 = fmaf(S[e], kav[cs][e], sa0); sa1 = fmaf(S[e + 1], kav[cs][e + 1], sa1); } \
          _Pragma("unroll") for (int e = 0; e < KE; e++) S[e] = fmaf(S[e], wv[cs][e], vt * kv[cs][e]); \
          float sa = (LPR == 8) ? red8((sa0 + sa1) + (sa2 + sa3)) : red4((sa0 + sa1) + (sa2 + sa3)); \
          _Pragma("unroll") for (int e = 0; e < KE; e++) S[e] = fmaf(sa, kb1[e], S[e]); \
        } else { \
          _Pragma("unroll") for (int e = 0; e < KE; e++) { \
            float w = WSCALAR ? wsv[cs] : wv[cs][e]; \
            float k = KFROMW ? (1.f - wv[cs][e]) : kv[cs][e]; \
            S[e] = fmaf(S[e], w, vt * k); } \
        } \
        float o0 = 0.f, o1 = 0.f, o2 = 0.f, o3 = 0.f; \
        _Pragma("unroll") for (int e = 0; e < KE; e += 2) { o0 = fmaf(S[e], rv1[e], o0); o1 = fmaf(S[e + 1], rv1[e + 1], o1); } \
        float o = (LPR == 8) ? red8((o0 + o1) + (o2 + o3)) : red4((o0 + o1) + (o2 + o3)); \
        if (ks == 0) obuf[(step_) * RB + vr] = o; }
#pragma unroll 1
      for (int step = 0; step < TB; step += 2) {
        LD_STEP(1, step + 1)
        DO_STEP(0, step)
        if (step + 2 < TB) LD_STEP(0, step + 2)
        DO_STEP(1, step + 1)
      }
    }
    __syncthreads();
    {
      const int row = blk * TB;
#pragma unroll
      for (int i = 0; i < TB * RB / 256; i++) { const int idx = tid + 256 * i, step = idx / RB, v2 = idx % RB; a.po[(size_t)(row + step) * a.so + v2] = obuf[idx]; }
    }
    if (blk + 1 < NBLK) STORE_BLK((blk & 1) ? buf0 : buf1)
    __syncthreads();
  }
  if (save)
#pragma unroll
  for (int q = 0; q < NQ; q++) { float4 t; t.x = S[q * 4]; t.y = S[q * 4 + 1]; t.z = S[q * 4 + 2]; t.w = S[q * 4 + 3]; *(float4*)(a.state + (size_t)vr * KD + q * (LPR * 4) + ks * 4) = t; }
}


struct ChunkArgs { const u16 *q, *k, *v; const float* lf; float* o; float* state; int ld, ldlf; float expA; };
#define QLD 136
#define KHLD 72
template <bool SSM>
__device__ __forceinline__ void chunk_task(const ChunkArgs& a, bool first, bool save, char* smem) {
  u16* QT = (u16*)smem;
  u16* KT = QT + 64 * QLD;
  u16* KH = KT + 64 * QLD;
  u16* VT = KH + 128 * KHLD;
  u16* ST = VT + 32 * KHLD;
  float* gam = (float*)(ST + 32 * QLD); float* em = gam + 128; float* cum = gam + 256; float* dts = gam + 512;
  const int tid = tidx(), lane = tid & 63, g = lane >> 4, c = lane & 15;
  const int w = __builtin_amdgcn_readfirstlane(tid >> 6);
  f32x4 accS[2][2];
#pragma unroll
  for (int i = 0; i < 2; i++)
#pragma unroll
    for (int j = 0; j < 2; j++)
      accS[i][j] = first ? (f32x4){0.f, 0.f, 0.f, 0.f} : *(const f32x4*)(a.state + (size_t)((i * 2 + j) * 256 + tid) * 4);
  float rcn[32]; u16 qan[32], kan[32]; u32x4 cqn[4], ckn[4], vvn; float dtn = 0.f;
#define CH_PREFETCH(chn_) { const int rp = (chn_) * 64; \
    if (!SSM) { const int d = tid & 127, half = tid >> 7; \
      const float* lfp = a.lf + (size_t)(rp + half * 32) * a.ldlf + d; \
      const u16* qp = a.q + (size_t)(rp + half * 32) * a.ld + d; const u16* kp = a.k + (size_t)(rp + half * 32) * a.ld + d; \
      _Pragma("unroll") for (int i = 0; i < 32; i++) rcn[i] = lfp[(size_t)i * a.ldlf]; \
      _Pragma("unroll") for (int i = 0; i < 32; i++) { qan[i] = qp[(size_t)i * a.ld]; kan[i] = kp[(size_t)i * a.ld]; } \
    } else { \
      _Pragma("unroll") for (int i = 0; i < 4; i++) { const int id = tid + 256 * i, s = id >> 4, cc = id & 15; \
        cqn[i] = *(const u32x4*)(a.q + (size_t)(rp + s) * a.ld + cc * 8); ckn[i] = *(const u32x4*)(a.k + (size_t)(rp + s) * a.ld + cc * 8); } \
      if (tid < 64) dtn = a.lf[(size_t)(rp + tid) * a.ldlf]; \
    } \
    { const int s = tid & 63, vg = tid >> 6; vvn = *(const u32x4*)(a.v + (size_t)(rp + s) * a.ld + vg * 8); } }
  CH_PREFETCH(0)
#pragma unroll 1
  for (int ch = 0; ch < SL / 64; ch++) {
    const int r0 = ch * 64;
    float rc[32]; float kf[32]; float rc63 = 0.f;
    if (!SSM) {
      const int d = tid & 127, half = tid >> 7;
#pragma unroll
      for (int i = 0; i < 32; i++) rc[i] = rcn[i];
      float tot = 0.f;
      if (half == 0) {
        float acc = 0.f;
#pragma unroll
        for (int i = 31; i >= 0; i--) { float l = rc[i]; tot += l; rc[i] = acc; acc -= l; }
        em[d] = __expf(tot);
      } else {
        float acc = 0.f;
#pragma unroll
        for (int i = 0; i < 32; i++) { acc += rc[i]; rc[i] = acc; }
        tot = acc;
      }
      cum[half * 128 + d] = tot;
#pragma unroll
      for (int i = 0; i < 32; i++) {
        const int s = half * 32 + i;
        float qv = bf2f(qan[i]); kf[i] = bf2f(kan[i]);
        float r = rc[i];
        QT[s * QLD + d] = f2bf(qv * __expf(fminf(r, 80.f)));
        KT[s * QLD + d] = f2bf(kf[i] * __expf(fminf(-r, 80.f)));
      }
    } else {
#pragma unroll
      for (int i = 0; i < 4; i++) {
        const int id = tid + 256 * i, s = id >> 4, cc = id & 15;
        *(u32x4*)(QT + s * QLD + cc * 8) = cqn[i];
        *(u32x4*)(KT + s * QLD + cc * 8) = ckn[i];
      }
      if (tid < 64) {
        float dtv = dtn;
        float x = -dtv * a.expA;
#pragma unroll
        for (int o = 1; o < 64; o <<= 1) { float y = __shfl_up(x, o); if (lane >= o) x += y; }
        cum[tid] = x; dts[tid] = dtv;
      }
    }
    {
      const int s = tid & 63, vg = tid >> 6;
      u32x4 vv = vvn;
#pragma unroll
      for (int j = 0; j < 4; j++) { VT[(vg * 8 + 2 * j) * KHLD + s] = (u16)(vv[j] & 0xffffu); VT[(vg * 8 + 2 * j + 1) * KHLD + s] = (u16)(vv[j] >> 16); }
    }
    __syncthreads();
#pragma unroll
    for (int dt2 = 0; dt2 < 2; dt2++) {
      const int d0 = (2 * w + dt2) * 16 + 4 * g;
      f32x4 e4 = (f32x4){1.f, 1.f, 1.f, 1.f};
      if (!SSM) e4 = *(const f32x4*)(em + d0);
#pragma unroll
      for (int vt = 0; vt < 2; vt++) {
        f32x4 sv = accS[dt2][vt] * e4;
        u32x2 pk; pk.x = pk2(sv[0], sv[1]); pk.y = pk2(sv[2], sv[3]);
        *(u32x2*)(ST + (16 * vt + c) * QLD + d0) = pk;
      }
    }
    if (!SSM) {
      const int d = tid & 127, half = tid >> 7;
      const float t0 = cum[d], t1 = cum[128 + d];
      rc63 = t1;
      if (half == 0) gam[d] = __expf(t0 + t1);
#pragma unroll
      for (int i = 0; i < 32; i++) KH[d * KHLD + half * 32 + i] = f2bf(kf[i] * __expf(rc63 - rc[i]));
    }
    if (SSM) {
      const int s = tid & 63, ng = tid >> 6;
      const float sc = __expf(cum[63] - cum[s]) * dts[s];
#pragma unroll
      for (int i = 0; i < 4; i++) {
        u32x4 kk = *(const u32x4*)(KT + s * QLD + ng * 32 + i * 8);
#pragma unroll
        for (int j = 0; j < 4; j++) {
          const int n = ng * 32 + i * 8 + 2 * j;
          KH[n * KHLD + s] = f2bf(__uint_as_float(kk[j] << 16) * sc);
          KH[(n + 1) * KHLD + s] = f2bf(__uint_as_float(kk[j] & 0xffff0000u) * sc);
        }
      }
    }
    __syncthreads();
    if (ch + 1 < SL / 64) CH_PREFETCH(ch + 1)
    {
      const int t = 16 * w + c;
      bf16x8 bq[4];
#pragma unroll
      for (int ks = 0; ks < 4; ks++) bq[ks] = *(const bf16x8*)(QT + t * QLD + ks * 32 + g * 8);
      f32x4 accp[4];
#pragma unroll
      for (int st = 0; st < 4; st++) {
        accp[st] = (f32x4){0.f, 0.f, 0.f, 0.f};
        if (st <= w) {
#pragma unroll
          for (int ks = 0; ks < 4; ks++) {
            bf16x8 ak = *(const bf16x8*)(KT + (16 * st + c) * QLD + ks * 32 + g * 8);
            accp[st] = __builtin_amdgcn_mfma_f32_16x16x32_bf16(ak, bq[ks], accp[st], 0, 0, 0);
          }
        }
      }
      float cumt = 0.f;
      if (SSM) cumt = cum[t];
#pragma unroll
      for (int st = 0; st < 4; st++)
#pragma unroll
        for (int r = 0; r < 4; r++) {
          const int s = 16 * st + 4 * g + r;
          float v = accp[st][r];
          if (SSM) v *= __expf(fminf(cumt - cum[s], 0.f)) * dts[s];
          accp[st][r] = (s <= t) ? v : 0.f;
        }
      bf16x8 bp[2];
#pragma unroll
      for (int a2 = 0; a2 < 2; a2++)
#pragma unroll
        for (int j = 0; j < 4; j++) { bp[a2][j] = (short)f2bf(accp[2 * a2][j]); bp[a2][4 + j] = (short)f2bf(accp[2 * a2 + 1][j]); }
      f32x4 acco[2], acco2[2];
#pragma unroll
      for (int vt = 0; vt < 2; vt++) {
        acco[vt] = (f32x4){0.f, 0.f, 0.f, 0.f}; acco2[vt] = (f32x4){0.f, 0.f, 0.f, 0.f};
#pragma unroll
        for (int a2 = 0; a2 < 2; a2++) {
          if (2 * a2 <= w) {
            const u16* vp = VT + (16 * vt + c) * KHLD + 32 * a2 + 4 * g;
            u32x2 lo = *(const u32x2*)vp, hi = *(const u32x2*)(vp + 16);
            u32x4 cmb; cmb.x = lo.x; cmb.y = lo.y; cmb.z = hi.x; cmb.w = hi.y;
            bf16x8 av = __builtin_bit_cast(bf16x8, cmb);
            acco[vt] = __builtin_amdgcn_mfma_f32_16x16x32_bf16(av, bp[a2], acco[vt], 0, 0, 0);
          }
        }
#pragma unroll
        for (int ks = 0; ks < 4; ks++) {
          bf16x8 as = *(const bf16x8*)(ST + (16 * vt + c) * QLD + ks * 32 + g * 8);
          if (SSM) acco2[vt] = __builtin_amdgcn_mfma_f32_16x16x32_bf16(as, bq[ks], acco2[vt], 0, 0, 0);
          else acco[vt] = __builtin_amdgcn_mfma_f32_16x16x32_bf16(as, bq[ks], acco[vt], 0, 0, 0);
        }
        f32x4 ov = acco[vt];
        if (SSM) ov += __expf(cumt) * acco2[vt];
        *(f32x4*)(a.o + (size_t)(r0 + t) * 4096 + 16 * vt + 4 * g) = ov;
      }
#pragma unroll
      for (int dt2 = 0; dt2 < 2; dt2++) {
        const int d0 = (2 * w + dt2) * 16;
        f32x4 gm;
        if (SSM) { float gs = __expf(cum[63]); gm = (f32x4){gs, gs, gs, gs}; }
        else gm = *(const f32x4*)(gam + d0 + 4 * g);
#pragma unroll
        for (int vt = 0; vt < 2; vt++) accS[dt2][vt] *= gm;
#pragma unroll
        for (int a2 = 0; a2 < 2; a2++) {
          bf16x8 ak = *(const bf16x8*)(KH + (d0 + c) * KHLD + 32 * a2 + 8 * g);
#pragma unroll
          for (int vt = 0; vt < 2; vt++) {
            bf16x8 bv = *(const bf16x8*)(VT + (16 * vt + c) * KHLD + 32 * a2 + 8 * g);
            accS[dt2][vt] = __builtin_amdgcn_mfma_f32_16x16x32_bf16(ak, bv, accS[dt2][vt], 0, 0, 0);
          }
        }
      }
    }
    __syncthreads();
  }
  if (save)
#pragma unroll
  for (int i = 0; i < 2; i++)
#pragma unroll
    for (int j = 0; j < 2; j++) *(f32x4*)(a.state + (size_t)((i * 2 + j) * 256 + tid) * 4) = accS[i][j];
}

__device__ __forceinline__ void chunk_dispatch(PP p, int layer, int ct, bool first, bool save, char* smem) {
  float* so = (float*)(p->ws + O_SO);
  ChunkArgs a;
  if (ct < 256) {
    const int vs = ct & 3, h = (ct >> 2) & 7, b = ct >> 5;
    const size_t ro = (size_t)b * SL * 1024 + h * 128;
    a.q = (const u16*)(p->ws + O_HQ) + ro; a.k = (const u16*)(p->ws + O_HK) + ro; a.v = (const u16*)(p->ws + O_HV) + ro + vs * 32;
    a.lf = (const float*)(p->ws + O_HW) + ro; a.o = so + (size_t)b * SL * 4096 + 1024 + h * 128 + vs * 32;
    a.state = (float*)(p->ws + O_STHG) + (size_t)ct * 4096; a.ld = 1024; a.ldlf = 1024; a.expA = 0.f;
    chunk_task<false>(a, first, save, smem);
  } else {
    const int t2 = ct - 256, vs = t2 & 1, hd = (t2 >> 1) & 31, b = t2 >> 6, g = hd >> 3;
    const u16* x2 = (const u16*)(p->ws + O_SX2) + (size_t)b * SL * 3072;
    a.q = x2 + 2560 + g * 128; a.k = x2 + 2048 + g * 128; a.v = x2 + hd * 64 + vs * 32;
    a.lf = (const float*)(p->ws + O_SDT) + (size_t)b * SL * 32 + hd; a.o = so + (size_t)b * SL * 4096 + 2048 + hd * 64 + vs * 32;
    a.state = (float*)(p->ws + O_STSS) + (size_t)t2 * 4096; a.ld = 3072; a.ldlf = 32; a.expA = __expf(p->in[19][layer * 32 + hd]);
    chunk_task<true>(a, first, save, smem);
  }
}
__device__ __forceinline__ void rwkv_dispatch(PP p, int task, bool first, bool save, char* smem) {
  float* so = (float*)(p->ws + O_SO);
  ScanArgs a;
  const int h = task & 15, b = task >> 4;
  const size_t ro = (size_t)b * SL * 1024 + h * 64;
  a.pr = (const u16*)(p->ws + O_PR) + ro; a.pk = (const u16*)(p->ws + O_PK) + ro; a.pka = (const u16*)(p->ws + O_PKA) + ro; a.pkb = (const u16*)(p->ws + O_PKB) + ro;
  a.pv = (const u16*)(p->ws + O_PV) + ro; a.pw = (const float*)(p->ws + O_RWW) + ro; a.pvs = nullptr;
  a.po = so + (size_t)b * SL * 4096 + h * 64; a.state = (float*)(p->ws + O_STRW) + (size_t)(b * 16 + h) * 4096;
  a.sr = a.sk = a.sab = a.sv = a.sw = 1024; a.svs = 0; a.so = 4096;
  scan_task<64, true, false, false, 4>(a, first, save, smem);
}
template <int BR> __device__ __forceinline__ void merge_tile(PP p, int layer, int seg, int t, char* smem);
__device__ __forceinline__ void merge_item(PP p, int layer, int seg, int t, char* smem);
__device__ __forceinline__ void ph_scan(PP p, int layer, int seg, int bid, int nb, char* smem, volatile LAS unsigned* bw) {
  const bool first = (seg == 0);
  unsigned* ctr = (unsigned*)(p->ws + O_BAR) + 3520;
  const unsigned base = (unsigned)(layer * NSEG + seg) * (unsigned)(1024 + nb);
  if (bid < 128) { rwkv_dispatch(p, bid, first, true, smem); __syncthreads(); }
#pragma unroll 1
  for (;;) {
    if (tidx() == 0) *bw = __hip_atomic_fetch_add(ctr, 1u, __ATOMIC_RELAXED, __HIP_MEMORY_SCOPE_AGENT);
    __syncthreads();
    const unsigned it = *bw - base;
    __syncthreads();
    if (it >= 1024u) break;
    if (it < 256u) { if (seg > 0) merge_item(p, layer, seg - 1, (int)it, smem); }
    else chunk_dispatch(p, layer, (int)it - 256, first, true, smem);
    __syncthreads();
  }
}

__device__ __forceinline__ void ph_post(PP p, int layer, int bid, int nb) {
  const float* so = (const float*)(p->ws + O_SO); u16* y = (u16*)(p->ws + O_Y);
  const int lane = tidx() & 63, wv = tidx() >> 6;
  {
    u16* urw = (u16*)(p->ws + O_URW);
    const int gt = bid * NTHR + tidx(), gs = nb * NTHR;
    for (int idx = gt; idx < 8 * 3456; idx += gs) { int b = idx / 3456, c = idx - b * 3456; urw[(size_t)(b * 513) * 3456 + c] = urw[(size_t)(b * 513 + 512) * 3456 + c]; }
  }
  const u16* pv = (const u16*)(p->ws + O_PV); const u16* rwg = (const u16*)(p->ws + O_RWG); const float* bonus = (const float*)(p->ws + O_BONUS);
  const float* gnw = p->in[12] + layer * 1024; const float* gnb = p->in[13] + layer * 1024;
  const u16* hg = (const u16*)(p->ws + O_HG); const float* hgn = p->in[15] + layer * 1024;
  const u16* sx2 = (const u16*)(p->ws + O_SX2); const u16* sz = (const u16*)(p->ws + O_SZ);
  const float* dsk = p->in[20] + layer * 32; const float* sgn = p->in[21] + layer * 2048;
#pragma unroll 1
  for (int task = bid * 4 + wv; task < RS * 12; task += nb * 4) {
    const int r = task / 12, s = task - r * 12;
    if (s < 4) {
      const int col = s * 256 + lane * 4;
      f32x4 o = *(const f32x4*)(so + (size_t)r * 4096 + col);
      const float mean = red16(o[0] + o[1] + o[2] + o[3]) * (1.f / 64.f);
      f32x4 d = o - mean;
      const float var = red16(d[0] * d[0] + d[1] * d[1] + d[2] * d[2] + d[3] * d[3]) * (1.f / 64.f);
      f32x4 on = d * rsqrtf(var + 64e-5f) * *(const f32x4*)(gnw + col) + *(const f32x4*)(gnb + col);
      on += bonus[r * 16 + (col >> 6)] * cvt4(*(const u32x2*)(pv + (size_t)r * 1024 + col));
      on *= cvt4(*(const u32x2*)(rwg + (size_t)r * 1024 + col));
      *(u32x2*)(y + (size_t)r * 4096 + col) = pack4(on[0], on[1], on[2], on[3]);
    } else if (s < 8) {
      const int c = (s - 4) * 256 + lane * 4;
      f32x4 o = *(const f32x4*)(so + (size_t)r * 4096 + 1024 + c);
      float ss = red16(o[0] * o[0] + o[1] * o[1] + o[2] * o[2] + o[3] * o[3]);
      ss += __shfl_xor(ss, 16);
      const float rstd = rsqrtf(ss * (1.f / 128.f) + 1e-5f);
      f32x4 on = o * rstd * *(const f32x4*)(hgn + c) * cvt4(*(const u32x2*)(hg + (size_t)r * 1024 + c));
      *(u32x2*)(y + (size_t)r * 4096 + 1024 + c) = pack4(on[0], on[1], on[2], on[3]);
    } else {
      const int g = s - 8, ch = g * 512 + lane * 8;
      f32x4 o0 = *(const f32x4*)(so + (size_t)r * 4096 + 2048 + ch), o1 = *(const f32x4*)(so + (size_t)r * 4096 + 2048 + ch + 4);
      u32x4 xr = *(const u32x4*)(sx2 + (size_t)r * 3072 + ch), zr = *(const u32x4*)(sz + (size_t)r * 2048 + ch);
      u32x2 t0; t0.x = xr.x; t0.y = xr.y; u32x2 t1; t1.x = xr.z; t1.y = xr.w;
      u32x2 z0; z0.x = zr.x; z0.y = zr.y; u32x2 z1; z1.x = zr.z; z1.y = zr.w;
      const float dk = dsk[ch >> 6];
      f32x4 y0 = (o0 + dk * cvt4(t0)) * cvt4(z0), y1 = (o1 + dk * cvt4(t1)) * cvt4(z1);
      float ss = y0[0] * y0[0] + y0[1] * y0[1] + y0[2] * y0[2] + y0[3] * y0[3] + y1[0] * y1[0] + y1[1] * y1[1] + y1[2] * y1[2] + y1[3] * y1[3];
      ss = red16(ss); ss += __shfl_xor(ss, 16); ss += __shfl_xor(ss, 32);
      const float rstd = rsqrtf(ss * (1.f / 512.f) + 1e-5f);
      y0 = y0 * rstd * *(const f32x4*)(sgn + ch); y1 = y1 * rstd * *(const f32x4*)(sgn + ch + 4);
      u32x4 ov; ov.x = pk2(y0[0], y0[1]); ov.y = pk2(y0[2], y0[3]); ov.z = pk2(y1[0], y1[1]); ov.w = pk2(y1[2], y1[3]);
      *(u32x4*)(y + (size_t)r * 4096 + 2048 + ch) = ov;
    }
  }
}

#define MT_ROW(row) ((size_t)(((row) >> 9) * 515 + 3 + ((row) & 511)) * 1536)
template <int BR>
__device__ __forceinline__ void merge_tile(PP p, int layer, int seg, int t, char* smem) {
  const u16* W = (const u16*)(p->ws + O_W) + (size_t)layer * W_LAYER + WBR;
  const u16* Y = (const u16*)(p->ws + O_Y); const u16* gp = (const u16*)(p->ws + ((seg & 1) ? O_GATES2 : O_GATES)) + BR * 1024; u16* mg = (u16*)(p->ws + O_MERGED);
  float* mt = (float*)(p->ws + O_SXBC);
  constexpr int k0 = BR * 1024, nkt = BR == 2 ? 64 : 32;
  const int m0 = (t & 31) * 128, n0 = (t >> 5) * 128;
  f32x4 acc[4][4]; ACC_ZERO(acc);
  gemm_kloop(Y + (size_t)m0 * 4096 + k0, 4096, W + (size_t)n0 * 4096 + k0, 4096, nkt, acc, smem);
  EPI_LOOP2({ l0[j] = cvt4(*(const u32x2*)(gp + (size_t)row * 3072 + col)); if (BR > 0) l1[j] = *(const f32x4*)(mt + MT_ROW(row) + col); else l1[j] = f4z(); },
            { const f32x4 gsum = l1[j] + l0[j] * v; if (BR < 2) *(f32x4*)(mt + MT_ROW(row) + col) = gsum; else *(u32x2*)(mg + (size_t)row * 1024 + col) = pack4v(gsum); })
}
__device__ __forceinline__ void merge_item(PP p, int layer, int seg, int t, char* smem) {
  merge_tile<0>(p, layer, seg, t, smem);
  merge_tile<1>(p, layer, seg, t, smem);
  merge_tile<2>(p, layer, seg, t, smem);
}
__device__ __forceinline__ void ph_merge(PP p, int layer, int seg, int bid, int nb, char* smem) {
#pragma unroll 1
  for (int t = bid; t < 256; t += nb) merge_item(p, layer, seg, t, smem);
}
__device__ __forceinline__ void ph_out(PP p, int layer, int seg, int bid, int nb, char* smem) {
  const u16* W = (const u16*)(p->ws + O_W) + (size_t)layer * W_LAYER + WOUT;
  const u16* mg = (const u16*)(p->ws + O_MERGED);
  const float* xs = layer == 0 ? p->in[0] : p->out;
  for (int t = bid; t < 256; t += nb) {
    const int m0 = (t & 31) * 128, n0 = (t >> 5) * 128;
    f32x4 acc[4][4]; ACC_ZERO(acc);
    gemm_kloop(mg + (size_t)m0 * 1024, 1024, W + (size_t)n0 * 1024, 1024, 32, acc, smem);
    EPI_LOOP2({ size_t gr = (size_t)(row >> 9) * SEQ + seg * SL + (row & 511); l0[j] = *(const f32x4*)(xs + gr * 1024 + col); },
              { size_t gr = (size_t)(row >> 9) * SEQ + seg * SL + (row & 511); *(f32x4*)(p->out + gr * 1024 + col) = l0[j] + v; })
  }
}
__device__ __forceinline__ void ph_ffi(PP p, int layer, int bid, int nb, char* smem) {
  const u16* W = (const u16*)(p->ws + O_W) + (size_t)layer * W_LAYER + WFFI;
  const u16* H2 = (const u16*)(p->ws + O_H2); u16* hid = (u16*)(p->ws + O_HID);
  for (int t = bid; t < 128 * 44; t += nb) {
    const int m0 = (t & 127) * 256, n0 = (t >> 7) * 128;
    f32x4 acc[8][4]; ACC_ZERO(acc);
    gemm_kloop(H2 + (size_t)m0 * 1024, 1024, W + (size_t)n0 * 1024, 1024, 32, acc, smem);
    const int lane = tidx() & 63, wave = tidx() >> 6, wm = wave >> 1, wn = wave & 1;
#pragma unroll
    for (int i = 0; i < 8; i++)
#pragma unroll
      for (int j = 0; j < 4; j += 2) {
        const int row = m0 + wm * 128 + i * 16 + (lane & 15);
        const int ng = n0 + wn * 64 + j * 16 + (lane >> 4) * 4;
        const int hc = (ng >> 5) * 16 + (ng & 15);
        const f32x4 g = acc[i][j], u = acc[i][j + 1];
        *(u32x2*)(hid + (size_t)row * 2816 + hc) = pack4v(g * sigm4(g) * u);
      }
  }
}
__device__ __forceinline__ void ph_ffo(PP p, int layer, int bid, int nb, char* smem) {
  const u16* W = (const u16*)(p->ws + O_W) + (size_t)layer * W_LAYER + WFFO;
  const u16* hid = (const u16*)(p->ws + O_HID);
  for (int t = bid; t < 128 * 8; t += nb) {
    const int m0 = (t & 127) * 256, n0 = (t >> 7) * 128;
    f32x4 acc[8][4]; ACC_ZERO(acc);
    gemm_kloop(hid + (size_t)m0 * 2816, 2816, W + (size_t)n0 * 2816, 2816, 88, acc, smem);
    float* outp = p->out;
    EPI_LOOP2({ l0[j] = *(const f32x4*)(outp + (size_t)row * 1024 + col); }, { *(f32x4*)(outp + (size_t)row * 1024 + col) = l0[j] + v; })
  }
}

__device__ __forceinline__ void ph_norm1(PP p, int layer, int seg, int bid, int nb) {
  if (seg == 0) {
    u16* urw = (u16*)(p->ws + O_URW); u16* sxbc = (u16*)(p->ws + O_SXBC);
    const int gt = bid * NTHR + tidx(), gs = nb * NTHR;
    for (int idx = gt; idx < 8 * 3456; idx += gs) { int b = idx / 3456, c = idx - b * 3456; urw[(size_t)(b * 513) * 3456 + c] = 0; }
    for (int idx = gt; idx < 8 * 9216; idx += gs) { int b = idx / 9216, c = idx - b * 9216; sxbc[(size_t)(b * 515) * 3072 + c] = 0; }
  }
  rmsnorm_rows(layer == 0 ? p->in[0] : p->out, p->in[1] + layer * 1024, (u16*)(p->ws + O_H), nullptr, RS, 0, seg, bid, nb);
}

#define XB_TMO      128
#define XB_XCNT(j)  (256  + 64 * (j))
#define XB_XSUB(j)  (1280 + 64 * (j))
#define XB_XGEN(j)  (2304 + 64 * (j))
#define XB_TOP      3328
#define XB_TOPGEN   3392
#define XCD_BAR_WORDS 3456
#define XB_SPIN_CAP (1u << 22)
__device__ __forceinline__ unsigned xb_ld(unsigned* p)              { return __hip_atomic_load(p, __ATOMIC_RELAXED, __HIP_MEMORY_SCOPE_AGENT); }
__device__ __forceinline__ unsigned xb_add(unsigned* p, unsigned v) { return __hip_atomic_fetch_add(p, v, __ATOMIC_RELAXED, __HIP_MEMORY_SCOPE_AGENT); }
__device__ __forceinline__ unsigned xb_xcc_id() { return (unsigned)__builtin_amdgcn_s_getreg((3 << 11) | 20) & 0xFu; }
#define XB_SPIN(cond, bar) do { unsigned _sp = 0; while (cond) { __builtin_amdgcn_s_sleep(1); \
    if ((++_sp & 255u) == 0u) { if (xb_ld(&(bar)[XB_TMO])) break; if (_sp > XB_SPIN_CAP) { atomicAdd(&(bar)[XB_TMO], 1u); break; } } } } while (0)
struct XcdBarrier { unsigned* bar; unsigned x; volatile LAS unsigned* st; };
__device__ __forceinline__ XcdBarrier xcd_barrier_post(unsigned* bar, volatile LAS unsigned* st) {
  XcdBarrier b; b.bar = bar; b.x = xb_xcc_id(); b.st = st;
  if (threadIdx.x == 0) (void)xb_add(&bar[XB_XCNT(b.x)], 1u);
  return b;
}
__device__ __forceinline__ void xcd_barrier_complete(unsigned* bar, unsigned x, unsigned& nloc, unsigned& nx) {
  const unsigned G = gridDim.x * gridDim.y * gridDim.z;
  unsigned sum, cnt, mine, sp = 0u;
  for (;;) {
    sum = 0u; cnt = 0u; mine = 0u;
#pragma unroll
    for (unsigned j = 0; j < 16; ++j) { const unsigned c = xb_ld(&bar[XB_XCNT(j)]); sum += c; cnt += (c > 0u) ? 1u : 0u; mine = (j == x) ? c : mine; }
    if (sum == G) break;
    __builtin_amdgcn_s_sleep(1);
    if ((++sp & 255u) == 0u) { if (xb_ld(&bar[XB_TMO])) break; if (sp > XB_SPIN_CAP) { atomicAdd(&bar[XB_TMO], 1u); break; } }
  }
  nloc = mine > 0u ? mine : 1u; nx = cnt > 0u ? cnt : 1u;
}
__device__ __forceinline__ void xcd_barrier(const XcdBarrier& b) {
  asm volatile("s_waitcnt vmcnt(0)" ::: "memory");
  __syncthreads();
  if (threadIdx.x == 0) {
    unsigned* bar = b.bar;
    __builtin_amdgcn_s_waitcnt(0);
    unsigned nloc = b.st[0], nx = b.st[1];
    if (nloc == 0u) { xcd_barrier_complete(bar, b.x, nloc, nx); b.st[0] = nloc; b.st[1] = nx; }
    const unsigned old = xb_add(&bar[XB_XSUB(b.x)], 1u);
    const unsigned gen = old / nloc;
    if (old + 1u == (gen + 1u) * nloc) {
      __builtin_amdgcn_fence(__ATOMIC_RELEASE, "agent");
      asm volatile("s_waitcnt vmcnt(0)" ::: "memory");
      const unsigned og = xb_add(&bar[XB_TOP], 1u);
      const unsigned tg = og / nx;
      if (og + 1u == (tg + 1u) * nx) xb_add(&bar[XB_TOPGEN], 1u);
      else XB_SPIN(xb_ld(&bar[XB_TOPGEN]) == tg, bar);
      __builtin_amdgcn_fence(__ATOMIC_ACQUIRE, "agent");
      xb_add(&bar[XB_XGEN(b.x)], 1u);
      asm volatile("s_waitcnt vmcnt(0)" ::: "memory");
    } else {
      XB_SPIN(xb_ld(&bar[XB_XGEN(b.x)]) == gen, bar);
      __builtin_amdgcn_fence(__ATOMIC_ACQUIRE, "agent");
      asm volatile("s_waitcnt vmcnt(0)" ::: "memory");
    }
  }
  __syncthreads();
}

#define SMEM_BYTES 73728
#ifndef SCANPROBE
#define SCANPROBE 0
#endif
#ifndef PHMASK
#define PHMASK 0xFFFF
#endif
#ifndef DBLMASK
#define DBLMASK 0
#endif
#define RUN(idx, call) { if ((PHMASK >> (idx)) & 1) { if ((DBLMASK >> (idx)) & 1) { call; __syncthreads(); } call; } }
__global__ void __launch_bounds__(NTHR, 2) mega(Params p_) {
  __shared__ __attribute__((aligned(1024))) char smem[SMEM_BYTES + 16];
  uint4& xb_words = *(uint4*)(smem + SMEM_BYTES);
  cg::grid_group grid = cg::this_grid();
  if (threadIdx.x == 0) xb_words = make_uint4(0u, 0u, 0u, 0u);
  __syncthreads();
  XcdBarrier xb = xcd_barrier_post((unsigned*)(p_.ws + O_BAR), (volatile LAS unsigned*)&xb_words);
  {
    PP p = (PP)__builtin_amdgcn_kernarg_segment_ptr();
    RUN(0, ph_wconv(p, blockIdx.x, gridDim.x, smem))
  }
  if (p_.out == nullptr) grid.sync();
  xcd_barrier(xb);
#pragma unroll 1
  for (int pc = 0; pc < 151; pc++) {
    PP p = (PP)__builtin_amdgcn_kernarg_segment_ptr();
    asm volatile("" : "+s"(p));
    int bid = blockIdx.x, nb = gridDim.x;
    asm volatile("" : "+s"(bid), "+s"(nb));
    const int l = pc / 75, q = pc - l * 75;
    bool did = true;
    if (pc == 150) {
      RUN(13, rmsnorm_rows(p->out, p->in[27], nullptr, p->out, TTOK, 2, 0, bid, nb))
      did = false;
    } else if (q >= 72) {
      if (q == 72) RUN(10, rmsnorm_rows(p->out, p->in[24] + l * 1024, (u16*)(p->ws + O_H2), nullptr, TTOK, 1, 0, bid, nb))
      else if (q == 73) RUN(11, ph_ffi(p, l, bid, nb, smem))
      else RUN(12, ph_ffo(p, l, bid, nb, smem))
    } else {
      const int sg = q / 9, st = q - sg * 9;
      switch (st) {
        case 0: if (sg == 0) RUN(1, ph_norm1(p, l, 0, bid, nb)) else did = false; break;
        case 1: RUN(2, ph_inproj(p, l, sg, bid, nb, smem)) break;
        case 2: RUN(3, ph_elem(p, l, sg, bid, nb)) if (sg + 1 < NSEG) RUN(1, ph_norm1(p, l, sg + 1, bid, nb)) break;
        case 3: RUN(4, ph_lora(p, l, bid, nb, smem)) break;
        case 4: RUN(5, ph_rprep(p, l, bid, nb)) break;
        case 5: ph_scan(p, l, sg, bid, nb, smem, ((volatile LAS unsigned*)&xb_words) + 2); break;
        case 6: RUN(7, ph_post(p, l, bid, nb)) if (sg > 0) RUN(9, ph_out(p, l, sg - 1, bid, nb, smem)) break;
        case 7: if (sg == NSEG - 1) RUN(8, ph_merge(p, l, sg, bid, nb, smem)) else did = false; break;
        default: if (sg == NSEG - 1) RUN(9, ph_out(p, l, sg, bid, nb, smem)) else did = false; break;
      }
    }
    if (did) xcd_barrier(xb);
  }
}

extern "C" void kernel_launch(void* const* d_in, const int* in_sizes, int n_in, void* d_out, int out_size, void* d_ws,
                              size_t ws_size, hipStream_t stream) {
  Params p{};
  for (int i = 0; i < 28; i++) p.in[i] = (const float*)d_in[i];
  p.out = (float*)d_out; p.ws = (char*)d_ws;
  static int grid_blocks = 0;
  if (!grid_blocks) {
    int dev = 0, cus = 0, per_cu = 0;
    hipGetDevice(&dev);
    hipDeviceGetAttribute(&cus, hipDeviceAttributeMultiprocessorCount, dev);
    hipOccupancyMaxActiveBlocksPerMultiprocessor(&per_cu, mega, NTHR, 0);
    if (per_cu > 2) per_cu = 2;
    if (per_cu < 1) per_cu = 1;
    grid_blocks = cus * per_cu;
  }
  hipMemsetAsync((char*)d_ws + O_BAR, 0, 16384, stream);
  void* args[] = {&p};
  hipError_t e = hipLaunchCooperativeKernel((void*)mega, dim3(grid_blocks), dim3(NTHR), args, 0, stream);
  if (e != hipSuccess) fprintf(stderr, "cooperative launch failed: %s (grid %d)\n", hipGetErrorString(e), grid_blocks);
}
```

```cpp
#include <hip/hip_runtime.h>
#include <hip/hip_cooperative_groups.h>
#include <stdint.h>
#include <stdio.h>
namespace cg = cooperative_groups;

typedef unsigned short u16;
using bf16x8 = __attribute__((ext_vector_type(8))) short;
using f32x4  = __attribute__((ext_vector_type(4))) float;
using u32x4 = __attribute__((ext_vector_type(4))) unsigned int;
using u32x2 = __attribute__((ext_vector_type(2))) unsigned int;

#define DM 1024
#define SEQ 4096
#define TTOK 32768
#define SL 512
#define NSEG 8
#define RS 4096
#define NTHR 256
#ifndef SCANPROBE
#define SCANPROBE 0
#endif

constexpr size_t al(size_t x) { return (x + 255) & ~(size_t)255; }
constexpr size_t WIN = 0;
constexpr size_t WWUP = WIN + (size_t)15872 * 1024;
constexpr size_t WAUP = WWUP + 65536;
constexpr size_t WGUP = WAUP + 65536;
constexpr size_t WBR = WGUP + 196608;
constexpr size_t WOUT = WBR + 4194304;
constexpr size_t WFFI = WOUT + 1048576;
constexpr size_t WFFO = WFFI + 5767168;
constexpr size_t W_LAYER = WFFO + 2883584;
constexpr size_t O_W = 0;
constexpr size_t O_H = al(O_W + 2 * W_LAYER * 2);
constexpr size_t O_URW = al(O_H + (size_t)RS * 1024 * 2);
constexpr size_t O_HQ = al(O_URW + (size_t)8 * 513 * 3456 * 2);
constexpr size_t O_HV = al(O_HQ + (size_t)RS * 1024 * 2);
constexpr size_t O_HG = al(O_HV + (size_t)RS * 1024 * 2);
constexpr size_t O_HW = al(O_HG + (size_t)RS * 1024 * 2);
constexpr size_t O_SZ = al(O_HW + (size_t)RS * 1024 * 4);
constexpr size_t O_SXBC = al(O_SZ + (size_t)RS * 2048 * 2);
constexpr size_t O_SDT = al(O_SXBC + (size_t)8 * 515 * 3072 * 2);
constexpr size_t O_SWD = al(O_SDT + (size_t)RS * 32 * 4);
constexpr size_t O_GATES = al(O_SWD + (size_t)RS * 32 * 4);
constexpr size_t O_LAW = al(O_GATES + (size_t)RS * 3072 * 2);
constexpr size_t O_LAA = al(O_LAW + (size_t)RS * 64 * 2);
constexpr size_t O_LAG = al(O_LAA + (size_t)RS * 64 * 2);
constexpr size_t O_SX2 = al(O_LAG + (size_t)RS * 192 * 2);
constexpr size_t O_RWW = al(O_SX2 + (size_t)RS * 3072 * 2);
constexpr size_t O_RWA = al(O_RWW + (size_t)RS * 1024 * 4);
constexpr size_t O_RWG = al(O_RWA + (size_t)RS * 1024 * 2);
constexpr size_t O_PR = al(O_RWG + (size_t)RS * 1024 * 2);
constexpr size_t O_PK = al(O_PR + (size_t)RS * 1024 * 2);
constexpr size_t O_PV = al(O_PK + (size_t)RS * 1024 * 2);
constexpr size_t O_PKA = al(O_PV + (size_t)RS * 1024 * 2);
constexpr size_t O_PKB = al(O_PKA + (size_t)RS * 1024 * 2);
constexpr size_t O_BONUS = al(O_PKB + (size_t)RS * 1024 * 2);
constexpr size_t O_SO = al(O_BONUS + (size_t)RS * 16 * 4);
constexpr size_t O_Y = al(O_SO + (size_t)RS * 4096 * 4);
constexpr size_t O_MERGED = al(O_Y + (size_t)RS * 4096 * 2);
constexpr size_t O_STRW = al(O_MERGED + (size_t)RS * 1024 * 2);
constexpr size_t O_STHG = al(O_STRW + (size_t)128 * 64 * 64 * 4);
constexpr size_t O_STSS = al(O_STHG + (size_t)64 * 128 * 128 * 4);
constexpr size_t O_END = al(O_STSS + (size_t)256 * 64 * 128 * 4);
constexpr size_t O_H2 = O_H;
constexpr size_t O_HID = al(O_H2 + (size_t)TTOK * 1024 * 2);
constexpr size_t O_END2 = al(O_HID + (size_t)TTOK * 2816 * 2);
constexpr size_t O_HK = O_END;
constexpr size_t O_GATES2 = al(O_HK + (size_t)RS * 1024 * 2);
constexpr size_t O_BAR = al(O_GATES2 + (size_t)RS * 3072 * 2);
static_assert(O_BAR + 16384 <= (size_t)536870912, "ws overflow");
static_assert(O_END2 <= (size_t)536870912, "ws overflow2");

#define LAS __attribute__((address_space(3)))
struct Params { const float* in[28]; float* out; char* ws; };
typedef const __attribute__((address_space(4))) Params* PP;

enum { PH_WCONV = 0, PH_NORM1, PH_INPROJ, PH_ELEM, PH_LORA, PH_RPREP, PH_SCAN, PH_POST, PH_MERGE, PH_OUT,
       PH_NORM2, PH_FFI, PH_FFO, PH_FINAL };

__device__ __forceinline__ float bf2f(u16 u) { return __uint_as_float(((unsigned)u) << 16); }
__device__ __forceinline__ u16 f2bf(float f) { unsigned u = __float_as_uint(f); u += 0x7fffu + ((u >> 16) & 1u); return (u16)(u >> 16); }
__device__ __forceinline__ float sigm(float x) { return 1.f / (1.f + __expf(-x)); }
__device__ __forceinline__ float wave_sum(float x) {
#pragma unroll
  for (int o = 32; o; o >>= 1) x += __shfl_xor(x, o);
  return x;
}
__device__ __forceinline__ f32x4 cvt4(u32x2 v) {
  f32x4 r; r.x = __uint_as_float(v.x << 16); r.y = __uint_as_float(v.x & 0xffff0000u);
  r.z = __uint_as_float(v.y << 16); r.w = __uint_as_float(v.y & 0xffff0000u); return r;
}
template <int CTRL> __device__ __forceinline__ float dppf(float x) {
  return __int_as_float(__builtin_amdgcn_update_dpp(0, __float_as_int(x), CTRL, 0xF, 0xF, true));
}
__device__ __forceinline__ float red16(float x) {
  x += dppf<0xB1>(x); x += dppf<0x4E>(x); x += dppf<0x141>(x); x += dppf<0x140>(x); return x;
}
__device__ __forceinline__ unsigned pk2(float a, float b) { return (unsigned)f2bf(a) | ((unsigned)f2bf(b) << 16); }
__device__ __forceinline__ u32x2 pack4(float a, float b, float c, float d) {
  u32x2 r; r.x = (unsigned)f2bf(a) | ((unsigned)f2bf(b) << 16); r.y = (unsigned)f2bf(c) | ((unsigned)f2bf(d) << 16); return r;
}
__device__ __forceinline__ f32x4 f4z() { return (f32x4){0.f, 0.f, 0.f, 0.f}; }
__device__ __forceinline__ f32x4 sigm4(f32x4 x) { f32x4 r; r[0] = sigm(x[0]); r[1] = sigm(x[1]); r[2] = sigm(x[2]); r[3] = sigm(x[3]); return r; }
__device__ __forceinline__ u32x2 pack4v(f32x4 x) { return pack4(x[0], x[1], x[2], x[3]); }
__device__ __forceinline__ float red4(float x) { x += dppf<0xB1>(x); x += dppf<0x4E>(x); return x; }
__device__ __forceinline__ float red8(float x) {
  x += dppf<0xB1>(x); x += dppf<0x4E>(x); x += dppf<0x141>(x); return x;
}

__device__ __forceinline__ int tidx() { int t = threadIdx.x; asm volatile("" : "+v"(t)); return t; }
__device__ __forceinline__ int remap_col(int kind, int n, int nsrc) {
  if (kind == 0) return n < nsrc ? n : -1;
  if (kind == 1) {
    if (n < 3456) return n < 3360 ? n : -1;
    if (n < 7552) return 3360 + (n - 3456);
    if (n < 12800) { int c = n - 7552; return c < 5152 ? 7456 + c : -1; }
    return 12608 + (n - 12800);
  }
  int blk = n >> 5, w = n & 31;
  return w < 16 ? blk * 16 + w : 2816 + blk * 16 + (w - 16);
}
__device__ __forceinline__ void tconv(const float* __restrict__ src, int K, int Nsrc, u16* __restrict__ dst, int Kpad, int Npad,
                      int kind, int bid, int nb, char* smem) {
  float(*tile)[65] = (float(*)[65])smem;
  const int tn = Npad >> 6, tk = Kpad >> 6, tid = tidx();
  for (int t = bid; t < tn * tk; t += nb) {
    const int n0 = (t % tn) << 6, k0 = (t / tn) << 6;
    const int nn = tid & 63, c = remap_col(kind, n0 + nn, Nsrc);
#pragma unroll
    for (int i = 0; i < 16; i++) {
      int kk = (tid >> 6) + 4 * i, k = k0 + kk;
      tile[kk][nn] = (k < K && c >= 0) ? src[(size_t)k * Nsrc + c] : 0.f;
    }
    __syncthreads();
#pragma unroll
    for (int i = 0; i < 16; i++) {
      int n2 = (tid >> 6) + 4 * i, kk = tid & 63;
      dst[(size_t)(n0 + n2) * Kpad + k0 + kk] = f2bf(tile[kk][n2]);
    }
    __syncthreads();
  }
}
__device__ __forceinline__ void ph_wconv(PP p, int bid, int nb, char* smem) {
  for (int l = 0; l < 2; l++) {
    u16* W = (u16*)(p->ws + O_W) + (size_t)l * W_LAYER;
    tconv(p->in[2] + (size_t)l * 1024 * 15680, 1024, 15680, W + WIN, 1024, 15872, 1, bid, nb, smem);
    tconv(p->in[5] + (size_t)l * 64 * 1024, 64, 1024, W + WWUP, 64, 1024, 0, bid, nb, smem);
    tconv(p->in[7] + (size_t)l * 64 * 1024, 64, 1024, W + WAUP, 64, 1024, 0, bid, nb, smem);
    tconv(p->in[8] + (size_t)l * 160 * 1024, 160, 1024, W + WGUP, 192, 1024, 0, bid, nb, smem);
    tconv(p->in[22] + (size_t)l * 4096 * 1024, 4096, 1024, W + WBR, 4096, 1024, 0, bid, nb, smem);
    tconv(p->in[23] + (size_t)l * 1024 * 1024, 1024, 1024, W + WOUT, 1024, 1024, 0, bid, nb, smem);
    tconv(p->in[25] + (size_t)l * 1024 * 5632, 1024, 5632, W + WFFI, 1024, 5632, 2, bid, nb, smem);
    tconv(p->in[26] + (size_t)l * 2816 * 1024, 2816, 1024, W + WFFO, 2816, 1024, 0, bid, nb, smem);
  }
}

__device__ __forceinline__ void rmsnorm_rows(const float* __restrict__ xs, const float* __restrict__ gain, u16* dst, float* dstf,
                             int nrows, int mode, int seg, int bid, int nb) {
  const int lane = tidx() & 63, wv = tidx() >> 6;
  for (int r = bid * 4 + wv; r < nrows; r += nb * 4) {
    size_t srow = (mode == 0) ? ((size_t)(r >> 9) * SEQ + seg * SL + (r & 511)) : (size_t)r;
    const float4* xp = (const float4*)(xs + srow * DM);
    float4 v[4]; float ss = 0.f;
#pragma unroll
    for (int i = 0; i < 4; i++) { v[i] = xp[lane + 64 * i]; ss += v[i].x * v[i].x + v[i].y * v[i].y + v[i].z * v[i].z + v[i].w * v[i].w; }
    ss = wave_sum(ss);
    float rstd = rsqrtf(ss * (1.f / DM) + 1e-5f);
#pragma unroll
    for (int i = 0; i < 4; i++) {
      float4 g = ((const float4*)gain)[lane + 64 * i];
      float a = v[i].x * rstd * g.x, b = v[i].y * rstd * g.y, c = v[i].z * rstd * g.z, d = v[i].w * rstd * g.w;
      if (mode == 2) { float4 o; o.x = a; o.y = b; o.z = c; o.w = d; ((float4*)(dstf + (size_t)r * DM))[lane + 64 * i] = o; }
      else { uint2 o; o.x = (unsigned)f2bf(a) | ((unsigned)f2bf(b) << 16); o.y = (unsigned)f2bf(c) | ((unsigned)f2bf(d) << 16);
             ((uint2*)(dst + (size_t)r * DM))[lane + 64 * i] = o; }
    }
  }
}

#define WAIT_V(n) asm volatile("s_waitcnt vmcnt(%0)" ::"n"(n) : "memory")
#define WAIT_L(n) asm volatile("s_waitcnt lgkmcnt(%0)" ::"n"(n) : "memory")
#define RAW_BARRIER() do { WAIT_L(0); __builtin_amdgcn_s_barrier(); } while (0)
template <int MI>
__device__ __forceinline__ void gemm_kloop(const u16* __restrict__ A, int lda, const u16* __restrict__ B, int ldb, int nkt,
                                           f32x4 (&acc)[MI][4], char* smem) {
  constexpr int NA = MI / 2, ABYTES = MI * 32 * 64, STB = ABYTES + 8192, NST = (MI == 4) ? 4 : 3, LPT = NA + 2;
  const int tid = tidx(), lane = tid & 63, wave = tid >> 6, wm = wave >> 1, wn = wave & 1;
  const int wu = __builtin_amdgcn_readfirstlane(wave);
  const u16* ga[NA]; const u16* gb[2];
#pragma unroll
  for (int i = 0; i < NA; i++) {
    const int r = (wu * NA + i) * 16 + (lane >> 2), kc = (lane & 3) ^ ((r >> 2) & 3);
    ga[i] = A + (size_t)r * lda + kc * 8;
  }
#pragma unroll
  for (int i = 0; i < 2; i++) {
    const int r = (wu * 2 + i) * 16 + (lane >> 2), kc = (lane & 3) ^ ((r >> 2) & 3);
    gb[i] = B + (size_t)r * ldb + kc * 8;
  }
  LAS char* sm = (LAS char*)smem;
#define GSTAGE(st_, kt_) { \
    _Pragma("unroll") for (int i = 0; i < NA; i++) \
      __builtin_amdgcn_global_load_lds((const unsigned*)(ga[i] + (kt_) * 32), (LAS unsigned*)(sm + (st_) * STB + (wu * NA + i) * 1024), 16, 0, 0); \
    _Pragma("unroll") for (int i = 0; i < 2; i++) \
      __builtin_amdgcn_global_load_lds((const unsigned*)(gb[i] + (kt_) * 32), (LAS unsigned*)(sm + (st_) * STB + ABYTES + (wu * 2 + i) * 1024), 16, 0, 0); }
  __syncthreads();
#pragma unroll
  for (int s0 = 0; s0 < NST - 1; s0++) if (s0 < nkt) GSTAGE(s0, s0)
  const int frow = lane & 15, fg = lane >> 4;
  const int fo = (frow * 4 + (fg ^ ((frow >> 2) & 3))) * 16;
  const int offA = (wm * MI * 16) * 64 + fo, offB = ABYTES + (wn * 64) * 64 + fo;
  int st = 0;
#pragma unroll 1
  for (int kt = 0; kt < nkt; kt++) {
    if (NST == 4) { if (kt + 2 < nkt) WAIT_V(2 * LPT); else if (kt + 1 < nkt) WAIT_V(LPT); else WAIT_V(0); }
    else { if (kt + 1 < nkt) WAIT_V(LPT); else WAIT_V(0); }
    RAW_BARRIER();
    if (kt + NST - 1 < nkt) { const int sn = (st + NST - 1 >= NST) ? st - 1 : st + NST - 1; GSTAGE(sn, kt + NST - 1) }
    const LAS char* sp = sm + st * STB;
    bf16x8 af[MI], bfr[4];
#pragma unroll
    for (int i = 0; i < MI; i++) af[i] = *(const LAS bf16x8*)(sp + offA + i * 1024);
#pragma unroll
    for (int i = 0; i < 4; i++) bfr[i] = *(const LAS bf16x8*)(sp + offB + i * 1024);
    __builtin_amdgcn_s_setprio(1);
#pragma unroll
    for (int i = 0; i < MI; i++)
#pragma unroll
      for (int j = 0; j < 4; j++) acc[i][j] = __builtin_amdgcn_mfma_f32_16x16x32_bf16(bfr[j], af[i], acc[i][j], 0, 0, 0);
    __builtin_amdgcn_s_setprio(0);
    st = (st + 1 == NST) ? 0 : st + 1;
  }
  RAW_BARRIER();
}
#define ACC_ZERO(acc) { _Pragma("unroll") for (int i = 0; i < (int)(sizeof(acc) / sizeof(acc[0])); i++) _Pragma("unroll") for (int j = 0; j < 4; j++) acc[i][j] = (f32x4){0.f, 0.f, 0.f, 0.f}; }
#define EPI_LOOP(BODY) { constexpr int MI_ = (int)(sizeof(acc) / sizeof(acc[0])); const int lane_ = tidx() & 63, wave_ = tidx() >> 6, wm_ = wave_ >> 1, wn_ = wave_ & 1; \
  _Pragma("unroll") for (int i = 0; i < MI_; i++) { _Pragma("unroll") for (int j = 0; j < 4; j++) { \
    const int row = m0 + wm_ * (MI_ * 16) + i * 16 + (lane_ & 15); const int col = n0 + wn_ * 64 + j * 16 + (lane_ >> 4) * 4; const f32x4 v = acc[i][j]; BODY } \
    asm volatile("" ::: "memory"); } }
#define EPI_LOOP2(LOAD, STORE) { constexpr int MI_ = (int)(sizeof(acc) / sizeof(acc[0])); const int lane_ = tidx() & 63, wave_ = tidx() >> 6, wm_ = wave_ >> 1, wn_ = wave_ & 1; \
  _Pragma("unroll") for (int i = 0; i < MI_; i++) { f32x4 l0[4], l1[4]; \
    _Pragma("unroll") for (int j = 0; j < 4; j++) { \
      const int row = m0 + wm_ * (MI_ * 16) + i * 16 + (lane_ & 15); const int col = n0 + wn_ * 64 + j * 16 + (lane_ >> 4) * 4; LOAD } \
    asm volatile("" ::: "memory"); \
    _Pragma("unroll") for (int j = 0; j < 4; j++) { \
      const int row = m0 + wm_ * (MI_ * 16) + i * 16 + (lane_ & 15); const int col = n0 + wn_ * 64 + j * 16 + (lane_ >> 4) * 4; const f32x4 v = acc[i][j]; STORE } \
    asm volatile("" ::: "memory"); } }
#define COLJ(j) (n0 + ((tidx() >> 6) & 1) * 64 + (j) * 16 + ((tidx() & 63) >> 4) * 4)
__device__ __forceinline__ void ph_inproj(PP p, int layer, int seg, int bid, int nb, char* smem) {
  const u16* W = (const u16*)(p->ws + O_W) + (size_t)layer * W_LAYER + WIN;
  const u16* H = (const u16*)(p->ws + O_H);
  u16* urw = (u16*)(p->ws + O_URW); u16* hq = (u16*)(p->ws + O_HQ); u16* hv = (u16*)(p->ws + O_HV); u16* hg = (u16*)(p->ws + O_HG);
  float* hw = (float*)(p->ws + O_HW); u16* hk = (u16*)(p->ws + O_HK); u16* sz = (u16*)(p->ws + O_SZ); u16* sxbc = (u16*)(p->ws + O_SXBC);
  float* sdt = (float*)(p->ws + O_SDT); u16* gates = (u16*)(p->ws + ((seg & 1) ? O_GATES2 : O_GATES));
  const float* lbl = p->in[14];
  const float* dtb = p->in[18] + layer * 32;
  for (int t = bid; t < 16 * 124; t += nb) {
    const int m0 = (t & 15) * 256, n0 = (t >> 4) * 128;
    f32x4 acc[8][4]; ACC_ZERO(acc);
    gemm_kloop(H + (size_t)m0 * 1024, 1024, W + (size_t)n0 * 1024, 1024, 32, acc, smem);
    if (n0 < 3456) {
      EPI_LOOP({ if (col < 3360) *(u32x2*)(urw + ((size_t)((row >> 9) * 513 + 1 + (row & 511))) * 3456 + col) = pack4v(v); })
    } else if (n0 < 7552) {
      const int which = (n0 - 3456) >> 10;
      if (which == 0) { EPI_LOOP({ int cc = (col - 3456) & 1023; *(u32x2*)(hq + (size_t)row * 1024 + cc) = pack4v(v * sigm4(v)); }) }
      else if (which == 1) {
        f32x4 lbj[4];
#pragma unroll
        for (int j = 0; j < 4; j++) {
          int cc = (COLJ(j) - 3456) & 1023;
          f32x4 l0 = *(const f32x4*)(lbl + cc), l1 = *(const f32x4*)(lbl + 1024 + cc);
#pragma unroll
          for (int e = 0; e < 4; e++) lbj[j][e] = layer == 0 ? 0.f : 1.f / (1.f + __expf(l0[e] - l1[e]));
        }
        EPI_LOOP({ int cc = (col - 3456) & 1023; const f32x4 lb = lbj[j];
                   f32x4 sg = sigm4(v); f32x4 w = lb + (1.f - lb) * sg; f32x4 lf;
                   lf[0] = fmaxf(__logf(w[0]), -60.f); lf[1] = fmaxf(__logf(w[1]), -60.f); lf[2] = fmaxf(__logf(w[2]), -60.f); lf[3] = fmaxf(__logf(w[3]), -60.f);
                   *(f32x4*)(hw + (size_t)row * 1024 + cc) = lf;
                   *(u32x2*)(hk + (size_t)row * 1024 + cc) = pack4v((1.f - lb) * (1.f - sg)); })
      } else if (which == 2) { EPI_LOOP({ int cc = (col - 3456) & 1023; *(u32x2*)(hv + (size_t)row * 1024 + cc) = pack4v(v); }) }
      else { EPI_LOOP({ int cc = (col - 3456) & 1023; *(u32x2*)(hg + (size_t)row * 1024 + cc) = pack4v(sigm4(v)); }) }
    } else if (n0 < 12800) {
      const int c0 = n0 - 7552;
      if (c0 < 2048) { EPI_LOOP({ int c = col - 7552; *(u32x2*)(sz + (size_t)row * 2048 + c) = pack4v(v * sigm4(v)); }) }
      else if (c0 < 5120) { EPI_LOOP({ int c = col - 7552 - 2048; *(u32x2*)(sxbc + ((size_t)((row >> 9) * 515 + 3 + (row & 511))) * 3072 + c) = pack4v(v); }) }
      else {
        f32x4 dbj[4];
#pragma unroll
        for (int j = 0; j < 4; j++) { int c = COLJ(j) - 7552 - 5120; dbj[j] = c < 32 ? *(const f32x4*)(dtb + c) : (f32x4){0.f, 0.f, 0.f, 0.f}; }
        EPI_LOOP({ int c = col - 7552 - 5120; if (c < 32) { f32x4 xx = v + dbj[j]; f32x4 o;
                   o[0] = xx[0] > 20.f ? xx[0] : log1pf(__expf(xx[0])); o[1] = xx[1] > 20.f ? xx[1] : log1pf(__expf(xx[1]));
                   o[2] = xx[2] > 20.f ? xx[2] : log1pf(__expf(xx[2])); o[3] = xx[3] > 20.f ? xx[3] : log1pf(__expf(xx[3]));
                   *(f32x4*)(sdt + (size_t)row * 32 + c) = o; } })
      }
    } else {
      EPI_LOOP({ int c = col - 12800; *(u32x2*)(gates + (size_t)row * 3072 + c) = pack4v(sigm4(v)); })
    }
  }
}

__device__ __forceinline__ void ph_elem(PP p, int layer, int seg, int bid, int nb) {
  const u16* urw = (const u16*)(p->ws + O_URW);
  const float* mu = p->in[3] + layer * 3360;
  u16* law = (u16*)(p->ws + O_LAW); u16* laa = (u16*)(p->ws + O_LAA); u16* lag = (u16*)(p->ws + O_LAG);
  const int gt = bid * NTHR + tidx(), gs = nb * NTHR;
#pragma unroll 1
  for (int idx = gt; idx < RS * 80; idx += gs) {
    const int r = idx / 80, gq = idx - r * 80;
    if (gq >= 72) { u32x2 z; z.x = 0; z.y = 0; *(u32x2*)(lag + (size_t)r * 192 + 160 + (gq - 72) * 4) = z; continue; }
    const int col = 3072 + gq * 4;
    const size_t ro = (size_t)((r >> 9) * 513 + 1 + (r & 511)) * 3456;
    f32x4 cur = cvt4(*(const u32x2*)(urw + ro + col)), prv = cvt4(*(const u32x2*)(urw + ro - 3456 + col));
    f32x4 m4 = *(const f32x4*)(mu + col);
    f32x4 val = cur + (prv - cur) * m4;
    if (gq < 16) *(u32x2*)(law + (size_t)r * 64 + gq * 4) = pack4(tanhf(val[0]), tanhf(val[1]), tanhf(val[2]), tanhf(val[3]));
    else if (gq < 32) *(u32x2*)(laa + (size_t)r * 64 + (gq - 16) * 4) = pack4(val[0], val[1], val[2], val[3]);
    else *(u32x2*)(lag + (size_t)r * 192 + (gq - 32) * 4) = pack4(sigm(val[0]), sigm(val[1]), sigm(val[2]), sigm(val[3]));
  }
  const u16* sxbc = (const u16*)(p->ws + O_SXBC); u16* sx2 = (u16*)(p->ws + O_SX2);
  const float* cw = p->in[16] + (size_t)layer * 3072 * 4; const float* cb = p->in[17] + layer * 3072;
#pragma unroll 1
  for (int idx = gt; idx < (RS / 4) * 384; idx += gs) {
    const int rb = idx / 384, cg = idx - rb * 384, r = rb * 4, ch = cg * 8;
    const size_t ro = (size_t)((r >> 9) * 515 + (r & 511)) * 3072 + ch;
    u32x4 xin[7];
#pragma unroll
    for (int j = 0; j < 7; j++) xin[j] = *(const u32x4*)(sxbc + ro + (size_t)j * 3072);
    f32x4 w4[8];
#pragma unroll
    for (int c = 0; c < 8; c++) w4[c] = *(const f32x4*)(cw + (size_t)(ch + c) * 4);
    f32x4 b0 = *(const f32x4*)(cb + ch), b1 = *(const f32x4*)(cb + ch + 4);
#pragma unroll
    for (int rr = 0; rr < 4; rr++) {
      float o[8];
#pragma unroll
      for (int c = 0; c < 8; c++) {
        float acc = c < 4 ? b0[c] : b1[c - 4];
#pragma unroll
        for (int j = 0; j < 4; j++) {
          const unsigned wd = xin[rr + j][c >> 1];
          const float xv = (c & 1) ? __uint_as_float(wd & 0xffff0000u) : __uint_as_float(wd << 16);
          acc = fmaf(xv, w4[c][j], acc);
        }
        o[c] = acc * sigm(acc);
      }
      u32x4 ov; ov.x = pk2(o[0], o[1]); ov.y = pk2(o[2], o[3]); ov.z = pk2(o[4], o[5]); ov.w = pk2(o[6], o[7]);
      *(u32x4*)(sx2 + (size_t)(r + rr) * 3072 + ch) = ov;
    }
  }
}

__device__ __forceinline__ void ph_lora(PP p, int layer, int bid, int nb, char* smem) {
  const u16* W = (const u16*)(p->ws + O_W) + (size_t)layer * W_LAYER;
  float* rww = (float*)(p->ws + O_RWW); u16* rwa = (u16*)(p->ws + O_RWA); u16* rwg = (u16*)(p->ws + O_RWG);
  const float* w0 = p->in[4] + layer * 1024; const float* a0 = p->in[6] + layer * 1024;
  for (int t = bid; t < 3 * 256; t += nb) {
    const int job = t >> 8, tt = t & 255, m0 = (tt & 31) * 128, n0 = (tt >> 5) * 128;
    f32x4 acc[4][4]; ACC_ZERO(acc);
    if (job == 0) {
      gemm_kloop((const u16*)(p->ws + O_LAW) + (size_t)m0 * 64, 64, W + WWUP + (size_t)n0 * 64, 64, 2, acc, smem);
      f32x4 pj[4];
#pragma unroll
      for (int j = 0; j < 4; j++) pj[j] = *(const f32x4*)(w0 + COLJ(j));
      EPI_LOOP({ f32x4 sg = sigm4(pj[j] + v); f32x4 o; o[0] = __expf(-0.60653066f * sg[0]); o[1] = __expf(-0.60653066f * sg[1]); o[2] = __expf(-0.60653066f * sg[2]); o[3] = __expf(-0.60653066f * sg[3]);
                 *(f32x4*)(rww + (size_t)row * 1024 + col) = o; })
    } else if (job == 1) {
      gemm_kloop((const u16*)(p->ws + O_LAA) + (size_t)m0 * 64, 64, W + WAUP + (size_t)n0 * 64, 64, 2, acc, smem);
      f32x4 pj[4];
#pragma unroll
      for (int j = 0; j < 4; j++) pj[j] = *(const f32x4*)(a0 + COLJ(j));
      EPI_LOOP({ *(u32x2*)(rwa + (size_t)row * 1024 + col) = pack4v(sigm4(pj[j] + v)); })
    } else {
      gemm_kloop((const u16*)(p->ws + O_LAG) + (size_t)m0 * 192, 192, W + WGUP + (size_t)n0 * 192, 192, 6, acc, smem);
      EPI_LOOP({ *(u32x2*)(rwg + (size_t)row * 1024 + col) = pack4v(v); })
    }
  }
}

__device__ __forceinline__ void ph_rprep(PP p, int layer, int bid, int nb) {
  const u16* urw = (const u16*)(p->ws + O_URW); const u16* rwa = (const u16*)(p->ws + O_RWA);
  u16* pr = (u16*)(p->ws + O_PR); u16* pk = (u16*)(p->ws + O_PK); u16* pv = (u16*)(p->ws + O_PV);
  u16* pka = (u16*)(p->ws + O_PKA); u16* pkb = (u16*)(p->ws + O_PKB); float* bonus = (float*)(p->ws + O_BONUS);
  const float* mu = p->in[3] + layer * 3360; const float* kk_ = p->in[9] + layer * 1024; const float* ka_ = p->in[10] + layer * 1024;
  const float* rk_ = p->in[11] + layer * 1024;
  {
    u16* sxbc = (u16*)(p->ws + O_SXBC);
    const int gt = bid * NTHR + tidx(), gs = nb * NTHR;
    for (int idx = gt; idx < 8 * 3 * 3072; idx += gs) { int b = idx / 9216, c = idx - b * 9216; sxbc[(size_t)(b * 515) * 3072 + c] = sxbc[(size_t)(b * 515 + 512) * 3072 + c]; }
  }
  const int lane = tidx() & 63, wv = tidx() >> 6;
#pragma unroll 1
  for (int task = bid * 4 + wv; task < RS * 4; task += nb * 4) {
    const int r = task >> 2, col = (task & 3) * 256 + lane * 4;
    const size_t ro = (size_t)((r >> 9) * 513 + 1 + (r & 511)) * 3456 + col;
    f32x4 rc = cvt4(*(const u32x2*)(urw + ro)), rp = cvt4(*(const u32x2*)(urw + ro - 3456));
    f32x4 kc = cvt4(*(const u32x2*)(urw + ro + 1024)), kp = cvt4(*(const u32x2*)(urw + ro - 3456 + 1024));
    f32x4 vc = cvt4(*(const u32x2*)(urw + ro + 2048)), vp = cvt4(*(const u32x2*)(urw + ro - 3456 + 2048));
    f32x4 a = cvt4(*(const u32x2*)(rwa + (size_t)r * 1024 + col));
    f32x4 rr = rc + (rp - rc) * *(const f32x4*)(mu + col);
    f32x4 k = kc + (kp - kc) * *(const f32x4*)(mu + 1024 + col);
    f32x4 vv = vc + (vp - vc) * *(const f32x4*)(mu + 2048 + col);
    f32x4 kkv = k * *(const f32x4*)(kk_ + col);
    float n2 = red16(kkv[0] * kkv[0] + kkv[1] * kkv[1] + kkv[2] * kkv[2] + kkv[3] * kkv[3]);
    const float inv = 1.f / fmaxf(sqrtf(n2), 1e-12f);
    f32x4 kkn = kkv * inv;
    f32x4 kmod = k * (1.f + (a - 1.f) * *(const f32x4*)(ka_ + col));
    f32x4 bt = rr * kmod * *(const f32x4*)(rk_ + col);
    float bn = red16(bt[0] + bt[1] + bt[2] + bt[3]);
    const size_t o = (size_t)r * 1024 + col;
    *(u32x2*)(pr + o) = pack4(rr[0], rr[1], rr[2], rr[3]);
    *(u32x2*)(pk + o) = pack4(kmod[0], kmod[1], kmod[2], kmod[3]);
    *(u32x2*)(pv + o) = pack4(vv[0], vv[1], vv[2], vv[3]);
    *(u32x2*)(pka + o) = pack4(-kkn[0], -kkn[1], -kkn[2], -kkn[3]);
    *(u32x2*)(pkb + o) = pack4(kkn[0] * a[0], kkn[1] * a[1], kkn[2] * a[2], kkn[3] * a[3]);
    if ((lane & 15) == 0) bonus[r * 16 + (col >> 6)] = bn;
  }
}

struct ScanArgs {
  const u16 *pr, *pk, *pka, *pkb, *pv;
  const float *pw, *pvs;
  float *po, *state;
  int sr, sk, sab, sv, sw, svs, so;
};
#define TB 16
template <int KD, bool DELTA, bool WSCALAR, bool KFROMW, int LPR>
__device__ __forceinline__ void scan_task(const ScanArgs& a, bool first, bool save, char* smem) {
  constexpr int RB = 256 / LPR, GV = RB / 4; constexpr int KE = KD / LPR, NQ = KE / 4, NG = KD / 64, G4 = KD / 4;
  constexpr int OFF_R = 0, OFF_K = KD;
  constexpr int OFF_W = KFROMW ? KD : 2 * KD;
  constexpr int OFF_KA = OFF_W + (WSCALAR ? 0 : KD);
  constexpr int OFF_KB = OFF_KA + (DELTA ? KD : 0);
  constexpr int OFF_V = OFF_KB + (DELTA ? KD : 0);
  constexpr int OFF_S = OFF_V + RB;
  constexpr int STR = OFF_S + 4;
  float* buf0 = (float*)smem; float* buf1 = buf0 + TB * STR; float* obuf = buf1 + TB * STR;
  const int tid = tidx(), ks = tid & (LPR - 1), vr = tid / LPR;
  u32x2 gr[NG], gk[NG], gka[NG], gkb[NG], gv; f32x4 gw[NG]; float gsw = 0.f, gsv = 0.f;
  gv.x = gv.y = 0;
#define LOAD_BLK(blk_) { \
    const int row = (blk_) * TB; \
    _Pragma("unroll") for (int i = 0; i < NG; i++) { \
      const int g = tid + 256 * i, step = g / G4, e4 = g % G4; \
      gr[i] = *(const u32x2*)(a.pr + (size_t)(row + step) * a.sr + e4 * 4); \
      if (!KFROMW) gk[i] = *(const u32x2*)(a.pk + (size_t)(row + step) * a.sk + e4 * 4); \
      if (!WSCALAR) gw[i] = *(const f32x4*)(a.pw + (size_t)(row + step) * a.sw + e4 * 4); \
      if (DELTA) { gka[i] = *(const u32x2*)(a.pka + (size_t)(row + step) * a.sab + e4 * 4); gkb[i] = *(const u32x2*)(a.pkb + (size_t)(row + step) * a.sab + e4 * 4); } \
    } \
    if (tid < TB * GV) { const int step = tid / GV, e4 = tid % GV; gv = *(const u32x2*)(a.pv + (size_t)(row + step) * a.sv + e4 * 4); } \
    if (WSCALAR && tid < TB) { gsw = a.pw[(size_t)(row + tid) * a.sw]; gsv = a.pvs[(size_t)(row + tid) * a.svs]; } }
#define STORE_BLK(buf_) { \
    float* bufp = (buf_); \
    _Pragma("unroll") for (int i = 0; i < NG; i++) { \
      const int g = tid + 256 * i, step = g / G4, e4 = g % G4; \
      float* d = bufp + step * STR + e4 * 4; \
      *(f32x4*)(d + OFF_R) = cvt4(gr[i]); \
      if (!KFROMW) *(f32x4*)(d + OFF_K) = cvt4(gk[i]); \
      if (!WSCALAR) *(f32x4*)(d + OFF_W) = gw[i]; \
      if (DELTA) { *(f32x4*)(d + OFF_KA) = cvt4(gka[i]); *(f32x4*)(d + OFF_KB) = cvt4(gkb[i]); } \
    } \
    if (tid < TB * GV) { const int step = tid / GV, e4 = tid % GV; *(f32x4*)(bufp + step * STR + OFF_V + e4 * 4) = cvt4(gv); } \
    if (WSCALAR && tid < TB) { bufp[tid * STR + OFF_S] = gsw; bufp[tid * STR + OFF_S + 1] = gsv; } }
  float S[KE];
  if (first) {
#pragma unroll
    for (int e = 0; e < KE; e++) S[e] = 0.f;
  } else {
#pragma unroll
    for (int q = 0; q < NQ; q++) { float4 t = *(const float4*)(a.state + (size_t)vr * KD + q * (LPR * 4) + ks * 4); S[q * 4] = t.x; S[q * 4 + 1] = t.y; S[q * 4 + 2] = t.z; S[q * 4 + 3] = t.w; }
  }
  LOAD_BLK(0)
  __syncthreads();
  STORE_BLK(buf0)
  __syncthreads();
  constexpr int NBLK = SL / TB;
  for (int blk = 0; blk < NBLK; blk++) {
    float* buf = (blk & 1) ? buf1 : buf0;
    if (blk + 1 < NBLK) LOAD_BLK(blk + 1)
    {
      float rv1[KE], kb1[KE], kv[2][KE], wv[2][KE], kav[2][KE], vtv[2], wsv[2], vsv[2];
#define LD_STEP(slot, st_) { const float* sp = buf + (st_) * STR; \
        _Pragma("unroll") for (int q = 0; q < NQ; q++) { \
          if (!WSCALAR) { f32x4 u = *(const f32x4*)(sp + OFF_W + q * (LPR * 4) + ks * 4); wv[slot][q * 4] = u[0]; wv[slot][q * 4 + 1] = u[1]; wv[slot][q * 4 + 2] = u[2]; wv[slot][q * 4 + 3] = u[3]; } \
          if (!KFROMW) { f32x4 u = *(const f32x4*)(sp + OFF_K + q * (LPR * 4) + ks * 4); kv[slot][q * 4] = u[0]; kv[slot][q * 4 + 1] = u[1]; kv[slot][q * 4 + 2] = u[2]; kv[slot][q * 4 + 3] = u[3]; } \
          if (DELTA) { f32x4 u = *(const f32x4*)(sp + OFF_KA + q * (LPR * 4) + ks * 4); kav[slot][q * 4] = u[0]; kav[slot][q * 4 + 1] = u[1]; kav[slot][q * 4 + 2] = u[2]; kav[slot][q * 4 + 3] = u[3]; \
                     } \
        } \
        vtv[slot] = sp[OFF_V + vr]; \
        if (WSCALAR) { wsv[slot] = sp[OFF_S]; vsv[slot] = sp[OFF_S + 1]; } }
      LD_STEP(0, 0)
#define DO_STEP(cs, step_) { \
        { const float* spr = buf + (step_) * STR; _Pragma("unroll") for (int q = 0; q < NQ; q++) { f32x4 t = *(const f32x4*)(spr + OFF_R + q * (LPR * 4) + ks * 4); rv1[q * 4] = t[0]; rv1[q * 4 + 1] = t[1]; rv1[q * 4 + 2] = t[2]; rv1[q * 4 + 3] = t[3]; \
            if (DELTA) { f32x4 x = *(const f32x4*)(spr + OFF_KB + q * (LPR * 4) + ks * 4); kb1[q * 4] = x[0]; kb1[q * 4 + 1] = x[1]; kb1[q * 4 + 2] = x[2]; kb1[q * 4 + 3] = x[3]; } } } \
        float vt = vtv[cs]; \
        if (WSCALAR) vt *= vsv[cs]; \
        if (DELTA) { \
          float sa0 = 0.f, sa1 = 0.f, sa2 = 0.f, sa3 = 0.f; \
          _Pragma("unroll") for (int e = 0; e < KE; e += 2) { sa0 = fmaf(S[e], kav[cs][e], sa0); sa1 = fmaf(S[e + 1], kav[cs][e + 1], sa1); } \
          _Pragma("unroll") for (int e = 0; e < KE; e++) S[e] = fmaf(S[e], wv[cs][e], vt * kv[cs][e]); \
          float sa = (LPR == 8) ? red8((sa0 + sa1) + (sa2 + sa3)) : red4((sa0 + sa1) + (sa2 + sa3)); \
          _Pragma("unroll") for (int e = 0; e < KE; e++) S[e] = fmaf(sa, kb1[e], S[e]); \
        } else { \
          _Pragma("unroll") for (int e = 0; e < KE; e++) { \
            float w = WSCALAR ? wsv[cs] : wv[cs][e]; \
            float k = KFROMW ? (1.f - wv[cs][e]) : kv[cs][e]; \
            S[e] = fmaf(S[e], w, vt * k); } \
        } \
        float o0 = 0.f, o1 = 0.f, o2 = 0.f, o3 = 0.f; \
        _Pragma("unroll") for (int e = 0; e < KE; e += 2) { o0 = fmaf(S[e], rv1[e], o0); o1 = fmaf(S[e + 1], rv1[e + 1], o1); } \
        float o = (LPR == 8) ? red8((o0 + o1) + (o2 + o3)) : red4((o0 + o1) + (o2 + o3)); \
        if (ks == 0) obuf[(step_) * RB + vr] = o; }
#pragma unroll 1
      for (int step = 0; step < TB; step += 2) {
        LD_STEP(1, step + 1)
        DO_STEP(0, step)
        if (step + 2 < TB) LD_STEP(0, step + 2)
        DO_STEP(1, step + 1)
      }
    }
    __syncthreads();
    {
      const int row = blk * TB;
#pragma unroll
      for (int i = 0; i < TB * RB / 256; i++) { const int idx = tid + 256 * i, step = idx / RB, v2 = idx % RB; a.po[(size_t)(row + step) * a.so + v2] = obuf[idx]; }
    }
    if (blk + 1 < NBLK) STORE_BLK((blk & 1) ? buf0 : buf1)
    __syncthreads();
  }
  if (save)
#pragma unroll
  for (int q = 0; q < NQ; q++) { float4 t; t.x = S[q * 4]; t.y = S[q * 4 + 1]; t.z = S[q * 4 + 2]; t.w = S[q * 4 + 3]; *(float4*)(a.state + (size_t)vr * KD + q * (LPR * 4) + ks * 4) = t; }
}


struct ChunkArgs { const u16 *q, *k, *v; const float* lf; float* o; float* state; int ld, ldlf; float expA; };
#define QLD 136
#define KHLD 72
template <bool SSM>
__device__ __forceinline__ void chunk_task(const ChunkArgs& a, bool first, bool save, char* smem) {
  u16* QT = (u16*)smem;
  u16* KT = QT + 64 * QLD;
  u16* KH = KT + 64 * QLD;
  u16* VT = KH + 128 * KHLD;
  u16* ST = VT + 32 * KHLD;
  float* gam = (float*)(ST + 32 * QLD); float* em = gam + 128; float* cum = gam + 256; float* dts = gam + 512;
  const int tid = tidx(), lane = tid & 63, g = lane >> 4, c = lane & 15;
  const int w = __builtin_amdgcn_readfirstlane(tid >> 6);
  f32x4 accS[2][2];
#pragma unroll
  for (int i = 0; i < 2; i++)
#pragma unroll
    for (int j = 0; j < 2; j++)
      accS[i][j] = first ? (f32x4){0.f, 0.f, 0.f, 0.f} : *(const f32x4*)(a.state + (size_t)((i * 2 + j) * 256 + tid) * 4);
  float rcn[32]; u16 qan[32], kan[32]; u32x4 cqn[4], ckn[4], vvn; float dtn = 0.f;
#define CH_PREFETCH(chn_) { const int rp = (chn_) * 64; \
    if (!SSM) { const int d = tid & 127, half = tid >> 7; \
      const float* lfp = a.lf + (size_t)(rp + half * 32) * a.ldlf + d; \
      const u16* qp = a.q + (size_t)(rp + half * 32) * a.ld + d; const u16* kp = a.k + (size_t)(rp + half * 32) * a.ld + d; \
      _Pragma("unroll") for (int i = 0; i < 32; i++) rcn[i] = lfp[(size_t)i * a.ldlf]; \
      _Pragma("unroll") for (int i = 0; i < 32; i++) { qan[i] = qp[(size_t)i * a.ld]; kan[i] = kp[(size_t)i * a.ld]; } \
    } else { \
      _Pragma("unroll") for (int i = 0; i < 4; i++) { const int id = tid + 256 * i, s = id >> 4, cc = id & 15; \
        cqn[i] = *(const u32x4*)(a.q + (size_t)(rp + s) * a.ld + cc * 8); ckn[i] = *(const u32x4*)(a.k + (size_t)(rp + s) * a.ld + cc * 8); } \
      if (tid < 64) dtn = a.lf[(size_t)(rp + tid) * a.ldlf]; \
    } \
    { const int s = tid & 63, vg = tid >> 6; vvn = *(const u32x4*)(a.v + (size_t)(rp + s) * a.ld + vg * 8); } }
  CH_PREFETCH(0)
#pragma unroll 1
  for (int ch = 0; ch < SL / 64; ch++) {
    const int r0 = ch * 64;
    float rc[32]; float kf[32]; float rc63 = 0.f;
    if (!SSM) {
      const int d = tid & 127, half = tid >> 7;
#pragma unroll
      for (int i = 0; i < 32; i++) rc[i] = rcn[i];
      float tot = 0.f;
      if (half == 0) {
        float acc = 0.f;
#pragma unroll
        for (int i = 31; i >= 0; i--) { float l = rc[i]; tot += l; rc[i] = acc; acc -= l; }
        em[d] = __expf(tot);
      } else {
        float acc = 0.f;
#pragma unroll
        for (int i = 0; i < 32; i++) { acc += rc[i]; rc[i] = acc; }
        tot = acc;
      }
      cum[half * 128 + d] = tot;
#pragma unroll
      for (int i = 0; i < 32; i++) {
        const int s = half * 32 + i;
        float qv = bf2f(qan[i]); kf[i] = bf2f(kan[i]);
        float r = rc[i];
        QT[s * QLD + d] = f2bf(qv * __expf(fminf(r, 80.f)));
        KT[s * QLD + d] = f2bf(kf[i] * __expf(fminf(-r, 80.f)));
      }
    } else {
#pragma unroll
      for (int i = 0; i < 4; i++) {
        const int id = tid + 256 * i, s = id >> 4, cc = id & 15;
        *(u32x4*)(QT + s * QLD + cc * 8) = cqn[i];
        *(u32x4*)(KT + s * QLD + cc * 8) = ckn[i];
      }
      if (tid < 64) {
        float dtv = dtn;
        float x = -dtv * a.expA;
#pragma unroll
        for (int o = 1; o < 64; o <<= 1) { float y = __shfl_up(x, o); if (lane >= o) x += y; }
        cum[tid] = x; dts[tid] = dtv;
      }
    }
    {
      const int s = tid & 63, vg = tid >> 6;
      u32x4 vv = vvn;
#pragma unroll
      for (int j = 0; j < 4; j++) { VT[(vg * 8 + 2 * j) * KHLD + s] = (u16)(vv[j] & 0xffffu); VT[(vg * 8 + 2 * j + 1) * KHLD + s] = (u16)(vv[j] >> 16); }
    }
    __syncthreads();
#pragma unroll
    for (int dt2 = 0; dt2 < 2; dt2++) {
      const int d0 = (2 * w + dt2) * 16 + 4 * g;
      f32x4 e4 = (f32x4){1.f, 1.f, 1.f, 1.f};
      if (!SSM) e4 = *(const f32x4*)(em + d0);
#pragma unroll
      for (int vt = 0; vt < 2; vt++) {
        f32x4 sv = accS[dt2][vt] * e4;
        u32x2 pk; pk.x = pk2(sv[0], sv[1]); pk.y = pk2(sv[2], sv[3]);
        *(u32x2*)(ST + (16 * vt + c) * QLD + d0) = pk;
      }
    }
    if (!SSM) {
      const int d = tid & 127, half = tid >> 7;
      const float t0 = cum[d], t1 = cum[128 + d];
      rc63 = t1;
      if (half == 0) gam[d] = __expf(t0 + t1);
#pragma unroll
      for (int i = 0; i < 32; i++) KH[d * KHLD + half * 32 + i] = f2bf(kf[i] * __expf(rc63 - rc[i]));
    }
    if (SSM) {
      const int s = tid & 63, ng = tid >> 6;
      const float sc = __expf(cum[63] - cum[s]) * dts[s];
#pragma unroll
      for (int i = 0; i < 4; i++) {
        u32x4 kk = *(const u32x4*)(KT + s * QLD + ng * 32 + i * 8);
#pragma unroll
        for (int j = 0; j < 4; j++) {
          const int n = ng * 32 + i * 8 + 2 * j;
          KH[n * KHLD + s] = f2bf(__uint_as_float(kk[j] << 16) * sc);
          KH[(n + 1) * KHLD + s] = f2bf(__uint_as_float(kk[j] & 0xffff0000u) * sc);
        }
      }
    }
    __syncthreads();
    if (ch + 1 < SL / 64) CH_PREFETCH(ch + 1)
    {
      const int t = 16 * w + c;
      bf16x8 bq[4];
#pragma unroll
      for (int ks = 0; ks < 4; ks++) bq[ks] = *(const bf16x8*)(QT + t * QLD + ks * 32 + g * 8);
      f32x4 accp[4];
#pragma unroll
      for (int st = 0; st < 4; st++) {
        accp[st] = (f32x4){0.f, 0.f, 0.f, 0.f};
        if (st <= w) {
#pragma unroll
          for (int ks = 0; ks < 4; ks++) {
            bf16x8 ak = *(const bf16x8*)(KT + (16 * st + c) * QLD + ks * 32 + g * 8);
            accp[st] = __builtin_amdgcn_mfma_f32_16x16x32_bf16(ak, bq[ks], accp[st], 0, 0, 0);
          }
        }
      }
      float cumt = 0.f;
      if (SSM) cumt = cum[t];
#pragma unroll
      for (int st = 0; st < 4; st++)
#pragma unroll
        for (int r = 0; r < 4; r++) {
          const int s = 16 * st + 4 * g + r;
          float v = accp[st][r];
          if (SSM) v *= __expf(fminf(cumt - cum[s], 0.f)) * dts[s];
          accp[st][r] = (s <= t) ? v : 0.f;
        }
      bf16x8 bp[2];
#pragma unroll
      for (int a2 = 0; a2 < 2; a2++)
#pragma unroll
        for (int j = 0; j < 4; j++) { bp[a2][j] = (short)f2bf(accp[2 * a2][j]); bp[a2][4 + j] = (short)f2bf(accp[2 * a2 + 1][j]); }
      f32x4 acco[2], acco2[2];
#pragma unroll
      for (int vt = 0; vt < 2; vt++) {
        acco[vt] = (f32x4){0.f, 0.f, 0.f, 0.f}; acco2[vt] = (f32x4){0.f, 0.f, 0.f, 0.f};
#pragma unroll
        for (int a2 = 0; a2 < 2; a2++) {
          if (2 * a2 <= w) {
            const u16* vp = VT + (16 * vt + c) * KHLD + 32 * a2 + 4 * g;
            u32x2 lo = *(const u32x2*)vp, hi = *(const u32x2*)(vp + 16);
            u32x4 cmb; cmb.x = lo.x; cmb.y = lo.y; cmb.z = hi.x; cmb.w = hi.y;
            bf16x8 av = __builtin_bit_cast(bf16x8, cmb);
            acco[vt] = __builtin_amdgcn_mfma_f32_16x16x32_bf16(av, bp[a2], acco[vt], 0, 0, 0);
          }
        }
#pragma unroll
        for (int ks = 0; ks < 4; ks++) {
          bf16x8 as = *(const bf16x8*)(ST + (16 * vt + c) * QLD + ks * 32 + g * 8);
          if (SSM) acco2[vt] = __builtin_amdgcn_mfma_f32_16x16x32_bf16(as, bq[ks], acco2[vt], 0, 0, 0);
          else acco[vt] = __builtin_amdgcn_mfma_f32_16x16x32_bf16(as, bq[ks], acco[vt], 0, 0, 0);
        }
        f32x4 ov = acco[vt];
        if (SSM) ov += __expf(cumt) * acco2[vt];
        *(f32x4*)(a.o + (size_t)(r0 + t) * 4096 + 16 * vt + 4 * g) = ov;
      }
#pragma unroll
      for (int dt2 = 0; dt2 < 2; dt2++) {
        const int d0 = (2 * w + dt2) * 16;
        f32x4 gm;
        if (SSM) { float gs = __expf(cum[63]); gm = (f32x4){gs, gs, gs, gs}; }
        else gm = *(const f32x4*)(gam + d0 + 4 * g);
#pragma unroll
        for (int vt = 0; vt < 2; vt++) accS[dt2][vt] *= gm;
#pragma unroll
        for (int a2 = 0; a2 < 2; a2++) {
          bf16x8 ak = *(const bf16x8*)(KH + (d0 + c) * KHLD + 32 * a2 + 8 * g);
#pragma unroll
          for (int vt = 0; vt < 2; vt++) {
            bf16x8 bv = *(const bf16x8*)(VT + (16 * vt + c) * KHLD + 32 * a2 + 8 * g);
            accS[dt2][vt] = __builtin_amdgcn_mfma_f32_16x16x32_bf16(ak, bv, accS[dt2][vt], 0, 0, 0);
          }
        }
      }
    }
    __syncthreads();
  }
  if (save)
#pragma unroll
  for (int i = 0; i < 2; i++)
#pragma unroll
    for (int j = 0; j < 2; j++) *(f32x4*)(a.state + (size_t)((i * 2 + j) * 256 + tid) * 4) = accS[i][j];
}

__device__ __forceinline__ void chunk_dispatch(PP p, int layer, int ct, bool first, bool save, char* smem) {
  float* so = (float*)(p->ws + O_SO);
  ChunkArgs a;
  if (ct < 256) {
    const int vs = ct & 3, h = (ct >> 2) & 7, b = ct >> 5;
    const size_t ro = (size_t)b * SL * 1024 + h * 128;
    a.q = (const u16*)(p->ws + O_HQ) + ro; a.k = (const u16*)(p->ws + O_HK) + ro; a.v = (const u16*)(p->ws + O_HV) + ro + vs * 32;
    a.lf = (const float*)(p->ws + O_HW) + ro; a.o = so + (size_t)b * SL * 4096 + 1024 + h * 128 + vs * 32;
    a.state = (float*)(p->ws + O_STHG) + (size_t)ct * 4096; a.ld = 1024; a.ldlf = 1024; a.expA = 0.f;
    chunk_task<false>(a, first, save, smem);
  } else {
    const int t2 = ct - 256, vs = t2 & 1, hd = (t2 >> 1) & 31, b = t2 >> 6, g = hd >> 3;
    const u16* x2 = (const u16*)(p->ws + O_SX2) + (size_t)b * SL * 3072;
    a.q = x2 + 2560 + g * 128; a.k = x2 + 2048 + g * 128; a.v = x2 + hd * 64 + vs * 32;
    a.lf = (const float*)(p->ws + O_SDT) + (size_t)b * SL * 32 + hd; a.o = so + (size_t)b * SL * 4096 + 2048 + hd * 64 + vs * 32;
    a.state = (float*)(p->ws + O_STSS) + (size_t)t2 * 4096; a.ld = 3072; a.ldlf = 32; a.expA = __expf(p->in[19][layer * 32 + hd]);
    chunk_task<true>(a, first, save, smem);
  }
}
__device__ __forceinline__ void rwkv_dispatch(PP p, int task, bool first, bool save, char* smem) {
  float* so = (float*)(p->ws + O_SO);
  ScanArgs a;
  const int h = task & 15, b = task >> 4;
  const size_t ro = (size_t)b * SL * 1024 + h * 64;
  a.pr = (const u16*)(p->ws + O_PR) + ro; a.pk = (const u16*)(p->ws + O_PK) + ro; a.pka = (const u16*)(p->ws + O_PKA) + ro; a.pkb = (const u16*)(p->ws + O_PKB) + ro;
  a.pv = (const u16*)(p->ws + O_PV) + ro; a.pw = (const float*)(p->ws + O_RWW) + ro; a.pvs = nullptr;
  a.po = so + (size_t)b * SL * 4096 + h * 64; a.state = (float*)(p->ws + O_STRW) + (size_t)(b * 16 + h) * 4096;
  a.sr = a.sk = a.sab = a.sv = a.sw = 1024; a.svs = 0; a.so = 4096;
  __builtin_amdgcn_s_setprio(3);
  scan_task<64, true, false, false, 4>(a, first, save, smem);
  __builtin_amdgcn_s_setprio(0);
}
template <int BR> __device__ __forceinline__ void merge_tile(PP p, int layer, int seg, int t, char* smem);
__device__ __forceinline__ void merge_item(PP p, int layer, int seg, int t, char* smem);
__device__ __forceinline__ void ph_scan(PP p, int layer, int seg, int bid, int nb, char* smem, volatile LAS unsigned* bw) {
  const bool first = (seg == 0);
  unsigned* ctr = (unsigned*)(p->ws + O_BAR) + 3520;
  const unsigned base = (unsigned)(layer * NSEG + seg) * (unsigned)(1024 + nb);
  if (bid < 128) { rwkv_dispatch(p, bid, first, true, smem); __syncthreads(); }
#pragma unroll 1
  for (;;) {
    if (tidx() == 0) *bw = __hip_atomic_fetch_add(ctr, 1u, __ATOMIC_RELAXED, __HIP_MEMORY_SCOPE_AGENT);
    __syncthreads();
    const unsigned it = *bw - base;
    __syncthreads();
    if (it >= 1024u) break;
    if (it < 256u) { if (seg > 0) merge_item(p, layer, seg - 1, (int)it, smem); }
    else chunk_dispatch(p, layer, (int)it - 256, first, true, smem);
    __syncthreads();
  }
}

__device__ __forceinline__ void ph_post(PP p, int layer, int bid, int nb) {
  const float* so = (const float*)(p->ws + O_SO); u16* y = (u16*)(p->ws + O_Y);
  const int lane = tidx() & 63, wv = tidx() >> 6;
  {
    u16* urw = (u16*)(p->ws + O_URW);
    const int gt = bid * NTHR + tidx(), gs = nb * NTHR;
    for (int idx = gt; idx < 8 * 3456; idx += gs) { int b = idx / 3456, c = idx - b * 3456; urw[(size_t)(b * 513) * 3456 + c] = urw[(size_t)(b * 513 + 512) * 3456 + c]; }
  }
  const u16* pv = (const u16*)(p->ws + O_PV); const u16* rwg = (const u16*)(p->ws + O_RWG); const float* bonus = (const float*)(p->ws + O_BONUS);
  const float* gnw = p->in[12] + layer * 1024; const float* gnb = p->in[13] + layer * 1024;
  const u16* hg = (const u16*)(p->ws + O_HG); const float* hgn = p->in[15] + layer * 1024;
  const u16* sx2 = (const u16*)(p->ws + O_SX2); const u16* sz = (const u16*)(p->ws + O_SZ);
  const float* dsk = p->in[20] + layer * 32; const float* sgn = p->in[21] + layer * 2048;
#pragma unroll 1
  for (int task = bid * 4 + wv; task < RS * 12; task += nb * 4) {
    const int r = task / 12, s = task - r * 12;
    if (s < 4) {
      const int col = s * 256 + lane * 4;
      f32x4 o = *(const f32x4*)(so + (size_t)r * 4096 + col);
      const float mean = red16(o[0] + o[1] + o[2] + o[3]) * (1.f / 64.f);
      f32x4 d = o - mean;
      const float var = red16(d[0] * d[0] + d[1] * d[1] + d[2] * d[2] + d[3] * d[3]) * (1.f / 64.f);
      f32x4 on = d * rsqrtf(var + 64e-5f) * *(const f32x4*)(gnw + col) + *(const f32x4*)(gnb + col);
      on += bonus[r * 16 + (col >> 6)] * cvt4(*(const u32x2*)(pv + (size_t)r * 1024 + col));
      on *= cvt4(*(const u32x2*)(rwg + (size_t)r * 1024 + col));
      *(u32x2*)(y + (size_t)r * 4096 + col) = pack4(on[0], on[1], on[2], on[3]);
    } else if (s < 8) {
      const int c = (s - 4) * 256 + lane * 4;
      f32x4 o = *(const f32x4*)(so + (size_t)r * 4096 + 1024 + c);
      float ss = red16(o[0] * o[0] + o[1] * o[1] + o[2] * o[2] + o[3] * o[3]);
      ss += __shfl_xor(ss, 16);
      const float rstd = rsqrtf(ss * (1.f / 128.f) + 1e-5f);
      f32x4 on = o * rstd * *(const f32x4*)(hgn + c) * cvt4(*(const u32x2*)(hg + (size_t)r * 1024 + c));
      *(u32x2*)(y + (size_t)r * 4096 + 1024 + c) = pack4(on[0], on[1], on[2], on[3]);
    } else {
      const int g = s - 8, ch = g * 512 + lane * 8;
      f32x4 o0 = *(const f32x4*)(so + (size_t)r * 4096 + 2048 + ch), o1 = *(const f32x4*)(so + (size_t)r * 4096 + 2048 + ch + 4);
      u32x4 xr = *(const u32x4*)(sx2 + (size_t)r * 3072 + ch), zr = *(const u32x4*)(sz + (size_t)r * 2048 + ch);
      u32x2 t0; t0.x = xr.x; t0.y = xr.y; u32x2 t1; t1.x = xr.z; t1.y = xr.w;
      u32x2 z0; z0.x = zr.x; z0.y = zr.y; u32x2 z1; z1.x = zr.z; z1.y = zr.w;
      const float dk = dsk[ch >> 6];
      f32x4 y0 = (o0 + dk * cvt4(t0)) * cvt4(z0), y1 = (o1 + dk * cvt4(t1)) * cvt4(z1);
      float ss = y0[0] * y0[0] + y0[1] * y0[1] + y0[2] * y0[2] + y0[3] * y0[3] + y1[0] * y1[0] + y1[1] * y1[1] + y1[2] * y1[2] + y1[3] * y1[3];
      ss = red16(ss); ss += __shfl_xor(ss, 16); ss += __shfl_xor(ss, 32);
      const float rstd = rsqrtf(ss * (1.f / 512.f) + 1e-5f);
      y0 = y0 * rstd * *(const f32x4*)(sgn + ch); y1 = y1 * rstd * *(const f32x4*)(sgn + ch + 4);
      u32x4 ov; ov.x = pk2(y0[0], y0[1]); ov.y = pk2(y0[2], y0[3]); ov.z = pk2(y1[0], y1[1]); ov.w = pk2(y1[2], y1[3]);
      *(u32x4*)(y + (size_t)r * 4096 + 2048 + ch) = ov;
    }
  }
}

#define MT_ROW(row) ((size_t)(((row) >> 9) * 515 + 3 + ((row) & 511)) * 1536)
template <int BR>
__device__ __forceinline__ void merge_tile(PP p, int layer, int seg, int t, char* smem) {
  const u16* W = (const u16*)(p->ws + O_W) + (size_t)layer * W_LAYER + WBR;
  const u16* Y = (const u16*)(p->ws + O_Y); const u16* gp = (const u16*)(p->ws + ((seg & 1) ? O_GATES2 : O_GATES)) + BR * 1024; u16* mg = (u16*)(p->ws + O_MERGED);
  float* mt = (float*)(p->ws + O_SXBC);
  constexpr int k0 = BR * 1024, nkt = BR == 2 ? 64 : 32;
  const int m0 = (t & 31) * 128, n0 = (t >> 5) * 128;
  f32x4 acc[4][4]; ACC_ZERO(acc);
  gemm_kloop(Y + (size_t)m0 * 4096 + k0, 4096, W + (size_t)n0 * 4096 + k0, 4096, nkt, acc, smem);
  EPI_LOOP2({ l0[j] = cvt4(*(const u32x2*)(gp + (size_t)row * 3072 + col)); if (BR > 0) l1[j] = *(const f32x4*)(mt + MT_ROW(row) + col); else l1[j] = f4z(); },
            { const f32x4 gsum = l1[j] + l0[j] * v; if (BR < 2) *(f32x4*)(mt + MT_ROW(row) + col) = gsum; else *(u32x2*)(mg + (size_t)row * 1024 + col) = pack4v(gsum); })
}
__device__ __forceinline__ void merge_item(PP p, int layer, int seg, int t, char* smem) {
  merge_tile<0>(p, layer, seg, t, smem);
  merge_tile<1>(p, layer, seg, t, smem);
  merge_tile<2>(p, layer, seg, t, smem);
}
__device__ __forceinline__ void ph_merge(PP p, int layer, int seg, int bid, int nb, char* smem) {
#pragma unroll 1
  for (int t = bid; t < 256; t += nb) merge_item(p, layer, seg, t, smem);
}
__device__ __forceinline__ void ph_out(PP p, int layer, int seg, int bid, int nb, char* smem) {
  const u16* W = (const u16*)(p->ws + O_W) + (size_t)layer * W_LAYER + WOUT;
  const u16* mg = (const u16*)(p->ws + O_MERGED);
  const float* xs = layer == 0 ? p->in[0] : p->out;
  for (int t = bid; t < 256; t += nb) {
    const int m0 = (t & 31) * 128, n0 = (t >> 5) * 128;
    f32x4 acc[4][4]; ACC_ZERO(acc);
    gemm_kloop(mg + (size_t)m0 * 1024, 1024, W + (size_t)n0 * 1024, 1024, 32, acc, smem);
    EPI_LOOP2({ size_t gr = (size_t)(row >> 9) * SEQ + seg * SL + (row & 511); l0[j] = *(const f32x4*)(xs + gr * 1024 + col); },
              { size_t gr = (size_t)(row >> 9) * SEQ + seg * SL + (row & 511); *(f32x4*)(p->out + gr * 1024 + col) = l0[j] + v; })
  }
}
__device__ __forceinline__ void ph_ffi(PP p, int layer, int bid, int nb, char* smem) {
  const u16* W = (const u16*)(p->ws + O_W) + (size_t)layer * W_LAYER + WFFI;
  const u16* H2 = (const u16*)(p->ws + O_H2); u16* hid = (u16*)(p->ws + O_HID);
  for (int t = bid; t < 128 * 44; t += nb) {
    const int m0 = (t & 127) * 256, n0 = (t >> 7) * 128;
    f32x4 acc[8][4]; ACC_ZERO(acc);
    gemm_kloop(H2 + (size_t)m0 * 1024, 1024, W + (size_t)n0 * 1024, 1024, 32, acc, smem);
    const int lane = tidx() & 63, wave = tidx() >> 6, wm = wave >> 1, wn = wave & 1;
#pragma unroll
    for (int i = 0; i < 8; i++)
#pragma unroll
      for (int j = 0; j < 4; j += 2) {
        const int row = m0 + wm * 128 + i * 16 + (lane & 15);
        const int ng = n0 + wn * 64 + j * 16 + (lane >> 4) * 4;
        const int hc = (ng >> 5) * 16 + (ng & 15);
        const f32x4 g = acc[i][j], u = acc[i][j + 1];
        *(u32x2*)(hid + (size_t)row * 2816 + hc) = pack4v(g * sigm4(g) * u);
      }
  }
}
__device__ __forceinline__ void ph_ffo(PP p, int layer, int bid, int nb, char* smem) {
  const u16* W = (const u16*)(p->ws + O_W) + (size_t)layer * W_LAYER + WFFO;
  const u16* hid = (const u16*)(p->ws + O_HID);
  for (int t = bid; t < 128 * 8; t += nb) {
    const int m0 = (t & 127) * 256, n0 = (t >> 7) * 128;
    f32x4 acc[8][4]; ACC_ZERO(acc);
    gemm_kloop(hid + (size_t)m0 * 2816, 2816, W + (size_t)n0 * 2816, 2816, 88, acc, smem);
    float* outp = p->out;
    EPI_LOOP2({ l0[j] = *(const f32x4*)(outp + (size_t)row * 1024 + col); }, { *(f32x4*)(outp + (size_t)row * 1024 + col) = l0[j] + v; })
  }
}

__device__ __forceinline__ void ph_norm1(PP p, int layer, int seg, int bid, int nb) {
  if (seg == 0) {
    u16* urw = (u16*)(p->ws + O_URW); u16* sxbc = (u16*)(p->ws + O_SXBC);
    const int gt = bid * NTHR + tidx(), gs = nb * NTHR;
    for (int idx = gt; idx < 8 * 3456; idx += gs) { int b = idx / 3456, c = idx - b * 3456; urw[(size_t)(b * 513) * 3456 + c] = 0; }
    for (int idx = gt; idx < 8 * 9216; idx += gs) { int b = idx / 9216, c = idx - b * 9216; sxbc[(size_t)(b * 515) * 3072 + c] = 0; }
  }
  rmsnorm_rows(layer == 0 ? p->in[0] : p->out, p->in[1] + layer * 1024, (u16*)(p->ws + O_H), nullptr, RS, 0, seg, bid, nb);
}

#define XB_TMO      128
#define XB_XCNT(j)  (256  + 64 * (j))
#define XB_XSUB(j)  (1280 + 64 * (j))
#define XB_XGEN(j)  (2304 + 64 * (j))
#define XB_TOP      3328
#define XB_TOPGEN   3392
#define XCD_BAR_WORDS 3456
#define XB_SPIN_CAP (1u << 22)
__device__ __forceinline__ unsigned xb_ld(unsigned* p)              { return __hip_atomic_load(p, __ATOMIC_RELAXED, __HIP_MEMORY_SCOPE_AGENT); }
__device__ __forceinline__ unsigned xb_add(unsigned* p, unsigned v) { return __hip_atomic_fetch_add(p, v, __ATOMIC_RELAXED, __HIP_MEMORY_SCOPE_AGENT); }
__device__ __forceinline__ unsigned xb_xcc_id() { return (unsigned)__builtin_amdgcn_s_getreg((3 << 11) | 20) & 0xFu; }
#define XB_SPIN(cond, bar) do { unsigned _sp = 0; while (cond) { __builtin_amdgcn_s_sleep(1); \
    if ((++_sp & 255u) == 0u) { if (xb_ld(&(bar)[XB_TMO])) break; if (_sp > XB_SPIN_CAP) { atomicAdd(&(bar)[XB_TMO], 1u); break; } } } } while (0)
struct XcdBarrier { unsigned* bar; unsigned x; volatile LAS unsigned* st; };
__device__ __forceinline__ XcdBarrier xcd_barrier_post(unsigned* bar, volatile LAS unsigned* st) {
  XcdBarrier b; b.bar = bar; b.x = xb_xcc_id(); b.st = st;
  if (threadIdx.x == 0) (void)xb_add(&bar[XB_XCNT(b.x)], 1u);
  return b;
}
__device__ __forceinline__ void xcd_barrier_complete(unsigned* bar, unsigned x, unsigned& nloc, unsigned& nx) {
  const unsigned G = gridDim.x * gridDim.y * gridDim.z;
  unsigned sum, cnt, mine, sp = 0u;
  for (;;) {
    sum = 0u; cnt = 0u; mine = 0u;
#pragma unroll
    for (unsigned j = 0; j < 16; ++j) { const unsigned c = xb_ld(&bar[XB_XCNT(j)]); sum += c; cnt += (c > 0u) ? 1u : 0u; mine = (j == x) ? c : mine; }
    if (sum == G) break;
    __builtin_amdgcn_s_sleep(1);
    if ((++sp & 255u) == 0u) { if (xb_ld(&bar[XB_TMO])) break; if (sp > XB_SPIN_CAP) { atomicAdd(&bar[XB_TMO], 1u); break; } }
  }
  nloc = mine > 0u ? mine : 1u; nx = cnt > 0u ? cnt : 1u;
}
__device__ __forceinline__ void xcd_barrier(const XcdBarrier& b) {
  asm volatile("s_waitcnt vmcnt(0)" ::: "memory");
  __syncthreads();
  if (threadIdx.x == 0) {
    unsigned* bar = b.bar;
    __builtin_amdgcn_s_waitcnt(0);
    unsigned nloc = b.st[0], nx = b.st[1];
    if (nloc == 0u) { xcd_barrier_complete(bar, b.x, nloc, nx); b.st[0] = nloc; b.st[1] = nx; }
    const unsigned old = xb_add(&bar[XB_XSUB(b.x)], 1u);
    const unsigned gen = old / nloc;
    if (old + 1u == (gen + 1u) * nloc) {
      __builtin_amdgcn_fence(__ATOMIC_RELEASE, "agent");
      asm volatile("s_waitcnt vmcnt(0)" ::: "memory");
      const unsigned og = xb_add(&bar[XB_TOP], 1u);
      const unsigned tg = og / nx;
      if (og + 1u == (tg + 1u) * nx) xb_add(&bar[XB_TOPGEN], 1u);
      else XB_SPIN(xb_ld(&bar[XB_TOPGEN]) == tg, bar);
      __builtin_amdgcn_fence(__ATOMIC_ACQUIRE, "agent");
      xb_add(&bar[XB_XGEN(b.x)], 1u);
      asm volatile("s_waitcnt vmcnt(0)" ::: "memory");
    } else {
      XB_SPIN(xb_ld(&bar[XB_XGEN(b.x)]) == gen, bar);
      __builtin_amdgcn_fence(__ATOMIC_ACQUIRE, "agent");
      asm volatile("s_waitcnt vmcnt(0)" ::: "memory");
    }
  }
  __syncthreads();
}

#define SMEM_BYTES 73728
#ifndef SCANPROBE
#define SCANPROBE 0
#endif
#ifndef PHMASK
#define PHMASK 0xFFFF
#endif
#ifndef DBLMASK
#define DBLMASK 0
#endif
#define RUN(idx, call) { if ((PHMASK >> (idx)) & 1) { if ((DBLMASK >> (idx)) & 1) { call; __syncthreads(); } call; } }
__global__ void __launch_bounds__(NTHR, 2) mega(Params p_) {
  __shared__ __attribute__((aligned(1024))) char smem[SMEM_BYTES + 16];
  uint4& xb_words = *(uint4*)(smem + SMEM_BYTES);
  cg::grid_group grid = cg::this_grid();
  if (threadIdx.x == 0) xb_words = make_uint4(0u, 0u, 0u, 0u);
  __syncthreads();
  XcdBarrier xb = xcd_barrier_post((unsigned*)(p_.ws + O_BAR), (volatile LAS unsigned*)&xb_words);
  {
    PP p = (PP)__builtin_amdgcn_kernarg_segment_ptr();
    RUN(0, ph_wconv(p, blockIdx.x, gridDim.x, smem))
  }
  if (p_.out == nullptr) grid.sync();
  xcd_barrier(xb);
#pragma unroll 1
  for (int pc = 0; pc < 151; pc++) {
    PP p = (PP)__builtin_amdgcn_kernarg_segment_ptr();
    asm volatile("" : "+s"(p));
    int bid = blockIdx.x, nb = gridDim.x;
    asm volatile("" : "+s"(bid), "+s"(nb));
    const int l = pc / 75, q = pc - l * 75;
    bool did = true;
    if (pc == 150) {
      RUN(13, rmsnorm_rows(p->out, p->in[27], nullptr, p->out, TTOK, 2, 0, bid, nb))
      did = false;
    } else if (q >= 72) {
      if (q == 72) RUN(10, rmsnorm_rows(p->out, p->in[24] + l * 1024, (u16*)(p->ws + O_H2), nullptr, TTOK, 1, 0, bid, nb))
      else if (q == 73) RUN(11, ph_ffi(p, l, bid, nb, smem))
      else RUN(12, ph_ffo(p, l, bid, nb, smem))
    } else {
      const int sg = q / 9, st = q - sg * 9;
      switch (st) {
        case 0: if (sg == 0) RUN(1, ph_norm1(p, l, 0, bid, nb)) else did = false; break;
        case 1: RUN(2, ph_inproj(p, l, sg, bid, nb, smem)) break;
        case 2: RUN(3, ph_elem(p, l, sg, bid, nb)) if (sg + 1 < NSEG) RUN(1, ph_norm1(p, l, sg + 1, bid, nb)) break;
        case 3: RUN(4, ph_lora(p, l, bid, nb, smem)) break;
        case 4: RUN(5, ph_rprep(p, l, bid, nb)) break;
        case 5: ph_scan(p, l, sg, bid, nb, smem, ((volatile LAS unsigned*)&xb_words) + 2); break;
        case 6: RUN(7, ph_post(p, l, bid, nb)) if (sg > 0) RUN(9, ph_out(p, l, sg - 1, bid, nb, smem)) break;
        case 7: if (sg == NSEG - 1) RUN(8, ph_merge(p, l, sg, bid, nb, smem)) else did = false; break;
        default: if (sg == NSEG - 1) RUN(9, ph_out(p, l, sg, bid, nb, smem)) else did = false; break;
      }
    }
    if (did) xcd_barrier(xb);
  }
}

extern "C" void kernel_launch(void* const* d_in, const int* in_sizes, int n_in, void* d_out, int out_size, void* d_ws,
                              size_t ws_size, hipStream_t stream) {
  Params p{};
  for (int i = 0; i < 28; i++) p.in[i] = (const float*)d_in[i];
  p.out = (float*)d_out; p.ws = (char*)d_ws;
  static int grid_blocks = 0;
  if (!grid_blocks) {
    int dev = 0, cus = 0, per_cu = 0;
    hipGetDevice(&dev);
    hipDeviceGetAttribute(&cus, hipDeviceAttributeMultiprocessorCount, dev);
    hipOccupancyMaxActiveBlocksPerMultiprocessor(&per_cu, mega, NTHR, 0);
    if (per_cu > 2) per_cu = 2;
    if (per_cu < 1) per_cu = 1;
    grid_blocks = cus * per_cu;
  }
  hipMemsetAsync((char*)d_ws + O_BAR, 0, 16384, stream);
  void* args[] = {&p};
  hipError_t e = hipLaunchCooperativeKernel((void*)mega, dim3(grid_blocks), dim3(NTHR), args, 0, stream);
  if (e != hipSuccess) fprintf(stderr, "cooperative launch failed: %s (grid %d)\n", hipGetErrorString(e), grid_blocks);
}
```

```cpp
#include <hip/hip_runtime.h>
#include <hip/hip_cooperative_groups.h>
#include <stdint.h>
#include <stdio.h>
namespace cg = cooperative_groups;

typedef unsigned short u16;
using bf16x8 = __attribute__((ext_vector_type(8))) short;
using f32x4  = __attribute__((ext_vector_type(4))) float;
using u32x4 = __attribute__((ext_vector_type(4))) unsigned int;
using u32x2 = __attribute__((ext_vector_type(2))) unsigned int;

#define DM 1024
#define SEQ 4096
#define TTOK 32768
#define SL 512
#define NSEG 8
#define RS 4096
#define NTHR 256
#ifndef SCANPROBE
#define SCANPROBE 0
#endif

constexpr size_t al(size_t x) { return (x + 255) & ~(size_t)255; }
constexpr size_t WIN = 0;
constexpr size_t WWUP = WIN + (size_t)15872 * 1024;
constexpr size_t WAUP = WWUP + 65536;
constexpr size_t WGUP = WAUP + 65536;
constexpr size_t WBR = WGUP + 196608;
constexpr size_t WOUT = WBR + 4194304;
constexpr size_t WFFI = WOUT + 1048576;
constexpr size_t WFFO = WFFI + 5767168;
constexpr size_t W_LAYER = WFFO + 2883584;
constexpr size_t O_W = 0;
constexpr size_t O_H = al(O_W + 2 * W_LAYER * 2);
constexpr size_t O_URW = al(O_H + (size_t)RS * 1024 * 2);
constexpr size_t O_HQ = al(O_URW + (size_t)8 * 513 * 3456 * 2);
constexpr size_t O_HV = al(O_HQ + (size_t)RS * 1024 * 2);
constexpr size_t O_HG = al(O_HV + (size_t)RS * 1024 * 2);
constexpr size_t O_HW = al(O_HG + (size_t)RS * 1024 * 2);
constexpr size_t O_SZ = al(O_HW + (size_t)RS * 1024 * 4);
constexpr size_t O_SXBC = al(O_SZ + (size_t)RS * 2048 * 2);
constexpr size_t O_SDT = al(O_SXBC + (size_t)8 * 515 * 3072 * 2);
constexpr size_t O_SWD = al(O_SDT + (size_t)RS * 32 * 4);
constexpr size_t O_GATES = al(O_SWD + (size_t)RS * 32 * 4);
constexpr size_t O_LAW = al(O_GATES + (size_t)RS * 3072 * 2);
constexpr size_t O_LAA = al(O_LAW + (size_t)RS * 64 * 2);
constexpr size_t O_LAG = al(O_LAA + (size_t)RS * 64 * 2);
constexpr size_t O_SX2 = al(O_LAG + (size_t)RS * 192 * 2);
constexpr size_t O_RWW = al(O_SX2 + (size_t)RS * 3072 * 2);
constexpr size_t O_RWA = al(O_RWW + (size_t)RS * 1024 * 4);
constexpr size_t O_RWG = al(O_RWA + (size_t)RS * 1024 * 2);
constexpr size_t O_PR = al(O_RWG + (size_t)RS * 1024 * 2);
constexpr size_t O_PK = al(O_PR + (size_t)RS * 1024 * 2);
constexpr size_t O_PV = al(O_PK + (size_t)RS * 1024 * 2);
constexpr size_t O_PKA = al(O_PV + (size_t)RS * 1024 * 2);
constexpr size_t O_PKB = al(O_PKA + (size_t)RS * 1024 * 2);
constexpr size_t O_BONUS = al(O_PKB + (size_t)RS * 1024 * 2);
constexpr size_t O_SO = al(O_BONUS + (size_t)RS * 16 * 4);
constexpr size_t O_Y = al(O_SO + (size_t)RS * 4096 * 4);
constexpr size_t O_MERGED = al(O_Y + (size_t)RS * 4096 * 2);
constexpr size_t O_STRW = al(O_MERGED + (size_t)RS * 1024 * 2);
constexpr size_t O_STHG = al(O_STRW + (size_t)128 * 64 * 64 * 4);
constexpr size_t O_STSS = al(O_STHG + (size_t)64 * 128 * 128 * 4);
constexpr size_t O_END = al(O_STSS + (size_t)256 * 64 * 128 * 4);
constexpr size_t O_H2 = O_H;
constexpr size_t O_HID = al(O_H2 + (size_t)TTOK * 1024 * 2);
constexpr size_t O_END2 = al(O_HID + (size_t)TTOK * 2816 * 2);
constexpr size_t O_HK = O_END;
constexpr size_t O_GATES2 = al(O_HK + (size_t)RS * 1024 * 2);
constexpr size_t O_BAR = al(O_GATES2 + (size_t)RS * 3072 * 2);
static_assert(O_BAR + 16384 <= (size_t)536870912, "ws overflow");
static_assert(O_END2 <= (size_t)536870912, "ws overflow2");

#define LAS __attribute__((address_space(3)))
struct Params { const float* in[28]; float* out; char* ws; };
typedef const __attribute__((address_space(4))) Params* PP;

enum { PH_WCONV = 0, PH_NORM1, PH_INPROJ, PH_ELEM, PH_LORA, PH_RPREP, PH_SCAN, PH_POST, PH_MERGE, PH_OUT,
       PH_NORM2, PH_FFI, PH_FFO, PH_FINAL };

__device__ __forceinline__ float bf2f(u16 u) { return __uint_as_float(((unsigned)u) << 16); }
__device__ __forceinline__ u16 f2bf(float f) { unsigned u = __float_as_uint(f); u += 0x7fffu + ((u >> 16) & 1u); return (u16)(u >> 16); }
__device__ __forceinline__ float sigm(float x) { return 1.f / (1.f + __expf(-x)); }
__device__ __forceinline__ float wave_sum(float x) {
#pragma unroll
  for (int o = 32; o; o >>= 1) x += __shfl_xor(x, o);
  return x;
}
__device__ __forceinline__ f32x4 cvt4(u32x2 v) {
  f32x4 r; r.x = __uint_as_float(v.x << 16); r.y = __uint_as_float(v.x & 0xffff0000u);
  r.z = __uint_as_float(v.y << 16); r.w = __uint_as_float(v.y & 0xffff0000u); return r;
}
template <int CTRL> __device__ __forceinline__ float dppf(float x) {
  return __int_as_float(__builtin_amdgcn_update_dpp(0, __float_as_int(x), CTRL, 0xF, 0xF, true));
}
__device__ __forceinline__ float red16(float x) {
  x += dppf<0xB1>(x); x += dppf<0x4E>(x); x += dppf<0x141>(x); x += dppf<0x140>(x); return x;
}
__device__ __forceinline__ unsigned pk2(float a, float b) { return (unsigned)f2bf(a) | ((unsigned)f2bf(b) << 16); }
__device__ __forceinline__ u32x2 pack4(float a, float b, float c, float d) {
  u32x2 r; r.x = (unsigned)f2bf(a) | ((unsigned)f2bf(b) << 16); r.y = (unsigned)f2bf(c) | ((unsigned)f2bf(d) << 16); return r;
}
__device__ __forceinline__ f32x4 f4z() { return (f32x4){0.f, 0.f, 0.f, 0.f}; }
__device__ __forceinline__ f32x4 sigm4(f32x4 x) { f32x4 r; r[0] = sigm(x[0]); r[1] = sigm(x[1]); r[2] = sigm(x[2]); r[3] = sigm(x[3]); return r; }
__device__ __forceinline__ u32x2 pack4v(f32x4 x) { return pack4(x[0], x[1], x[2], x[3]); }
__device__ __forceinline__ float red4(float x) { x += dppf<0xB1>(x); x += dppf<0x4E>(x); return x; }
__device__ __forceinline__ float red8(float x) {
  x += dppf<0xB1>(x); x += dppf<0x4E>(x); x += dppf<0x141>(x); return x;
}

__device__ __forceinline__ int tidx() { int t = threadIdx.x; asm volatile("" : "+v"(t)); return t; }
__device__ __forceinline__ int remap_col(int kind, int n, int nsrc) {
  if (kind == 0) return n < nsrc ? n : -1;
  if (kind == 1) {
    if (n < 3456) return n < 3360 ? n : -1;
    if (n < 7552) return 3360 + (n - 3456);
    if (n < 12800) { int c = n - 7552; return c < 5152 ? 7456 + c : -1; }
    return 12608 + (n - 12800);
  }
  int blk = n >> 5, w = n & 31;
  return w < 16 ? blk * 16 + w : 2816 + blk * 16 + (w - 16);
}
__device__ __forceinline__ void tconv(const float* __restrict__ src, int K, int Nsrc, u16* __restrict__ dst, int Kpad, int Npad,
                      int kind, int bid, int nb, char* smem) {
  float(*tile)[65] = (float(*)[65])smem;
  const int tn = Npad >> 6, tk = Kpad >> 6, tid = tidx();
  for (int t = bid; t < tn * tk; t += nb) {
    const int n0 = (t % tn) << 6, k0 = (t / tn) << 6;
    const int nn = tid & 63, c = remap_col(kind, n0 + nn, Nsrc);
#pragma unroll
    for (int i = 0; i < 16; i++) {
      int kk = (tid >> 6) + 4 * i, k = k0 + kk;
      tile[kk][nn] = (k < K && c >= 0) ? src[(size_t)k * Nsrc + c] : 0.f;
    }
    __syncthreads();
#pragma unroll
    for (int i = 0; i < 16; i++) {
      int n2 = (tid >> 6) + 4 * i, kk = tid & 63;
      dst[(size_t)(n0 + n2) * Kpad + k0 + kk] = f2bf(tile[kk][n2]);
    }
    __syncthreads();
  }
}
__device__ __forceinline__ void ph_wconv(PP p, int bid, int nb, char* smem) {
  for (int l = 0; l < 2; l++) {
    u16* W = (u16*)(p->ws + O_W) + (size_t)l * W_LAYER;
    tconv(p->in[2] + (size_t)l * 1024 * 15680, 1024, 15680, W + WIN, 1024, 15872, 1, bid, nb, smem);
    tconv(p->in[5] + (size_t)l * 64 * 1024, 64, 1024, W + WWUP, 64, 1024, 0, bid, nb, smem);
    tconv(p->in[7] + (size_t)l * 64 * 1024, 64, 1024, W + WAUP, 64, 1024, 0, bid, nb, smem);
    tconv(p->in[8] + (size_t)l * 160 * 1024, 160, 1024, W + WGUP, 192, 1024, 0, bid, nb, smem);
    tconv(p->in[22] + (size_t)l * 4096 * 1024, 4096, 1024, W + WBR, 4096, 1024, 0, bid, nb, smem);
    tconv(p->in[23] + (size_t)l * 1024 * 1024, 1024, 1024, W + WOUT, 1024, 1024, 0, bid, nb, smem);
    tconv(p->in[25] + (size_t)l * 1024 * 5632, 1024, 5632, W + WFFI, 1024, 5632, 2, bid, nb, smem);
    tconv(p->in[26] + (size_t)l * 2816 * 1024, 2816, 1024, W + WFFO, 2816, 1024, 0, bid, nb, smem);
  }
}

__device__ __forceinline__ void rmsnorm_rows(const float* __restrict__ xs, const float* __restrict__ gain, u16* dst, float* dstf,
                             int nrows, int mode, int seg, int bid, int nb) {
  const int lane = tidx() & 63, wv = tidx() >> 6;
  for (int r = bid * 4 + wv; r < nrows; r += nb * 4) {
    size_t srow = (mode == 0) ? ((size_t)(r >> 9) * SEQ + seg * SL + (r & 511)) : (size_t)r;
    const float4* xp = (const float4*)(xs + srow * DM);
    float4 v[4]; float ss = 0.f;
#pragma unroll
    for (int i = 0; i < 4; i++) { v[i] = xp[lane + 64 * i]; ss += v[i].x * v[i].x + v[i].y * v[i].y + v[i].z * v[i].z + v[i].w * v[i].w; }
    ss = wave_sum(ss);
    float rstd = rsqrtf(ss * (1.f / DM) + 1e-5f);
#pragma unroll
    for (int i = 0; i < 4; i++) {
      float4 g = ((const float4*)gain)[lane + 64 * i];
      float a = v[i].x * rstd * g.x, b = v[i].y * rstd * g.y, c = v[i].z * rstd * g.z, d = v[i].w * rstd * g.w;
      if (mode == 2) { float4 o; o.x = a; o.y = b; o.z = c; o.w = d; ((float4*)(dstf + (size_t)r * DM))[lane + 64 * i] = o; }
      else { uint2 o; o.x = (unsigned)f2bf(a) | ((unsigned)f2bf(b) << 16); o.y = (unsigned)f2bf(c) | ((unsigned)f2bf(d) << 16);
             ((uint2*)(dst + (size_t)r * DM))[lane + 64 * i] = o; }
    }
  }
}

#define WAIT_V(n) asm volatile("s_waitcnt vmcnt(%0)" ::"n"(n) : "memory")
#define WAIT_L(n) asm volatile("s_waitcnt lgkmcnt(%0)" ::"n"(n) : "memory")
#define RAW_BARRIER() do { WAIT_L(0); __builtin_amdgcn_s_barrier(); } while (0)
template <int MI>
__device__ __forceinline__ void gemm_kloop(const u16* __restrict__ A, int lda, const u16* __restrict__ B, int ldb, int nkt,
                                           f32x4 (&acc)[MI][4], char* smem) {
  constexpr int NA = MI / 2, ABYTES = MI * 32 * 64, STB = ABYTES + 8192, NST = (MI == 4) ? 4 : 3, LPT = NA + 2;
  const int tid = tidx(), lane = tid & 63, wave = tid >> 6, wm = wave >> 1, wn = wave & 1;
  const int wu = __builtin_amdgcn_readfirstlane(wave);
  const u16* ga[NA]; const u16* gb[2];
#pragma unroll
  for (int i = 0; i < NA; i++) {
    const int r = (wu * NA + i) * 16 + (lane >> 2), kc = (lane & 3) ^ ((r >> 2) & 3);
    ga[i] = A + (size_t)r * lda + kc * 8;
  }
#pragma unroll
  for (int i = 0; i < 2; i++) {
    const int r = (wu * 2 + i) * 16 + (lane >> 2), kc = (lane & 3) ^ ((r >> 2) & 3);
    gb[i] = B + (size_t)r * ldb + kc * 8;
  }
  LAS char* sm = (LAS char*)smem;
#define GSTAGE(st_, kt_) { \
    _Pragma("unroll") for (int i = 0; i < NA; i++) \
      __builtin_amdgcn_global_load_lds((const unsigned*)(ga[i] + (kt_) * 32), (LAS unsigned*)(sm + (st_) * STB + (wu * NA + i) * 1024), 16, 0, 0); \
    _Pragma("unroll") for (int i = 0; i < 2; i++) \
      __builtin_amdgcn_global_load_lds((const unsigned*)(gb[i] + (kt_) * 32), (LAS unsigned*)(sm + (st_) * STB + ABYTES + (wu * 2 + i) * 1024), 16, 0, 0); }
#define WAIT_TILES(n_) { if ((n_) >= 3) WAIT_V(3 * LPT); else if ((n_) == 2) WAIT_V(2 * LPT); else if ((n_) == 1) WAIT_V(LPT); else WAIT_V(0); }
#define LDS_RD128(dst_, addr_) asm volatile("ds_read_b128 %0, %1" : "=v"(dst_) : "v"(addr_) : "memory")
#define RD_A(fa_, st_) { const unsigned ab_ = sbase + (st_) * STB + offA; \
    _Pragma("unroll") for (int i = 0; i < MI; i++) LDS_RD128(fa_[i], ab_ + i * 1024); }
#define RD_B(fb_, st_) { const unsigned bb_ = sbase + (st_) * STB + offB; \
    _Pragma("unroll") for (int i = 0; i < 4; i++) LDS_RD128(fb_[i], bb_ + i * 1024); }
#define DO_MFMA(fa_, fb_) { __builtin_amdgcn_s_setprio(1); \
    _Pragma("unroll") for (int i = 0; i < MI; i++) _Pragma("unroll") for (int j = 0; j < 4; j++) \
      acc[i][j] = __builtin_amdgcn_mfma_f32_16x16x32_bf16(__builtin_bit_cast(bf16x8, fb_[j]), __builtin_bit_cast(bf16x8, fa_[i]), acc[i][j], 0, 0, 0); \
    __builtin_amdgcn_s_setprio(0); }
#define KSTEP(fca_, fna_, kt_) { \
    RD_B(fb, st) \
    if ((kt_) + 1 < nkt) { \
      { const int rem_ = nkt - 2 - (kt_); WAIT_TILES(rem_ < NST - 2 ? rem_ : NST - 2) } \
      RAW_BARRIER(); \
      __builtin_amdgcn_sched_barrier(0); \
      if ((kt_) + NST < nkt) GSTAGE(st, (kt_) + NST) \
      st = (st + 1 == NST) ? 0 : st + 1; \
      RD_A(fna_, st) \
    } else { \
      WAIT_L(0); __builtin_amdgcn_sched_barrier(0); \
    } \
    DO_MFMA(fca_, fb) }
  __syncthreads();
#pragma unroll
  for (int s0 = 0; s0 < NST; s0++) if (s0 < nkt) GSTAGE(s0, s0)
  const int frow = lane & 15, fg = lane >> 4;
  const int fo = (frow * 4 + (fg ^ ((frow >> 2) & 3))) * 16;
  const int offA = (wm * MI * 16) * 64 + fo, offB = ABYTES + (wn * 64) * 64 + fo;
  int st = 0;
  const unsigned sbase = (unsigned)(unsigned long)sm;
  u32x4 fa0[MI], fa1[MI], fb[4];
  { const int rem_ = nkt - 1; WAIT_TILES(rem_ < NST - 1 ? rem_ : NST - 1) }
  RAW_BARRIER();
  __builtin_amdgcn_sched_barrier(0);
  RD_A(fa0, 0)
#pragma unroll 1
  for (int kt = 0; kt < nkt; kt += 2) {
    KSTEP(fa0, fa1, kt)
    KSTEP(fa1, fa0, kt + 1)
  }
  RAW_BARRIER();
}
#define ACC_ZERO(acc) { _Pragma("unroll") for (int i = 0; i < (int)(sizeof(acc) / sizeof(acc[0])); i++) _Pragma("unroll") for (int j = 0; j < 4; j++) acc[i][j] = (f32x4){0.f, 0.f, 0.f, 0.f}; }
#define EPI_LOOP(BODY) { constexpr int MI_ = (int)(sizeof(acc) / sizeof(acc[0])); const int lane_ = tidx() & 63, wave_ = tidx() >> 6, wm_ = wave_ >> 1, wn_ = wave_ & 1; \
  _Pragma("unroll") for (int i = 0; i < MI_; i++) { _Pragma("unroll") for (int j = 0; j < 4; j++) { \
    const int row = m0 + wm_ * (MI_ * 16) + i * 16 + (lane_ & 15); const int col = n0 + wn_ * 64 + j * 16 + (lane_ >> 4) * 4; const f32x4 v = acc[i][j]; BODY } \
    asm volatile("" ::: "memory"); } }
#define EPI_LOOP2(LOAD, STORE) { constexpr int MI_ = (int)(sizeof(acc) / sizeof(acc[0])); const int lane_ = tidx() & 63, wave_ = tidx() >> 6, wm_ = wave_ >> 1, wn_ = wave_ & 1; \
  _Pragma("unroll") for (int i = 0; i < MI_; i++) { f32x4 l0[4], l1[4]; \
    _Pragma("unroll") for (int j = 0; j < 4; j++) { \
      const int row = m0 + wm_ * (MI_ * 16) + i * 16 + (lane_ & 15); const int col = n0 + wn_ * 64 + j * 16 + (lane_ >> 4) * 4; LOAD } \
    asm volatile("" ::: "memory"); \
    _Pragma("unroll") for (int j = 0; j < 4; j++) { \
      const int row = m0 + wm_ * (MI_ * 16) + i * 16 + (lane_ & 15); const int col = n0 + wn_ * 64 + j * 16 + (lane_ >> 4) * 4; const f32x4 v = acc[i][j]; STORE } \
    asm volatile("" ::: "memory"); } }
#define COLJ(j) (n0 + ((tidx() >> 6) & 1) * 64 + (j) * 16 + ((tidx() & 63) >> 4) * 4)
__device__ __forceinline__ void ph_inproj(PP p, int layer, int seg, int bid, int nb, char* smem) {
  const u16* W = (const u16*)(p->ws + O_W) + (size_t)layer * W_LAYER + WIN;
  const u16* H = (const u16*)(p->ws + O_H);
  u16* urw = (u16*)(p->ws + O_URW); u16* hq = (u16*)(p->ws + O_HQ); u16* hv = (u16*)(p->ws + O_HV); u16* hg = (u16*)(p->ws + O_HG);
  float* hw = (float*)(p->ws + O_HW); u16* hk = (u16*)(p->ws + O_HK); u16* sz = (u16*)(p->ws + O_SZ); u16* sxbc = (u16*)(p->ws + O_SXBC);
  float* sdt = (float*)(p->ws + O_SDT); u16* gates = (u16*)(p->ws + ((seg & 1) ? O_GATES2 : O_GATES));
  const float* lbl = p->in[14];
  const float* dtb = p->in[18] + layer * 32;
  for (int t = bid; t < 16 * 124; t += nb) {
    const int m0 = (t & 15) * 256, n0 = (t >> 4) * 128;
    f32x4 acc[8][4]; ACC_ZERO(acc);
    gemm_kloop(H + (size_t)m0 * 1024, 1024, W + (size_t)n0 * 1024, 1024, 32, acc, smem);
    if (n0 < 3456) {
      EPI_LOOP({ if (col < 3360) *(u32x2*)(urw + ((size_t)((row >> 9) * 513 + 1 + (row & 511))) * 3456 + col) = pack4v(v); })
    } else if (n0 < 7552) {
      const int which = (n0 - 3456) >> 10;
      if (which == 0) { EPI_LOOP({ int cc = (col - 3456) & 1023; *(u32x2*)(hq + (size_t)row * 1024 + cc) = pack4v(v * sigm4(v)); }) }
      else if (which == 1) {
        f32x4 lbj[4];
#pragma unroll
        for (int j = 0; j < 4; j++) {
          int cc = (COLJ(j) - 3456) & 1023;
          f32x4 l0 = *(const f32x4*)(lbl + cc), l1 = *(const f32x4*)(lbl + 1024 + cc);
#pragma unroll
          for (int e = 0; e < 4; e++) lbj[j][e] = layer == 0 ? 0.f : 1.f / (1.f + __expf(l0[e] - l1[e]));
        }
        EPI_LOOP({ int cc = (col - 3456) & 1023; const f32x4 lb = lbj[j];
                   f32x4 sg = sigm4(v); f32x4 w = lb + (1.f - lb) * sg; f32x4 lf;
                   lf[0] = fmaxf(__logf(w[0]), -60.f); lf[1] = fmaxf(__logf(w[1]), -60.f); lf[2] = fmaxf(__logf(w[2]), -60.f); lf[3] = fmaxf(__logf(w[3]), -60.f);
                   *(f32x4*)(hw + (size_t)row * 1024 + cc) = lf;
                   *(u32x2*)(hk + (size_t)row * 1024 + cc) = pack4v((1.f - lb) * (1.f - sg)); })
      } else if (which == 2) { EPI_LOOP({ int cc = (col - 3456) & 1023; *(u32x2*)(hv + (size_t)row * 1024 + cc) = pack4v(v); }) }
      else { EPI_LOOP({ int cc = (col - 3456) & 1023; *(u32x2*)(hg + (size_t)row * 1024 + cc) = pack4v(sigm4(v)); }) }
    } else if (n0 < 12800) {
      const int c0 = n0 - 7552;
      if (c0 < 2048) { EPI_LOOP({ int c = col - 7552; *(u32x2*)(sz + (size_t)row * 2048 + c) = pack4v(v * sigm4(v)); }) }
      else if (c0 < 5120) { EPI_LOOP({ int c = col - 7552 - 2048; *(u32x2*)(sxbc + ((size_t)((row >> 9) * 515 + 3 + (row & 511))) * 3072 + c) = pack4v(v); }) }
      else {
        f32x4 dbj[4];
#pragma unroll
        for (int j = 0; j < 4; j++) { int c = COLJ(j) - 7552 - 5120; dbj[j] = c < 32 ? *(const f32x4*)(dtb + c) : (f32x4){0.f, 0.f, 0.f, 0.f}; }
        EPI_LOOP({ int c = col - 7552 - 5120; if (c < 32) { f32x4 xx = v + dbj[j]; f32x4 o;
                   o[0] = xx[0] > 20.f ? xx[0] : log1pf(__expf(xx[0])); o[1] = xx[1] > 20.f ? xx[1] : log1pf(__expf(xx[1]));
                   o[2] = xx[2] > 20.f ? xx[2] : log1pf(__expf(xx[2])); o[3] = xx[3] > 20.f ? xx[3] : log1pf(__expf(xx[3]));
                   *(f32x4*)(sdt + (size_t)row * 32 + c) = o; } })
      }
    } else {
      EPI_LOOP({ int c = col - 12800; *(u32x2*)(gates + (size_t)row * 3072 + c) = pack4v(sigm4(v)); })
    }
  }
}

__device__ __forceinline__ void ph_elem(PP p, int layer, int seg, int bid, int nb) {
  const u16* urw = (const u16*)(p->ws + O_URW);
  const float* mu = p->in[3] + layer * 3360;
  u16* law = (u16*)(p->ws + O_LAW); u16* laa = (u16*)(p->ws + O_LAA); u16* lag = (u16*)(p->ws + O_LAG);
  const int gt = bid * NTHR + tidx(), gs = nb * NTHR;
#pragma unroll 1
  for (int idx = gt; idx < RS * 80; idx += gs) {
    const int r = idx / 80, gq = idx - r * 80;
    if (gq >= 72) { u32x2 z; z.x = 0; z.y = 0; *(u32x2*)(lag + (size_t)r * 192 + 160 + (gq - 72) * 4) = z; continue; }
    const int col = 3072 + gq * 4;
    const size_t ro = (size_t)((r >> 9) * 513 + 1 + (r & 511)) * 3456;
    f32x4 cur = cvt4(*(const u32x2*)(urw + ro + col)), prv = cvt4(*(const u32x2*)(urw + ro - 3456 + col));
    f32x4 m4 = *(const f32x4*)(mu + col);
    f32x4 val = cur + (prv - cur) * m4;
    if (gq < 16) *(u32x2*)(law + (size_t)r * 64 + gq * 4) = pack4(tanhf(val[0]), tanhf(val[1]), tanhf(val[2]), tanhf(val[3]));
    else if (gq < 32) *(u32x2*)(laa + (size_t)r * 64 + (gq - 16) * 4) = pack4(val[0], val[1], val[2], val[3]);
    else *(u32x2*)(lag + (size_t)r * 192 + (gq - 32) * 4) = pack4(sigm(val[0]), sigm(val[1]), sigm(val[2]), sigm(val[3]));
  }
  const u16* sxbc = (const u16*)(p->ws + O_SXBC); u16* sx2 = (u16*)(p->ws + O_SX2);
  const float* cw = p->in[16] + (size_t)layer * 3072 * 4; const float* cb = p->in[17] + layer * 3072;
#pragma unroll 1
  for (int idx = gt; idx < (RS / 4) * 384; idx += gs) {
    const int rb = idx / 384, cg = idx - rb * 384, r = rb * 4, ch = cg * 8;
    const size_t ro = (size_t)((r >> 9) * 515 + (r & 511)) * 3072 + ch;
    u32x4 xin[7];
#pragma unroll
    for (int j = 0; j < 7; j++) xin[j] = *(const u32x4*)(sxbc + ro + (size_t)j * 3072);
    f32x4 w4[8];
#pragma unroll
    for (int c = 0; c < 8; c++) w4[c] = *(const f32x4*)(cw + (size_t)(ch + c) * 4);
    f32x4 b0 = *(const f32x4*)(cb + ch), b1 = *(const f32x4*)(cb + ch + 4);
#pragma unroll
    for (int rr = 0; rr < 4; rr++) {
      float o[8];
#pragma unroll
      for (int c = 0; c < 8; c++) {
        float acc = c < 4 ? b0[c] : b1[c - 4];
#pragma unroll
        for (int j = 0; j < 4; j++) {
          const unsigned wd = xin[rr + j][c >> 1];
          const float xv = (c & 1) ? __uint_as_float(wd & 0xffff0000u) : __uint_as_float(wd << 16);
          acc = fmaf(xv, w4[c][j], acc);
        }
        o[c] = acc * sigm(acc);
      }
      u32x4 ov; ov.x = pk2(o[0], o[1]); ov.y = pk2(o[2], o[3]); ov.z = pk2(o[4], o[5]); ov.w = pk2(o[6], o[7]);
      *(u32x4*)(sx2 + (size_t)(r + rr) * 3072 + ch) = ov;
    }
  }
}

__device__ __forceinline__ void ph_lora(PP p, int layer, int bid, int nb, char* smem) {
  const u16* W = (const u16*)(p->ws + O_W) + (size_t)layer * W_LAYER;
  float* rww = (float*)(p->ws + O_RWW); u16* rwa = (u16*)(p->ws + O_RWA); u16* rwg = (u16*)(p->ws + O_RWG);
  const float* w0 = p->in[4] + layer * 1024; const float* a0 = p->in[6] + layer * 1024;
  for (int t = bid; t < 3 * 256; t += nb) {
    const int job = t >> 8, tt = t & 255, m0 = (tt & 31) * 128, n0 = (tt >> 5) * 128;
    f32x4 acc[4][4]; ACC_ZERO(acc);
    if (job == 0) {
      gemm_kloop((const u16*)(p->ws + O_LAW) + (size_t)m0 * 64, 64, W + WWUP + (size_t)n0 * 64, 64, 2, acc, smem);
      f32x4 pj[4];
#pragma unroll
      for (int j = 0; j < 4; j++) pj[j] = *(const f32x4*)(w0 + COLJ(j));
      EPI_LOOP({ f32x4 sg = sigm4(pj[j] + v); f32x4 o; o[0] = __expf(-0.60653066f * sg[0]); o[1] = __expf(-0.60653066f * sg[1]); o[2] = __expf(-0.60653066f * sg[2]); o[3] = __expf(-0.60653066f * sg[3]);
                 *(f32x4*)(rww + (size_t)row * 1024 + col) = o; })
    } else if (job == 1) {
      gemm_kloop((const u16*)(p->ws + O_LAA) + (size_t)m0 * 64, 64, W + WAUP + (size_t)n0 * 64, 64, 2, acc, smem);
      f32x4 pj[4];
#pragma unroll
      for (int j = 0; j < 4; j++) pj[j] = *(const f32x4*)(a0 + COLJ(j));
      EPI_LOOP({ *(u32x2*)(rwa + (size_t)row * 1024 + col) = pack4v(sigm4(pj[j] + v)); })
    } else {
      gemm_kloop((const u16*)(p->ws + O_LAG) + (size_t)m0 * 192, 192, W + WGUP + (size_t)n0 * 192, 192, 6, acc, smem);
      EPI_LOOP({ *(u32x2*)(rwg + (size_t)row * 1024 + col) = pack4v(v); })
    }
  }
}

__device__ __forceinline__ void ph_rprep(PP p, int layer, int bid, int nb) {
  const u16* urw = (const u16*)(p->ws + O_URW); const u16* rwa = (const u16*)(p->ws + O_RWA);
  u16* pr = (u16*)(p->ws + O_PR); u16* pk = (u16*)(p->ws + O_PK); u16* pv = (u16*)(p->ws + O_PV);
  u16* pka = (u16*)(p->ws + O_PKA); u16* pkb = (u16*)(p->ws + O_PKB); float* bonus = (float*)(p->ws + O_BONUS);
  const float* mu = p->in[3] + layer * 3360; const float* kk_ = p->in[9] + layer * 1024; const float* ka_ = p->in[10] + layer * 1024;
  const float* rk_ = p->in[11] + layer * 1024;
  {
    u16* sxbc = (u16*)(p->ws + O_SXBC);
    const int gt = bid * NTHR + tidx(), gs = nb * NTHR;
    for (int idx = gt; idx < 8 * 3 * 3072; idx += gs) { int b = idx / 9216, c = idx - b * 9216; sxbc[(size_t)(b * 515) * 3072 + c] = sxbc[(size_t)(b * 515 + 512) * 3072 + c]; }
  }
  const int lane = tidx() & 63, wv = tidx() >> 6;
#pragma unroll 1
  for (int task = bid * 4 + wv; task < RS * 4; task += nb * 4) {
    const int r = task >> 2, col = (task & 3) * 256 + lane * 4;
    const size_t ro = (size_t)((r >> 9) * 513 + 1 + (r & 511)) * 3456 + col;
    f32x4 rc = cvt4(*(const u32x2*)(urw + ro)), rp = cvt4(*(const u32x2*)(urw + ro - 3456));
    f32x4 kc = cvt4(*(const u32x2*)(urw + ro + 1024)), kp = cvt4(*(const u32x2*)(urw + ro - 3456 + 1024));
    f32x4 vc = cvt4(*(const u32x2*)(urw + ro + 2048)), vp = cvt4(*(const u32x2*)(urw + ro - 3456 + 2048));
    f32x4 a = cvt4(*(const u32x2*)(rwa + (size_t)r * 1024 + col));
    f32x4 rr = rc + (rp - rc) * *(const f32x4*)(mu + col);
    f32x4 k = kc + (kp - kc) * *(const f32x4*)(mu + 1024 + col);
    f32x4 vv = vc + (vp - vc) * *(const f32x4*)(mu + 2048 + col);
    f32x4 kkv = k * *(const f32x4*)(kk_ + col);
    float n2 = red16(kkv[0] * kkv[0] + kkv[1] * kkv[1] + kkv[2] * kkv[2] + kkv[3] * kkv[3]);
    const float inv = 1.f / fmaxf(sqrtf(n2), 1e-12f);
    f32x4 kkn = kkv * inv;
    f32x4 kmod = k * (1.f + (a - 1.f) * *(const f32x4*)(ka_ + col));
    f32x4 bt = rr * kmod * *(const f32x4*)(rk_ + col);
    float bn = red16(bt[0] + bt[1] + bt[2] + bt[3]);
    const size_t o = (size_t)r * 1024 + col;
    *(u32x2*)(pr + o) = pack4(rr[0], rr[1], rr[2], rr[3]);
    *(u32x2*)(pk + o) = pack4(kmod[0], kmod[1], kmod[2], kmod[3]);
    *(u32x2*)(pv + o) = pack4(vv[0], vv[1], vv[2], vv[3]);
    *(u32x2*)(pka + o) = pack4(-kkn[0], -kkn[1], -kkn[2], -kkn[3]);
    *(u32x2*)(pkb + o) = pack4(kkn[0] * a[0], kkn[1] * a[1], kkn[2] * a[2], kkn[3] * a[3]);
    if ((lane & 15) == 0) bonus[r * 16 + (col >> 6)] = bn;
  }
}

struct ScanArgs {
  const u16 *pr, *pk, *pka, *pkb, *pv;
  const float *pw, *pvs;
  float *po, *state;
  int sr, sk, sab, sv, sw, svs, so;
};
#define TB 16
template <int KD, bool DELTA, bool WSCALAR, bool KFROMW, int LPR>
__device__ __forceinline__ void scan_task(const ScanArgs& a, bool first, bool save, char* smem) {
  constexpr int RB = 256 / LPR, GV = RB / 4; constexpr int KE = KD / LPR, NQ = KE / 4, NG = KD / 64, G4 = KD / 4;
  constexpr int OFF_R = 0, OFF_K = KD;
  constexpr int OFF_W = KFROMW ? KD : 2 * KD;
  constexpr int OFF_KA = OFF_W + (WSCALAR ? 0 : KD);
  constexpr int OFF_KB = OFF_KA + (DELTA ? KD : 0);
  constexpr int OFF_V = OFF_KB + (DELTA ? KD : 0);
  constexpr int OFF_S = OFF_V + RB;
  constexpr int STR = OFF_S + 4;
  float* buf0 = (float*)smem; float* buf1 = buf0 + TB * STR; float* obuf = buf1 + TB * STR;
  const int tid = tidx(), ks = tid & (LPR - 1), vr = tid / LPR;
  u32x2 gr[NG], gk[NG], gka[NG], gkb[NG], gv; f32x4 gw[NG]; float gsw = 0.f, gsv = 0.f;
  gv.x = gv.y = 0;
#define LOAD_BLK(blk_) { \
    const int row = (blk_) * TB; \
    _Pragma("unroll") for (int i = 0; i < NG; i++) { \
      const int g = tid + 256 * i, step = g / G4, e4 = g % G4; \
      gr[i] = *(const u32x2*)(a.pr + (size_t)(row + step) * a.sr + e4 * 4); \
      if (!KFROMW) gk[i] = *(const u32x2*)(a.pk + (size_t)(row + step) * a.sk + e4 * 4); \
      if (!WSCALAR) gw[i] = *(const f32x4*)(a.pw + (size_t)(row + step) * a.sw + e4 * 4); \
      if (DELTA) { gka[i] = *(const u32x2*)(a.pka + (size_t)(row + step) * a.sab + e4 * 4); gkb[i] = *(const u32x2*)(a.pkb + (size_t)(row + step) * a.sab + e4 * 4); } \
    } \
    if (tid < TB * GV) { const int step = tid / GV, e4 = tid % GV; gv = *(const u32x2*)(a.pv + (size_t)(row + step) * a.sv + e4 * 4); } \
    if (WSCALAR && tid < TB) { gsw = a.pw[(size_t)(row + tid) * a.sw]; gsv = a.pvs[(size_t)(row + tid) * a.svs]; } }
#define STORE_BLK(buf_) { \
    float* bufp = (buf_); \
    _Pragma("unroll") for (int i = 0; i < NG; i++) { \
      const int g = tid + 256 * i, step = g / G4, e4 = g % G4; \
      float* d = bufp + step * STR + e4 * 4; \
      *(f32x4*)(d + OFF_R) = cvt4(gr[i]); \
      if (!KFROMW) *(f32x4*)(d + OFF_K) = cvt4(gk[i]); \
      if (!WSCALAR) *(f32x4*)(d + OFF_W) = gw[i]; \
      if (DELTA) { *(f32x4*)(d + OFF_KA) = cvt4(gka[i]); *(f32x4*)(d + OFF_KB) = cvt4(gkb[i]); } \
    } \
    if (tid < TB * GV) { const int step = tid / GV, e4 = tid % GV; *(f32x4*)(bufp + step * STR + OFF_V + e4 * 4) = cvt4(gv); } \
    if (WSCALAR && tid < TB) { bufp[tid * STR + OFF_S] = gsw; bufp[tid * STR + OFF_S + 1] = gsv; } }
  float S[KE];
  if (first) {
#pragma unroll
    for (int e = 0; e < KE; e++) S[e] = 0.f;
  } else {
#pragma unroll
    for (int q = 0; q < NQ; q++) { float4 t = *(const float4*)(a.state + (size_t)vr * KD + q * (LPR * 4) + ks * 4); S[q * 4] = t.x; S[q * 4 + 1] = t.y; S[q * 4 + 2] = t.z; S[q * 4 + 3] = t.w; }
  }
  LOAD_BLK(0)
  __syncthreads();
  STORE_BLK(buf0)
  __syncthreads();
  constexpr int NBLK = SL / TB;
  for (int blk = 0; blk < NBLK; blk++) {
    float* buf = (blk & 1) ? buf1 : buf0;
    if (blk + 1 < NBLK) LOAD_BLK(blk + 1)
    {
      float rv1[KE], kb1[KE], kv[2][KE], wv[2][KE], kav[2][KE], vtv[2], wsv[2], vsv[2];
#define LD_STEP(slot, st_) { const float* sp = buf + (st_) * STR; \
        _Pragma("unroll") for (int q = 0; q < NQ; q++) { \
          if (!WSCALAR) { f32x4 u = *(const f32x4*)(sp + OFF_W + q * (LPR * 4) + ks * 4); wv[slot][q * 4] = u[0]; wv[slot][q * 4 + 1] = u[1]; wv[slot][q * 4 + 2] = u[2]; wv[slot][q * 4 + 3] = u[3]; } \
          if (!KFROMW) { f32x4 u = *(const f32x4*)(sp + OFF_K + q * (LPR * 4) + ks * 4); kv[slot][q * 4] = u[0]; kv[slot][q * 4 + 1] = u[1]; kv[slot][q * 4 + 2] = u[2]; kv[slot][q * 4 + 3] = u[3]; } \
          if (DELTA) { f32x4 u = *(const f32x4*)(sp + OFF_KA + q * (LPR * 4) + ks * 4); kav[slot][q * 4] = u[0]; kav[slot][q * 4 + 1] = u[1]; kav[slot][q * 4 + 2] = u[2]; kav[slot][q * 4 + 3] = u[3]; \
                     } \
        } \
        vtv[slot] = sp[OFF_V + vr]; \
        if (WSCALAR) { wsv[slot] = sp[OFF_S]; vsv[slot] = sp[OFF_S + 1]; } }
      LD_STEP(0, 0)
#define DO_STEP(cs, step_) { \
        { const float* spr = buf + (step_) * STR; _Pragma("unroll") for (int q = 0; q < NQ; q++) { f32x4 t = *(const f32x4*)(spr + OFF_R + q * (LPR * 4) + ks * 4); rv1[q * 4] = t[0]; rv1[q * 4 + 1] = t[1]; rv1[q * 4 + 2] = t[2]; rv1[q * 4 + 3] = t[3]; \
            if (DELTA) { f32x4 x = *(const f32x4*)(spr + OFF_KB + q * (LPR * 4) + ks * 4); kb1[q * 4] = x[0]; kb1[q * 4 + 1] = x[1]; kb1[q * 4 + 2] = x[2]; kb1[q * 4 + 3] = x[3]; } } } \
        float vt = vtv[cs]; \
        if (WSCALAR) vt *= vsv[cs]; \
        if (DELTA) { \
          float sa0 = 0.f, sa1 = 0.f, sa2 = 0.f, sa3 = 0.f; \
          _Pragma("unroll") for (int e = 0; e < KE; e += 2) { sa0 = fmaf(S[e], kav[cs][e], sa0); sa1 = fmaf(S[e + 1], kav[cs][e + 1], sa1); } \
          _Pragma("unroll") for (int e = 0; e < KE; e++) S[e] = fmaf(S[e], wv[cs][e], vt * kv[cs][e]); \
          float sa = (LPR == 8) ? red8((sa0 + sa1) + (sa2 + sa3)) : red4((sa0 + sa1) + (sa2 + sa3)); \
          _Pragma("unroll") for (int e = 0; e < KE; e++) S[e] = fmaf(sa, kb1[e], S[e]); \
        } else { \
          _Pragma("unroll") for (int e = 0; e < KE; e++) { \
            float w = WSCALAR ? wsv[cs] : wv[cs][e]; \
            float k = KFROMW ? (1.f - wv[cs][e]) : kv[cs][e]; \
            S[e] = fmaf(S[e], w, vt * k); } \
        } \
        float o0 = 0.f, o1 = 0.f, o2 = 0.f, o3 = 0.f; \
        _Pragma("unroll") for (int e = 0; e < KE; e += 2) { o0 = fmaf(S[e], rv1[e], o0); o1 = fmaf(S[e + 1], rv1[e + 1], o1); } \
        float o = (LPR == 8) ? red8((o0 + o1) + (o2 + o3)) : red4((o0 + o1) + (o2 + o3)); \
        if (ks == 0) obuf[(step_) * RB + vr] = o; }
#pragma unroll 1
      for (int step = 0; step < TB; step += 2) {
        LD_STEP(1, step + 1)
        DO_STEP(0, step)
        if (step + 2 < TB) LD_STEP(0, step + 2)
        DO_STEP(1, step + 1)
      }
    }
    __syncthreads();
    {
      const int row = blk * TB;
#pragma unroll
      for (int i = 0; i < TB * RB / 256; i++) { const int idx = tid + 256 * i, step = idx / RB, v2 = idx % RB; a.po[(size_t)(row + step) * a.so + v2] = obuf[idx]; }
    }
    if (blk + 1 < NBLK) STORE_BLK((blk & 1) ? buf0 : buf1)
    __syncthreads();
  }
  if (save)
#pragma unroll
  for (int q = 0; q < NQ; q++) { float4 t; t.x = S[q * 4]; t.y = S[q * 4 + 1]; t.z = S[q * 4 + 2]; t.w = S[q * 4 + 3]; *(float4*)(a.state + (size_t)vr * KD + q * (LPR * 4) + ks * 4) = t; }
}


struct ChunkArgs { const u16 *q, *k, *v; const float* lf; float* o; float* state; int ld, ldlf; float expA; };
#define QLD 136
#define KHLD 72
template <bool SSM>
__device__ __forceinline__ void chunk_task(const ChunkArgs& a, bool first, bool save, char* smem) {
  u16* QT = (u16*)smem;
  u16* KT = QT + 64 * QLD;
  u16* KH = KT + 64 * QLD;
  u16* VT = KH + 128 * KHLD;
  u16* ST = VT + 32 * KHLD;
  float* gam = (float*)(ST + 32 * QLD); float* em = gam + 128; float* cum = gam + 256; float* dts = gam + 512;
  const int tid = tidx(), lane = tid & 63, g = lane >> 4, c = lane & 15;
  const int w = __builtin_amdgcn_readfirstlane(tid >> 6);
  f32x4 accS[2][2];
#pragma unroll
  for (int i = 0; i < 2; i++)
#pragma unroll
    for (int j = 0; j < 2; j++)
      accS[i][j] = first ? (f32x4){0.f, 0.f, 0.f, 0.f} : *(const f32x4*)(a.state + (size_t)((i * 2 + j) * 256 + tid) * 4);
  float rcn[32]; u16 qan[32], kan[32]; u32x4 cqn[4], ckn[4], vvn; float dtn = 0.f;
#define CH_PREFETCH(chn_) { const int rp = (chn_) * 64; \
    if (!SSM) { const int d = tid & 127, half = tid >> 7; \
      const float* lfp = a.lf + (size_t)(rp + half * 32) * a.ldlf + d; \
      const u16* qp = a.q + (size_t)(rp + half * 32) * a.ld + d; const u16* kp = a.k + (size_t)(rp + half * 32) * a.ld + d; \
      _Pragma("unroll") for (int i = 0; i < 32; i++) rcn[i] = lfp[(size_t)i * a.ldlf]; \
      _Pragma("unroll") for (int i = 0; i < 32; i++) { qan[i] = qp[(size_t)i * a.ld]; kan[i] = kp[(size_t)i * a.ld]; } \
    } else { \
      _Pragma("unroll") for (int i = 0; i < 4; i++) { const int id = tid + 256 * i, s = id >> 4, cc = id & 15; \
        cqn[i] = *(const u32x4*)(a.q + (size_t)(rp + s) * a.ld + cc * 8); ckn[i] = *(const u32x4*)(a.k + (size_t)(rp + s) * a.ld + cc * 8); } \
      if (tid < 64) dtn = a.lf[(size_t)(rp + tid) * a.ldlf]; \
    } \
    { const int s = tid & 63, vg = tid >> 6; vvn = *(const u32x4*)(a.v + (size_t)(rp + s) * a.ld + vg * 8); } }
  CH_PREFETCH(0)
#pragma unroll 1
  for (int ch = 0; ch < SL / 64; ch++) {
    const int r0 = ch * 64;
    float rc[32]; float kf[32]; float rc63 = 0.f;
    if (!SSM) {
      const int d = tid & 127, half = tid >> 7;
#pragma unroll
      for (int i = 0; i < 32; i++) rc[i] = rcn[i];
      float tot = 0.f;
      if (half == 0) {
        float acc = 0.f;
#pragma unroll
        for (int i = 31; i >= 0; i--) { float l = rc[i]; tot += l; rc[i] = acc; acc -= l; }
        em[d] = __expf(tot);
      } else {
        float acc = 0.f;
#pragma unroll
        for (int i = 0; i < 32; i++) { acc += rc[i]; rc[i] = acc; }
        tot = acc;
      }
      cum[half * 128 + d] = tot;
#pragma unroll
      for (int i = 0; i < 32; i++) {
        const int s = half * 32 + i;
        float qv = bf2f(qan[i]); kf[i] = bf2f(kan[i]);
        float r = rc[i];
        QT[s * QLD + d] = f2bf(qv * __expf(fminf(r, 80.f)));
        KT[s * QLD + d] = f2bf(kf[i] * __expf(fminf(-r, 80.f)));
      }
    } else {
#pragma unroll
      for (int i = 0; i < 4; i++) {
        const int id = tid + 256 * i, s = id >> 4, cc = id & 15;
        *(u32x4*)(QT + s * QLD + cc * 8) = cqn[i];
        *(u32x4*)(KT + s * QLD + cc * 8) = ckn[i];
      }
      if (tid < 64) {
        float dtv = dtn;
        float x = -dtv * a.expA;
#pragma unroll
        for (int o = 1; o < 64; o <<= 1) { float y = __shfl_up(x, o); if (lane >= o) x += y; }
        cum[tid] = x; dts[tid] = dtv;
      }
    }
    {
      const int s = tid & 63, vg = tid >> 6;
      u32x4 vv = vvn;
#pragma unroll
      for (int j = 0; j < 4; j++) { VT[(vg * 8 + 2 * j) * KHLD + s] = (u16)(vv[j] & 0xffffu); VT[(vg * 8 + 2 * j + 1) * KHLD + s] = (u16)(vv[j] >> 16); }
    }
    __syncthreads();
#pragma unroll
    for (int dt2 = 0; dt2 < 2; dt2++) {
      const int d0 = (2 * w + dt2) * 16 + 4 * g;
      f32x4 e4 = (f32x4){1.f, 1.f, 1.f, 1.f};
      if (!SSM) e4 = *(const f32x4*)(em + d0);
#pragma unroll
      for (int vt = 0; vt < 2; vt++) {
        f32x4 sv = accS[dt2][vt] * e4;
        u32x2 pk; pk.x = pk2(sv[0], sv[1]); pk.y = pk2(sv[2], sv[3]);
        *(u32x2*)(ST + (16 * vt + c) * QLD + d0) = pk;
      }
    }
    if (!SSM) {
      const int d = tid & 127, half = tid >> 7;
      const float t0 = cum[d], t1 = cum[128 + d];
      rc63 = t1;
      if (half == 0) gam[d] = __expf(t0 + t1);
#pragma unroll
      for (int i = 0; i < 32; i++) KH[d * KHLD + half * 32 + i] = f2bf(kf[i] * __expf(rc63 - rc[i]));
    }
    if (SSM) {
      const int s = tid & 63, ng = tid >> 6;
      const float sc = __expf(cum[63] - cum[s]) * dts[s];
#pragma unroll
      for (int i = 0; i < 4; i++) {
        u32x4 kk = *(const u32x4*)(KT + s * QLD + ng * 32 + i * 8);
#pragma unroll
        for (int j = 0; j < 4; j++) {
          const int n = ng * 32 + i * 8 + 2 * j;
          KH[n * KHLD + s] = f2bf(__uint_as_float(kk[j] << 16) * sc);
          KH[(n + 1) * KHLD + s] = f2bf(__uint_as_float(kk[j] & 0xffff0000u) * sc);
        }
      }
    }
    __syncthreads();
    if (ch + 1 < SL / 64) CH_PREFETCH(ch + 1)
    {
      const int t = 16 * w + c;
      bf16x8 bq[4];
#pragma unroll
      for (int ks = 0; ks < 4; ks++) bq[ks] = *(const bf16x8*)(QT + t * QLD + ks * 32 + g * 8);
      f32x4 accp[4];
#pragma unroll
      for (int st = 0; st < 4; st++) {
        accp[st] = (f32x4){0.f, 0.f, 0.f, 0.f};
        if (st <= w) {
#pragma unroll
          for (int ks = 0; ks < 4; ks++) {
            bf16x8 ak = *(const bf16x8*)(KT + (16 * st + c) * QLD + ks * 32 + g * 8);
            accp[st] = __builtin_amdgcn_mfma_f32_16x16x32_bf16(ak, bq[ks], accp[st], 0, 0, 0);
          }
        }
      }
      float cumt = 0.f;
      if (SSM) cumt = cum[t];
#pragma unroll
      for (int st = 0; st < 4; st++)
#pragma unroll
        for (int r = 0; r < 4; r++) {
          const int s = 16 * st + 4 * g + r;
          float v = accp[st][r];
          if (SSM) v *= __expf(fminf(cumt - cum[s], 0.f)) * dts[s];
          accp[st][r] = (s <= t) ? v : 0.f;
        }
      bf16x8 bp[2];
#pragma unroll
      for (int a2 = 0; a2 < 2; a2++)
#pragma unroll
        for (int j = 0; j < 4; j++) { bp[a2][j] = (short)f2bf(accp[2 * a2][j]); bp[a2][4 + j] = (short)f2bf(accp[2 * a2 + 1][j]); }
      f32x4 acco[2], acco2[2];
#pragma unroll
      for (int vt = 0; vt < 2; vt++) {
        acco[vt] = (f32x4){0.f, 0.f, 0.f, 0.f}; acco2[vt] = (f32x4){0.f, 0.f, 0.f, 0.f};
#pragma unroll
        for (int a2 = 0; a2 < 2; a2++) {
          if (2 * a2 <= w) {
            const u16* vp = VT + (16 * vt + c) * KHLD + 32 * a2 + 4 * g;
            u32x2 lo = *(const u32x2*)vp, hi = *(const u32x2*)(vp + 16);
            u32x4 cmb; cmb.x = lo.x; cmb.y = lo.y; cmb.z = hi.x; cmb.w = hi.y;
            bf16x8 av = __builtin_bit_cast(bf16x8, cmb);
            acco[vt] = __builtin_amdgcn_mfma_f32_16x16x32_bf16(av, bp[a2], acco[vt], 0, 0, 0);
          }
        }
#pragma unroll
        for (int ks = 0; ks < 4; ks++) {
          bf16x8 as = *(const bf16x8*)(ST + (16 * vt + c) * QLD + ks * 32 + g * 8);
          if (SSM) acco2[vt] = __builtin_amdgcn_mfma_f32_16x16x32_bf16(as, bq[ks], acco2[vt], 0, 0, 0);
          else acco[vt] = __builtin_amdgcn_mfma_f32_16x16x32_bf16(as, bq[ks], acco[vt], 0, 0, 0);
        }
        f32x4 ov = acco[vt];
        if (SSM) ov += __expf(cumt) * acco2[vt];
        *(f32x4*)(a.o + (size_t)(r0 + t) * 4096 + 16 * vt + 4 * g) = ov;
      }
#pragma unroll
      for (int dt2 = 0; dt2 < 2; dt2++) {
        const int d0 = (2 * w + dt2) * 16;
        f32x4 gm;
        if (SSM) { float gs = __expf(cum[63]); gm = (f32x4){gs, gs, gs, gs}; }
        else gm = *(const f32x4*)(gam + d0 + 4 * g);
#pragma unroll
        for (int vt = 0; vt < 2; vt++) accS[dt2][vt] *= gm;
#pragma unroll
        for (int a2 = 0; a2 < 2; a2++) {
          bf16x8 ak = *(const bf16x8*)(KH + (d0 + c) * KHLD + 32 * a2 + 8 * g);
#pragma unroll
          for (int vt = 0; vt < 2; vt++) {
            bf16x8 bv = *(const bf16x8*)(VT + (16 * vt + c) * KHLD + 32 * a2 + 8 * g);
            accS[dt2][vt] = __builtin_amdgcn_mfma_f32_16x16x32_bf16(ak, bv, accS[dt2][vt], 0, 0, 0);
          }
        }
      }
    }
    __syncthreads();
  }
  if (save)
#pragma unroll
  for (int i = 0; i < 2; i++)
#pragma unroll
    for (int j = 0; j < 2; j++) *(f32x4*)(a.state + (size_t)((i * 2 + j) * 256 + tid) * 4) = accS[i][j];
}

__device__ __forceinline__ void chunk_dispatch(PP p, int layer, int ct, bool first, bool save, char* smem) {
  float* so = (float*)(p->ws + O_SO);
  ChunkArgs a;
  if (ct < 256) {
    const int vs = ct & 3, h = (ct >> 2) & 7, b = ct >> 5;
    const size_t ro = (size_t)b * SL * 1024 + h * 128;
    a.q = (const u16*)(p->ws + O_HQ) + ro; a.k = (const u16*)(p->ws + O_HK) + ro; a.v = (const u16*)(p->ws + O_HV) + ro + vs * 32;
    a.lf = (const float*)(p->ws + O_HW) + ro; a.o = so + (size_t)b * SL * 4096 + 1024 + h * 128 + vs * 32;
    a.state = (float*)(p->ws + O_STHG) + (size_t)ct * 4096; a.ld = 1024; a.ldlf = 1024; a.expA = 0.f;
    chunk_task<false>(a, first, save, smem);
  } else {
    const int t2 = ct - 256, vs = t2 & 1, hd = (t2 >> 1) & 31, b = t2 >> 6, g = hd >> 3;
    const u16* x2 = (const u16*)(p->ws + O_SX2) + (size_t)b * SL * 3072;
    a.q = x2 + 2560 + g * 128; a.k = x2 + 2048 + g * 128; a.v = x2 + hd * 64 + vs * 32;
    a.lf = (const float*)(p->ws + O_SDT) + (size_t)b * SL * 32 + hd; a.o = so + (size_t)b * SL * 4096 + 2048 + hd * 64 + vs * 32;
    a.state = (float*)(p->ws + O_STSS) + (size_t)t2 * 4096; a.ld = 3072; a.ldlf = 32; a.expA = __expf(p->in[19][layer * 32 + hd]);
    chunk_task<true>(a, first, save, smem);
  }
}
__device__ __forceinline__ void rwkv_dispatch(PP p, int task, bool first, bool save, char* smem) {
  float* so = (float*)(p->ws + O_SO);
  ScanArgs a;
  const int h = task & 15, b = task >> 4;
  const size_t ro = (size_t)b * SL * 1024 + h * 64;
  a.pr = (const u16*)(p->ws + O_PR) + ro; a.pk = (const u16*)(p->ws + O_PK) + ro; a.pka = (const u16*)(p->ws + O_PKA) + ro; a.pkb = (const u16*)(p->ws + O_PKB) + ro;
  a.pv = (const u16*)(p->ws + O_PV) + ro; a.pw = (const float*)(p->ws + O_RWW) + ro; a.pvs = nullptr;
  a.po = so + (size_t)b * SL * 4096 + h * 64; a.state = (float*)(p->ws + O_STRW) + (size_t)(b * 16 + h) * 4096;
  a.sr = a.sk = a.sab = a.sv = a.sw = 1024; a.svs = 0; a.so = 4096;
  __builtin_amdgcn_s_setprio(3);
  scan_task<64, true, false, false, 4>(a, first, save, smem);
  __builtin_amdgcn_s_setprio(0);
}
template <int BR> __device__ __forceinline__ void merge_tile(PP p, int layer, int seg, int t, char* smem);
__device__ __forceinline__ void merge_item(PP p, int layer, int seg, int t, char* smem);
__device__ __forceinline__ void ph_scan(PP p, int layer, int seg, int bid, int nb, char* smem, volatile LAS unsigned* bw) {
  const bool first = (seg == 0);
  unsigned* ctr = (unsigned*)(p->ws + O_BAR) + 3520;
  const unsigned base = (unsigned)(layer * NSEG + seg) * (unsigned)(1024 + nb);
  if (bid < 128) { rwkv_dispatch(p, bid, first, true, smem); __syncthreads(); }
#pragma unroll 1
  for (;;) {
    if (tidx() == 0) *bw = __hip_atomic_fetch_add(ctr, 1u, __ATOMIC_RELAXED, __HIP_MEMORY_SCOPE_AGENT);
    __syncthreads();
    const unsigned it = *bw - base;
    __syncthreads();
    if (it >= 1024u) break;
    if (it < 256u) { if (seg > 0) merge_item(p, layer, seg - 1, (int)it, smem); }
    else chunk_dispatch(p, layer, (int)it - 256, first, true, smem);
    __syncthreads();
  }
}

__device__ __forceinline__ void ph_post(PP p, int layer, int bid, int nb) {
  const float* so = (const float*)(p->ws + O_SO); u16* y = (u16*)(p->ws + O_Y);
  const int lane = tidx() & 63, wv = tidx() >> 6;
  {
    u16* urw = (u16*)(p->ws + O_URW);
    const int gt = bid * NTHR + tidx(), gs = nb * NTHR;
    for (int idx = gt; idx < 8 * 3456; idx += gs) { int b = idx / 3456, c = idx - b * 3456; urw[(size_t)(b * 513) * 3456 + c] = urw[(size_t)(b * 513 + 512) * 3456 + c]; }
  }
  const u16* pv = (const u16*)(p->ws + O_PV); const u16* rwg = (const u16*)(p->ws + O_RWG); const float* bonus = (const float*)(p->ws + O_BONUS);
  const float* gnw = p->in[12] + layer * 1024; const float* gnb = p->in[13] + layer * 1024;
  const u16* hg = (const u16*)(p->ws + O_HG); const float* hgn = p->in[15] + layer * 1024;
  const u16* sx2 = (const u16*)(p->ws + O_SX2); const u16* sz = (const u16*)(p->ws + O_SZ);
  const float* dsk = p->in[20] + layer * 32; const float* sgn = p->in[21] + layer * 2048;
#pragma unroll 1
  for (int task = bid * 4 + wv; task < RS * 12; task += nb * 4) {
    const int r = task / 12, s = task - r * 12;
    if (s < 4) {
      const int col = s * 256 + lane * 4;
      f32x4 o = *(const f32x4*)(so + (size_t)r * 4096 + col);
      const float mean = red16(o[0] + o[1] + o[2] + o[3]) * (1.f / 64.f);
      f32x4 d = o - mean;
      const float var = red16(d[0] * d[0] + d[1] * d[1] + d[2] * d[2] + d[3] * d[3]) * (1.f / 64.f);
      f32x4 on = d * rsqrtf(var + 64e-5f) * *(const f32x4*)(gnw + col) + *(const f32x4*)(gnb + col);
      on += bonus[r * 16 + (col >> 6)] * cvt4(*(const u32x2*)(pv + (size_t)r * 1024 + col));
      on *= cvt4(*(const u32x2*)(rwg + (size_t)r * 1024 + col));
      *(u32x2*)(y + (size_t)r * 4096 + col) = pack4(on[0], on[1], on[2], on[3]);
    } else if (s < 8) {
      const int c = (s - 4) * 256 + lane * 4;
      f32x4 o = *(const f32x4*)(so + (size_t)r * 4096 + 1024 + c);
      float ss = red16(o[0] * o[0] + o[1] * o[1] + o[2] * o[2] + o[3] * o[3]);
      ss += __shfl_xor(ss, 16);
      const float rstd = rsqrtf(ss * (1.f / 128.f) + 1e-5f);
      f32x4 on = o * rstd * *(const f32x4*)(hgn + c) * cvt4(*(const u32x2*)(hg + (size_t)r * 1024 + c));
      *(u32x2*)(y + (size_t)r * 4096 + 1024 + c) = pack4(on[0], on[1], on[2], on[3]);
    } else {
      const int g = s - 8, ch = g * 512 + lane * 8;
      f32x4 o0 = *(const f32x4*)(so + (size_t)r * 4096 + 2048 + ch), o1 = *(const f32x4*)(so + (size_t)r * 4096 + 2048 + ch + 4);
      u32x4 xr = *(const u32x4*)(sx2 + (size_t)r * 3072 + ch), zr = *(const u32x4*)(sz + (size_t)r * 2048 + ch);
      u32x2 t0; t0.x = xr.x; t0.y = xr.y; u32x2 t1; t1.x = xr.z; t1.y = xr.w;
      u32x2 z0; z0.x = zr.x; z0.y = zr.y; u32x2 z1; z1.x = zr.z; z1.y = zr.w;
      const float dk = dsk[ch >> 6];
      f32x4 y0 = (o0 + dk * cvt4(t0)) * cvt4(z0), y1 = (o1 + dk * cvt4(t1)) * cvt4(z1);
      float ss = y0[0] * y0[0] + y0[1] * y0[1] + y0[2] * y0[2] + y0[3] * y0[3] + y1[0] * y1[0] + y1[1] * y1[1] + y1[2] * y1[2] + y1[3] * y1[3];
      ss = red16(ss); ss += __shfl_xor(ss, 16); ss += __shfl_xor(ss, 32);
      const float rstd = rsqrtf(ss * (1.f / 512.f) + 1e-5f);
      y0 = y0 * rstd * *(const f32x4*)(sgn + ch); y1 = y1 * rstd * *(const f32x4*)(sgn + ch + 4);
      u32x4 ov; ov.x = pk2(y0[0], y0[1]); ov.y = pk2(y0[2], y0[3]); ov.z = pk2(y1[0], y1[1]); ov.w = pk2(y1[2], y1[3]);
      *(u32x4*)(y + (size_t)r * 4096 + 2048 + ch) = ov;
    }
  }
}

#define MT_ROW(row) ((size_t)(((row) >> 9) * 515 + 3 + ((row) & 511)) * 1536)
template <int BR>
__device__ __forceinline__ void merge_tile(PP p, int layer, int seg, int t, char* smem) {
  const u16* W = (const u16*)(p->ws + O_W) + (size_t)layer * W_LAYER + WBR;
  const u16* Y = (const u16*)(p->ws + O_Y); const u16* gp = (const u16*)(p->ws + ((seg & 1) ? O_GATES2 : O_GATES)) + BR * 1024; u16* mg = (u16*)(p->ws + O_MERGED);
  float* mt = (float*)(p->ws + O_SXBC);
  constexpr int k0 = BR * 1024, nkt = BR == 2 ? 64 : 32;
  const int m0 = (t & 31) * 128, n0 = (t >> 5) * 128;
  f32x4 acc[4][4]; ACC_ZERO(acc);
  gemm_kloop(Y + (size_t)m0 * 4096 + k0, 4096, W + (size_t)n0 * 4096 + k0, 4096, nkt, acc, smem);
  EPI_LOOP2({ l0[j] = cvt4(*(const u32x2*)(gp + (size_t)row * 3072 + col)); if (BR > 0) l1[j] = *(const f32x4*)(mt + MT_ROW(row) + col); else l1[j] = f4z(); },
            { const f32x4 gsum = l1[j] + l0[j] * v; if (BR < 2) *(f32x4*)(mt + MT_ROW(row) + col) = gsum; else *(u32x2*)(mg + (size_t)row * 1024 + col) = pack4v(gsum); })
}
__device__ __forceinline__ void merge_item(PP p, int layer, int seg, int t, char* smem) {
  merge_tile<0>(p, layer, seg, t, smem);
  merge_tile<1>(p, layer, seg, t, smem);
  merge_tile<2>(p, layer, seg, t, smem);
}
__device__ __forceinline__ void ph_merge(PP p, int layer, int seg, int bid, int nb, char* smem) {
#pragma unroll 1
  for (int t = bid; t < 256; t += nb) merge_item(p, layer, seg, t, smem);
}
__device__ __forceinline__ void ph_out(PP p, int layer, int seg, int bid, int nb, char* smem) {
  const u16* W = (const u16*)(p->ws + O_W) + (size_t)layer * W_LAYER + WOUT;
  const u16* mg = (const u16*)(p->ws + O_MERGED);
  const float* xs = layer == 0 ? p->in[0] : p->out;
  for (int t = bid; t < 256; t += nb) {
    const int m0 = (t & 31) * 128, n0 = (t >> 5) * 128;
    f32x4 acc[4][4]; ACC_ZERO(acc);
    gemm_kloop(mg + (size_t)m0 * 1024, 1024, W + (size_t)n0 * 1024, 1024, 32, acc, smem);
    EPI_LOOP2({ size_t gr = (size_t)(row >> 9) * SEQ + seg * SL + (row & 511); l0[j] = *(const f32x4*)(xs + gr * 1024 + col); },
              { size_t gr = (size_t)(row >> 9) * SEQ + seg * SL + (row & 511); *(f32x4*)(p->out + gr * 1024 + col) = l0[j] + v; })
  }
}
__device__ __forceinline__ void ph_ffi(PP p, int layer, int bid, int nb, char* smem) {
  const u16* W = (const u16*)(p->ws + O_W) + (size_t)layer * W_LAYER + WFFI;
  const u16* H2 = (const u16*)(p->ws + O_H2); u16* hid = (u16*)(p->ws + O_HID);
  for (int t = bid; t < 128 * 44; t += nb) {
    const int m0 = (t & 127) * 256, n0 = (t >> 7) * 128;
    f32x4 acc[8][4]; ACC_ZERO(acc);
    gemm_kloop(H2 + (size_t)m0 * 1024, 1024, W + (size_t)n0 * 1024, 1024, 32, acc, smem);
    const int lane = tidx() & 63, wave = tidx() >> 6, wm = wave >> 1, wn = wave & 1;
#pragma unroll
    for (int i = 0; i < 8; i++)
#pragma unroll
      for (int j = 0; j < 4; j += 2) {
        const int row = m0 + wm * 128 + i * 16 + (lane & 15);
        const int ng = n0 + wn * 64 + j * 16 + (lane >> 4) * 4;
        const int hc = (ng >> 5) * 16 + (ng & 15);
        const f32x4 g = acc[i][j], u = acc[i][j + 1];
        *(u32x2*)(hid + (size_t)row * 2816 + hc) = pack4v(g * sigm4(g) * u);
      }
  }
}
__device__ __forceinline__ void ph_ffo(PP p, int layer, int bid, int nb, char* smem) {
  const u16* W = (const u16*)(p->ws + O_W) + (size_t)layer * W_LAYER + WFFO;
  const u16* hid = (const u16*)(p->ws + O_HID);
  for (int t = bid; t < 128 * 8; t += nb) {
    const int m0 = (t & 127) * 256, n0 = (t >> 7) * 128;
    f32x4 acc[8][4]; ACC_ZERO(acc);
    gemm_kloop(hid + (size_t)m0 * 2816, 2816, W + (size_t)n0 * 2816, 2816, 88, acc, smem);
    float* outp = p->out;
    EPI_LOOP2({ l0[j] = *(const f32x4*)(outp + (size_t)row * 1024 + col); }, { *(f32x4*)(outp + (size_t)row * 1024 + col) = l0[j] + v; })
  }
}

__device__ __forceinline__ void ph_norm1(PP p, int layer, int seg, int bid, int nb) {
  if (seg == 0) {
    u16* urw = (u16*)(p->ws + O_URW); u16* sxbc = (u16*)(p->ws + O_SXBC);
    const int gt = bid * NTHR + tidx(), gs = nb * NTHR;
    for (int idx = gt; idx < 8 * 3456; idx += gs) { int b = idx / 3456, c = idx - b * 3456; urw[(size_t)(b * 513) * 3456 + c] = 0; }
    for (int idx = gt; idx < 8 * 9216; idx += gs) { int b = idx / 9216, c = idx - b * 9216; sxbc[(size_t)(b * 515) * 3072 + c] = 0; }
  }
  rmsnorm_rows(layer == 0 ? p->in[0] : p->out, p->in[1] + layer * 1024, (u16*)(p->ws + O_H), nullptr, RS, 0, seg, bid, nb);
}

#define XB_TMO      128
#define XB_XCNT(j)  (256  + 64 * (j))
#define XB_XSUB(j)  (1280 + 64 * (j))
#define XB_XGEN(j)  (2304 + 64 * (j))
#define XB_TOP      3328
#define XB_TOPGEN   3392
#define XCD_BAR_WORDS 3456
#define XB_SPIN_CAP (1u << 22)
__device__ __forceinline__ unsigned xb_ld(unsigned* p)              { return __hip_atomic_load(p, __ATOMIC_RELAXED, __HIP_MEMORY_SCOPE_AGENT); }
__device__ __forceinline__ unsigned xb_add(unsigned* p, unsigned v) { return __hip_atomic_fetch_add(p, v, __ATOMIC_RELAXED, __HIP_MEMORY_SCOPE_AGENT); }
__device__ __forceinline__ unsigned xb_xcc_id() { return (unsigned)__builtin_amdgcn_s_getreg((3 << 11) | 20) & 0xFu; }
#define XB_SPIN(cond, bar) do { unsigned _sp = 0; while (cond) { __builtin_amdgcn_s_sleep(1); \
    if ((++_sp & 255u) == 0u) { if (xb_ld(&(bar)[XB_TMO])) break; if (_sp > XB_SPIN_CAP) { atomicAdd(&(bar)[XB_TMO], 1u); break; } } } } while (0)
struct XcdBarrier { unsigned* bar; unsigned x; volatile LAS unsigned* st; };
__device__ __forceinline__ XcdBarrier xcd_barrier_post(unsigned* bar, volatile LAS unsigned* st) {
  XcdBarrier b; b.bar = bar; b.x = xb_xcc_id(); b.st = st;
  if (threadIdx.x == 0) (void)xb_add(&bar[XB_XCNT(b.x)], 1u);
  return b;
}
__device__ __forceinline__ void xcd_barrier_complete(unsigned* bar, unsigned x, unsigned& nloc, unsigned& nx) {
  const unsigned G = gridDim.x * gridDim.y * gridDim.z;
  unsigned sum, cnt, mine, sp = 0u;
  for (;;) {
    sum = 0u; cnt = 0u; mine = 0u;
#pragma unroll
    for (unsigned j = 0; j < 16; ++j) { const unsigned c = xb_ld(&bar[XB_XCNT(j)]); sum += c; cnt += (c > 0u) ? 1u : 0u; mine = (j == x) ? c : mine; }
    if (sum == G) break;
    __builtin_amdgcn_s_sleep(1);
    if ((++sp & 255u) == 0u) { if (xb_ld(&bar[XB_TMO])) break; if (sp > XB_SPIN_CAP) { atomicAdd(&bar[XB_TMO], 1u); break; } }
  }
  nloc = mine > 0u ? mine : 1u; nx = cnt > 0u ? cnt : 1u;
}
__device__ __forceinline__ void xcd_barrier(const XcdBarrier& b) {
  asm volatile("s_waitcnt vmcnt(0)" ::: "memory");
  __syncthreads();
  if (threadIdx.x == 0) {
    unsigned* bar = b.bar;
    __builtin_amdgcn_s_waitcnt(0);
    unsigned nloc = b.st[0], nx = b.st[1];
    if (nloc == 0u) { xcd_barrier_complete(bar, b.x, nloc, nx); b.st[0] = nloc; b.st[1] = nx; }
    const unsigned old = xb_add(&bar[XB_XSUB(b.x)], 1u);
    const unsigned gen = old / nloc;
    if (old + 1u == (gen + 1u) * nloc) {
      __builtin_amdgcn_fence(__ATOMIC_RELEASE, "agent");
      asm volatile("s_waitcnt vmcnt(0)" ::: "memory");
      const unsigned og = xb_add(&bar[XB_TOP], 1u);
      const unsigned tg = og / nx;
      if (og + 1u == (tg + 1u) * nx) xb_add(&bar[XB_TOPGEN], 1u);
      else XB_SPIN(xb_ld(&bar[XB_TOPGEN]) == tg, bar);
      __builtin_amdgcn_fence(__ATOMIC_ACQUIRE, "agent");
      xb_add(&bar[XB_XGEN(b.x)], 1u);
      asm volatile("s_waitcnt vmcnt(0)" ::: "memory");
    } else {
      XB_SPIN(xb_ld(&bar[XB_XGEN(b.x)]) == gen, bar);
      __builtin_amdgcn_fence(__ATOMIC_ACQUIRE, "agent");
      asm volatile("s_waitcnt vmcnt(0)" ::: "memory");
    }
  }
  __syncthreads();
}

#define SMEM_BYTES 73728
#ifndef SCANPROBE
#define SCANPROBE 0
#endif
#ifndef PHMASK
#define PHMASK 0xFFFF
#endif
#ifndef DBLMASK
#define DBLMASK 0
#endif
#define RUN(idx, call) { if ((PHMASK >> (idx)) & 1) { if ((DBLMASK >> (idx)) & 1) { call; __syncthreads(); } call; } }
__global__ void __launch_bounds__(NTHR, 2) mega(Params p_) {
  __shared__ __attribute__((aligned(1024))) char smem[SMEM_BYTES + 16];
  uint4& xb_words = *(uint4*)(smem + SMEM_BYTES);
  cg::grid_group grid = cg::this_grid();
  if (threadIdx.x == 0) xb_words = make_uint4(0u, 0u, 0u, 0u);
  __syncthreads();
  XcdBarrier xb = xcd_barrier_post((unsigned*)(p_.ws + O_BAR), (volatile LAS unsigned*)&xb_words);
  {
    PP p = (PP)__builtin_amdgcn_kernarg_segment_ptr();
    RUN(0, ph_wconv(p, blockIdx.x, gridDim.x, smem))
  }
  if (p_.out == nullptr) grid.sync();
  xcd_barrier(xb);
#pragma unroll 1
  for (int pc = 0; pc < 151; pc++) {
    PP p = (PP)__builtin_amdgcn_kernarg_segment_ptr();
    asm volatile("" : "+s"(p));
    int bid = blockIdx.x, nb = gridDim.x;
    asm volatile("" : "+s"(bid), "+s"(nb));
    const int l = pc / 75, q = pc - l * 75;
    bool did = true;
    if (pc == 150) {
      RUN(13, rmsnorm_rows(p->out, p->in[27], nullptr, p->out, TTOK, 2, 0, bid, nb))
      did = false;
    } else if (q >= 72) {
      if (q == 72) RUN(10, rmsnorm_rows(p->out, p->in[24] + l * 1024, (u16*)(p->ws + O_H2), nullptr, TTOK, 1, 0, bid, nb))
      else if (q == 73) RUN(11, ph_ffi(p, l, bid, nb, smem))
      else RUN(12, ph_ffo(p, l, bid, nb, smem))
    } else {
      const int sg = q / 9, st = q - sg * 9;
      switch (st) {
        case 0: if (sg == 0) RUN(1, ph_norm1(p, l, 0, bid, nb)) else did = false; break;
        case 1: RUN(2, ph_inproj(p, l, sg, bid, nb, smem)) break;
        case 2: RUN(3, ph_elem(p, l, sg, bid, nb)) if (sg + 1 < NSEG) RUN(1, ph_norm1(p, l, sg + 1, bid, nb)) break;
        case 3: RUN(4, ph_lora(p, l, bid, nb, smem)) break;
        case 4: RUN(5, ph_rprep(p, l, bid, nb)) break;
        case 5: ph_scan(p, l, sg, bid, nb, smem, ((volatile LAS unsigned*)&xb_words) + 2); break;
        case 6: RUN(7, ph_post(p, l, bid, nb)) if (sg > 0) RUN(9, ph_out(p, l, sg - 1, bid, nb, smem)) break;
        case 7: if (sg == NSEG - 1) RUN(8, ph_merge(p, l, sg, bid, nb, smem)) else did = false; break;
        default: if (sg == NSEG - 1) RUN(9, ph_out(p, l, sg, bid, nb, smem)) else did = false; break;
      }
    }
    if (did) xcd_barrier(xb);
  }
}

extern "C" void kernel_launch(void* const* d_in, const int* in_sizes, int n_in, void* d_out, int out_size, void* d_ws,
                              size_t ws_size, hipStream_t stream) {
  Params p{};
  for (int i = 0; i < 28; i++) p.in[i] = (const float*)d_in[i];
  p.out = (float*)d_out; p.ws = (char*)d_ws;
  static int grid_blocks = 0;
  if (!grid_blocks) {
    int dev = 0, cus = 0, per_cu = 0;
    hipGetDevice(&dev);
    hipDeviceGetAttribute(&cus, hipDeviceAttributeMultiprocessorCount, dev);
    hipOccupancyMaxActiveBlocksPerMultiprocessor(&per_cu, mega, NTHR, 0);
    if (per_cu > 2) per_cu = 2;
    if (per_cu < 1) per_cu = 1;
    grid_blocks = cus * per_cu;
  }
  hipMemsetAsync((char*)d_ws + O_BAR, 0, 16384, stream);
  void* args[] = {&p};
  hipError_t e = hipLaunchCooperativeKernel((void*)mega, dim3(grid_blocks), dim3(NTHR), args, 0, stream);
  if (e != hipSuccess) fprintf(stderr, "cooperative launch failed: %s (grid %d)\n", hipGetErrorString(e), grid_blocks);
}
```

```cpp
#include <hip/hip_runtime.h>
#include <hip/hip_cooperative_groups.h>
#include <stdint.h>
#include <stdio.h>
namespace cg = cooperative_groups;

typedef unsigned short u16;
using bf16x8 = __attribute__((ext_vector_type(8))) short;
using f32x4  = __attribute__((ext_vector_type(4))) float;
using u32x4 = __attribute__((ext_vector_type(4))) unsigned int;
using u32x2 = __attribute__((ext_vector_type(2))) unsigned int;

#define DM 1024
#define SEQ 4096
#define TTOK 32768
#define SL 512
#define NSEG 8
#define RS 4096
#define NTHR 256
#ifndef SCANPROBE
#define SCANPROBE 0
#endif

constexpr size_t al(size_t x) { return (x + 255) & ~(size_t)255; }
constexpr size_t WIN = 0;
constexpr size_t WWUP = WIN + (size_t)15872 * 1024;
constexpr size_t WAUP = WWUP + 65536;
constexpr size_t WGUP = WAUP + 65536;
constexpr size_t WBR = WGUP + 196608;
constexpr size_t WOUT = WBR + 4194304;
constexpr size_t WFFI = WOUT + 1048576;
constexpr size_t WFFO = WFFI + 5767168;
constexpr size_t W_LAYER = WFFO + 2883584;
constexpr size_t O_W = 0;
constexpr size_t O_H = al(O_W + 2 * W_LAYER * 2);
constexpr size_t O_URW = al(O_H + (size_t)RS * 1024 * 2);
constexpr size_t O_HQ = al(O_URW + (size_t)8 * 513 * 3456 * 2);
constexpr size_t O_HV = al(O_HQ + (size_t)RS * 1024 * 2);
constexpr size_t O_HG = al(O_HV + (size_t)RS * 1024 * 2);
constexpr size_t O_HW = al(O_HG + (size_t)RS * 1024 * 2);
constexpr size_t O_SZ = al(O_HW + (size_t)RS * 1024 * 4);
constexpr size_t O_SXBC = al(O_SZ + (size_t)RS * 2048 * 2);
constexpr size_t O_SDT = al(O_SXBC + (size_t)8 * 515 * 3072 * 2);
constexpr size_t O_SWD = al(O_SDT + (size_t)RS * 32 * 4);
constexpr size_t O_GATES = al(O_SWD + (size_t)RS * 32 * 4);
constexpr size_t O_LAW = al(O_GATES + (size_t)RS * 3072 * 2);
constexpr size_t O_LAA = al(O_LAW + (size_t)RS * 64 * 2);
constexpr size_t O_LAG = al(O_LAA + (size_t)RS * 64 * 2);
constexpr size_t O_SX2 = al(O_LAG + (size_t)RS * 192 * 2);
constexpr size_t O_RWW = al(O_SX2 + (size_t)RS * 3072 * 2);
constexpr size_t O_RWA = al(O_RWW + (size_t)RS * 1024 * 4);
constexpr size_t O_RWG = al(O_RWA + (size_t)RS * 1024 * 2);
constexpr size_t O_PR = al(O_RWG + (size_t)RS * 1024 * 2);
constexpr size_t O_PK = al(O_PR + (size_t)RS * 1024 * 2);
constexpr size_t O_PV = al(O_PK + (size_t)RS * 1024 * 2);
constexpr size_t O_PKA = al(O_PV + (size_t)RS * 1024 * 2);
constexpr size_t O_PKB = al(O_PKA + (size_t)RS * 1024 * 2);
constexpr size_t O_BONUS = al(O_PKB + (size_t)RS * 1024 * 2);
constexpr size_t O_SO = al(O_BONUS + (size_t)RS * 16 * 4);
constexpr size_t O_Y = al(O_SO + (size_t)RS * 4096 * 4);
constexpr size_t O_MERGED = al(O_Y + (size_t)RS * 4096 * 2);
constexpr size_t O_STRW = al(O_MERGED + (size_t)RS * 1024 * 2);
constexpr size_t O_STHG = al(O_STRW + (size_t)128 * 64 * 64 * 4);
constexpr size_t O_STSS = al(O_STHG + (size_t)64 * 128 * 128 * 4);
constexpr size_t O_END = al(O_STSS + (size_t)256 * 64 * 128 * 4);
constexpr size_t O_H2 = O_H;
constexpr size_t O_HID = al(O_H2 + (size_t)TTOK * 1024 * 2);
constexpr size_t O_END2 = al(O_HID + (size_t)TTOK * 2816 * 2);
constexpr size_t O_HK = O_END;
constexpr size_t O_GATES2 = al(O_HK + (size_t)RS * 1024 * 2);
constexpr size_t O_BAR = al(O_GATES2 + (size_t)RS * 3072 * 2);
static_assert(O_BAR + 16384 <= (size_t)536870912, "ws overflow");
static_assert(O_END2 <= (size_t)536870912, "ws overflow2");

#define LAS __attribute__((address_space(3)))
struct Params { const float* in[28]; float* out; char* ws; };
typedef const __attribute__((address_space(4))) Params* PP;

enum { PH_WCONV = 0, PH_NORM1, PH_INPROJ, PH_ELEM, PH_LORA, PH_RPREP, PH_SCAN, PH_POST, PH_MERGE, PH_OUT,
       PH_NORM2, PH_FFI, PH_FFO, PH_FINAL };

__device__ __forceinline__ float bf2f(u16 u) { return __uint_as_float(((unsigned)u) << 16); }
__device__ __forceinline__ u16 f2bf(float f) { unsigned u = __float_as_uint(f); u += 0x7fffu + ((u >> 16) & 1u); return (u16)(u >> 16); }
__device__ __forceinline__ float sigm(float x) { return 1.f / (1.f + __expf(-x)); }
__device__ __forceinline__ float wave_sum(float x) {
#pragma unroll
  for (int o = 32; o; o >>= 1) x += __shfl_xor(x, o);
  return x;
}
__device__ __forceinline__ f32x4 cvt4(u32x2 v) {
  f32x4 r; r.x = __uint_as_float(v.x << 16); r.y = __uint_as_float(v.x & 0xffff0000u);
  r.z = __uint_as_float(v.y << 16); r.w = __uint_as_float(v.y & 0xffff0000u); return r;
}
template <int CTRL> __device__ __forceinline__ float dppf(float x) {
  return __int_as_float(__builtin_amdgcn_update_dpp(0, __float_as_int(x), CTRL, 0xF, 0xF, true));
}
__device__ __forceinline__ float red16(float x) {
  x += dppf<0xB1>(x); x += dppf<0x4E>(x); x += dppf<0x141>(x); x += dppf<0x140>(x); return x;
}
__device__ __forceinline__ unsigned pk2(float a, float b) { return (unsigned)f2bf(a) | ((unsigned)f2bf(b) << 16); }
__device__ __forceinline__ u32x2 pack4(float a, float b, float c, float d) {
  u32x2 r; r.x = (unsigned)f2bf(a) | ((unsigned)f2bf(b) << 16); r.y = (unsigned)f2bf(c) | ((unsigned)f2bf(d) << 16); return r;
}
__device__ __forceinline__ f32x4 f4z() { return (f32x4){0.f, 0.f, 0.f, 0.f}; }
__device__ __forceinline__ f32x4 sigm4(f32x4 x) { f32x4 r; r[0] = sigm(x[0]); r[1] = sigm(x[1]); r[2] = sigm(x[2]); r[3] = sigm(x[3]); return r; }
__device__ __forceinline__ u32x2 pack4v(f32x4 x) { return pack4(x[0], x[1], x[2], x[3]); }
__device__ __forceinline__ float red4(float x) { x += dppf<0xB1>(x); x += dppf<0x4E>(x); return x; }
__device__ __forceinline__ float red8(float x) {
  x += dppf<0xB1>(x); x += dppf<0x4E>(x); x += dppf<0x141>(x); return x;
}

__device__ __forceinline__ int tidx() { int t = threadIdx.x; asm volatile("" : "+v"(t)); return t; }
__device__ __forceinline__ int remap_col(int kind, int n, int nsrc) {
  if (kind == 0) return n < nsrc ? n : -1;
  if (kind == 1) {
    if (n < 3456) return n < 3360 ? n : -1;
    if (n < 7552) return 3360 + (n - 3456);
    if (n < 12800) { int c = n - 7552; return c < 5152 ? 7456 + c : -1; }
    return 12608 + (n - 12800);
  }
  int blk = n >> 5, w = n & 31;
  return w < 16 ? blk * 16 + w : 2816 + blk * 16 + (w - 16);
}
__device__ __forceinline__ void tconv(const float* __restrict__ src, int K, int Nsrc, u16* __restrict__ dst, int Kpad, int Npad,
                      int kind, int bid, int nb, char* smem) {
  float(*tile)[65] = (float(*)[65])smem;
  const int tn = Npad >> 6, tk = Kpad >> 6, tid = tidx();
  for (int t = bid; t < tn * tk; t += nb) {
    const int n0 = (t % tn) << 6, k0 = (t / tn) << 6;
    const int nn4 = (tid & 15) * 4, c = remap_col(kind, n0 + nn4, Nsrc);
#pragma unroll
    for (int i = 0; i < 4; i++) {
      const int kk = (tid >> 4) + 16 * i, k = k0 + kk;
      f32x4 v = (f32x4){0.f, 0.f, 0.f, 0.f};
      if (k < K && c >= 0) v = *(const f32x4*)(src + (size_t)k * Nsrc + c);
      tile[kk][nn4] = v[0]; tile[kk][nn4 + 1] = v[1]; tile[kk][nn4 + 2] = v[2]; tile[kk][nn4 + 3] = v[3];
    }
    __syncthreads();
#pragma unroll
    for (int i = 0; i < 8; i++) {
      const int n2 = (tid >> 5) + 8 * i, kk = (tid & 31) * 2;
      *(unsigned*)(dst + (size_t)(n0 + n2) * Kpad + k0 + kk) = pk2(tile[kk][n2], tile[kk + 1][n2]);
    }
    __syncthreads();
  }
}
__device__ __forceinline__ void ph_wconv(PP p, int bid, int nb, char* smem) {
  for (int l = 0; l < 2; l++) {
    u16* W = (u16*)(p->ws + O_W) + (size_t)l * W_LAYER;
    tconv(p->in[2] + (size_t)l * 1024 * 15680, 1024, 15680, W + WIN, 1024, 15872, 1, bid, nb, smem);
    tconv(p->in[5] + (size_t)l * 64 * 1024, 64, 1024, W + WWUP, 64, 1024, 0, bid, nb, smem);
    tconv(p->in[7] + (size_t)l * 64 * 1024, 64, 1024, W + WAUP, 64, 1024, 0, bid, nb, smem);
    tconv(p->in[8] + (size_t)l * 160 * 1024, 160, 1024, W + WGUP, 192, 1024, 0, bid, nb, smem);
    tconv(p->in[22] + (size_t)l * 4096 * 1024, 4096, 1024, W + WBR, 4096, 1024, 0, bid, nb, smem);
    tconv(p->in[23] + (size_t)l * 1024 * 1024, 1024, 1024, W + WOUT, 1024, 1024, 0, bid, nb, smem);
    tconv(p->in[25] + (size_t)l * 1024 * 5632, 1024, 5632, W + WFFI, 1024, 5632, 2, bid, nb, smem);
    tconv(p->in[26] + (size_t)l * 2816 * 1024, 2816, 1024, W + WFFO, 2816, 1024, 0, bid, nb, smem);
  }
}

__device__ __forceinline__ void rmsnorm_rows(const float* __restrict__ xs, const float* __restrict__ gain, u16* dst, float* dstf,
                             int nrows, int mode, int seg, int bid, int nb) {
  const int lane = tidx() & 63, wv = tidx() >> 6;
  for (int r = bid * 4 + wv; r < nrows; r += nb * 4) {
    size_t srow = (mode == 0) ? ((size_t)(r >> 9) * SEQ + seg * SL + (r & 511)) : (size_t)r;
    const float4* xp = (const float4*)(xs + srow * DM);
    float4 v[4]; float ss = 0.f;
#pragma unroll
    for (int i = 0; i < 4; i++) { v[i] = xp[lane + 64 * i]; ss += v[i].x * v[i].x + v[i].y * v[i].y + v[i].z * v[i].z + v[i].w * v[i].w; }
    ss = wave_sum(ss);
    float rstd = rsqrtf(ss * (1.f / DM) + 1e-5f);
#pragma unroll
    for (int i = 0; i < 4; i++) {
      float4 g = ((const float4*)gain)[lane + 64 * i];
      float a = v[i].x * rstd * g.x, b = v[i].y * rstd * g.y, c = v[i].z * rstd * g.z, d = v[i].w * rstd * g.w;
      if (mode == 2) { float4 o; o.x = a; o.y = b; o.z = c; o.w = d; ((float4*)(dstf + (size_t)r * DM))[lane + 64 * i] = o; }
      else { uint2 o; o.x = (unsigned)f2bf(a) | ((unsigned)f2bf(b) << 16); o.y = (unsigned)f2bf(c) | ((unsigned)f2bf(d) << 16);
             ((uint2*)(dst + (size_t)r * DM))[lane + 64 * i] = o; }
    }
  }
}

#define WAIT_V(n) asm volatile("s_waitcnt vmcnt(%0)" ::"n"(n) : "memory")
#define WAIT_L(n) asm volatile("s_waitcnt lgkmcnt(%0)" ::"n"(n) : "memory")
#define RAW_BARRIER() do { WAIT_L(0); __builtin_amdgcn_s_barrier(); } while (0)
template <int MI>
__device__ __forceinline__ void gemm_kloop(const u16* __restrict__ A, int lda, const u16* __restrict__ B, int ldb, int nkt,
                                           f32x4 (&acc)[MI][4], char* smem) {
  constexpr int NA = MI / 2, ABYTES = MI * 32 * 64, STB = ABYTES + 8192, NST = (MI == 4) ? 4 : 3, LPT = NA + 2;
  const int tid = tidx(), lane = tid & 63, wave = tid >> 6, wm = wave >> 1, wn = wave & 1;
  const int wu = __builtin_amdgcn_readfirstlane(wave);
  const u16* ga[NA]; const u16* gb[2];
#pragma unroll
  for (int i = 0; i < NA; i++) {
    const int r = (wu * NA + i) * 16 + (lane >> 2), kc = (lane & 3) ^ ((r >> 2) & 3);
    ga[i] = A + (size_t)r * lda + kc * 8;
  }
#pragma unroll
  for (int i = 0; i < 2; i++) {
    const int r = (wu * 2 + i) * 16 + (lane >> 2), kc = (lane & 3) ^ ((r >> 2) & 3);
    gb[i] = B + (size_t)r * ldb + kc * 8;
  }
  LAS char* sm = (LAS char*)smem;
#define GSTAGE(st_, kt_) { \
    _Pragma("unroll") for (int i = 0; i < NA; i++) \
      __builtin_amdgcn_global_load_lds((const unsigned*)(ga[i] + (kt_) * 32), (LAS unsigned*)(sm + (st_) * STB + (wu * NA + i) * 1024), 16, 0, 0); \
    _Pragma("unroll") for (int i = 0; i < 2; i++) \
      __builtin_amdgcn_global_load_lds((const unsigned*)(gb[i] + (kt_) * 32), (LAS unsigned*)(sm + (st_) * STB + ABYTES + (wu * 2 + i) * 1024), 16, 0, 0); }
#define WAIT_TILES(n_) { if ((n_) >= 3) WAIT_V(3 * LPT); else if ((n_) == 2) WAIT_V(2 * LPT); else if ((n_) == 1) WAIT_V(LPT); else WAIT_V(0); }
#define LDS_RD128(dst_, addr_) asm volatile("ds_read_b128 %0, %1" : "=v"(dst_) : "v"(addr_) : "memory")
#define RD_A(fa_, st_) { const unsigned ab_ = sbase + (st_) * STB + offA; \
    _Pragma("unroll") for (int i = 0; i < MI; i++) LDS_RD128(fa_[i], ab_ + i * 1024); }
#define RD_B(fb_, st_) { const unsigned bb_ = sbase + (st_) * STB + offB; \
    _Pragma("unroll") for (int i = 0; i < 4; i++) LDS_RD128(fb_[i], bb_ + i * 1024); }
#define DO_MFMA(fa_, fb_) { __builtin_amdgcn_s_setprio(1); \
    _Pragma("unroll") for (int i = 0; i < MI; i++) _Pragma("unroll") for (int j = 0; j < 4; j++) \
      acc[i][j] = __builtin_amdgcn_mfma_f32_16x16x32_bf16(__builtin_bit_cast(bf16x8, fb_[j]), __builtin_bit_cast(bf16x8, fa_[i]), acc[i][j], 0, 0, 0); \
    __builtin_amdgcn_s_setprio(0); }
#define KSTEP(fca_, fna_, kt_) { \
    RD_B(fb, st) \
    if ((kt_) + 1 < nkt) { \
      { const int rem_ = nkt - 2 - (kt_); WAIT_TILES(rem_ < NST - 2 ? rem_ : NST - 2) } \
      RAW_BARRIER(); \
      __builtin_amdgcn_sched_barrier(0); \
      if ((kt_) + NST < nkt) GSTAGE(st, (kt_) + NST) \
      st = (st + 1 == NST) ? 0 : st + 1; \
      RD_A(fna_, st) \
    } else { \
      WAIT_L(0); __builtin_amdgcn_sched_barrier(0); \
    } \
    DO_MFMA(fca_, fb) }
  __syncthreads();
#pragma unroll
  for (int s0 = 0; s0 < NST; s0++) if (s0 < nkt) GSTAGE(s0, s0)
  const int frow = lane & 15, fg = lane >> 4;
  const int fo = (frow * 4 + (fg ^ ((frow >> 2) & 3))) * 16;
  const int offA = (wm * MI * 16) * 64 + fo, offB = ABYTES + (wn * 64) * 64 + fo;
  int st = 0;
  const unsigned sbase = (unsigned)(unsigned long)sm;
  u32x4 fa0[MI], fa1[MI], fb[4];
  { const int rem_ = nkt - 1; WAIT_TILES(rem_ < NST - 1 ? rem_ : NST - 1) }
  RAW_BARRIER();
  __builtin_amdgcn_sched_barrier(0);
  RD_A(fa0, 0)
#pragma unroll 1
  for (int kt = 0; kt < nkt; kt += 2) {
    KSTEP(fa0, fa1, kt)
    KSTEP(fa1, fa0, kt + 1)
  }
  RAW_BARRIER();
}
#define ACC_ZERO(acc) { _Pragma("unroll") for (int i = 0; i < (int)(sizeof(acc) / sizeof(acc[0])); i++) _Pragma("unroll") for (int j = 0; j < 4; j++) acc[i][j] = (f32x4){0.f, 0.f, 0.f, 0.f}; }
#define EPI_LOOP(BODY) { constexpr int MI_ = (int)(sizeof(acc) / sizeof(acc[0])); const int lane_ = tidx() & 63, wave_ = tidx() >> 6, wm_ = wave_ >> 1, wn_ = wave_ & 1; \
  _Pragma("unroll") for (int i = 0; i < MI_; i++) { _Pragma("unroll") for (int j = 0; j < 4; j++) { \
    const int row = m0 + wm_ * (MI_ * 16) + i * 16 + (lane_ & 15); const int col = n0 + wn_ * 64 + j * 16 + (lane_ >> 4) * 4; const f32x4 v = acc[i][j]; BODY } \
    asm volatile("" ::: "memory"); } }
#define EPI_LOOP2(LOAD, STORE) { constexpr int MI_ = (int)(sizeof(acc) / sizeof(acc[0])); const int lane_ = tidx() & 63, wave_ = tidx() >> 6, wm_ = wave_ >> 1, wn_ = wave_ & 1; \
  _Pragma("unroll") for (int i = 0; i < MI_; i++) { f32x4 l0[4], l1[4]; \
    _Pragma("unroll") for (int j = 0; j < 4; j++) { \
      const int row = m0 + wm_ * (MI_ * 16) + i * 16 + (lane_ & 15); const int col = n0 + wn_ * 64 + j * 16 + (lane_ >> 4) * 4; LOAD } \
    asm volatile("" ::: "memory"); \
    _Pragma("unroll") for (int j = 0; j < 4; j++) { \
      const int row = m0 + wm_ * (MI_ * 16) + i * 16 + (lane_ & 15); const int col = n0 + wn_ * 64 + j * 16 + (lane_ >> 4) * 4; const f32x4 v = acc[i][j]; STORE } \
    asm volatile("" ::: "memory"); } }
#define COLJ(j) (n0 + ((tidx() >> 6) & 1) * 64 + (j) * 16 + ((tidx() & 63) >> 4) * 4)
__device__ __forceinline__ void ph_inproj(PP p, int layer, int seg, int bid, int nb, char* smem) {
  const u16* W = (const u16*)(p->ws + O_W) + (size_t)layer * W_LAYER + WIN;
  const u16* H = (const u16*)(p->ws + O_H);
  u16* urw = (u16*)(p->ws + O_URW); u16* hq = (u16*)(p->ws + O_HQ); u16* hv = (u16*)(p->ws + O_HV); u16* hg = (u16*)(p->ws + O_HG);
  float* hw = (float*)(p->ws + O_HW); u16* hk = (u16*)(p->ws + O_HK); u16* sz = (u16*)(p->ws + O_SZ); u16* sxbc = (u16*)(p->ws + O_SXBC);
  float* sdt = (float*)(p->ws + O_SDT); u16* gates = (u16*)(p->ws + ((seg & 1) ? O_GATES2 : O_GATES));
  const float* lbl = p->in[14];
  const float* dtb = p->in[18] + layer * 32;
  for (int t = bid; t < 16 * 124; t += nb) {
    const int m0 = (t & 15) * 256, n0 = (t >> 4) * 128;
    f32x4 acc[8][4]; ACC_ZERO(acc);
    gemm_kloop(H + (size_t)m0 * 1024, 1024, W + (size_t)n0 * 1024, 1024, 32, acc, smem);
    if (n0 < 3456) {
      EPI_LOOP({ if (col < 3360) *(u32x2*)(urw + ((size_t)((row >> 9) * 513 + 1 + (row & 511))) * 3456 + col) = pack4v(v); })
    } else if (n0 < 7552) {
      const int which = (n0 - 3456) >> 10;
      if (which == 0) { EPI_LOOP({ int cc = (col - 3456) & 1023; *(u32x2*)(hq + (size_t)row * 1024 + cc) = pack4v(v * sigm4(v)); }) }
      else if (which == 1) {
        f32x4 lbj[4];
#pragma unroll
        for (int j = 0; j < 4; j++) {
          int cc = (COLJ(j) - 3456) & 1023;
          f32x4 l0 = *(const f32x4*)(lbl + cc), l1 = *(const f32x4*)(lbl + 1024 + cc);
#pragma unroll
          for (int e = 0; e < 4; e++) lbj[j][e] = layer == 0 ? 0.f : 1.f / (1.f + __expf(l0[e] - l1[e]));
        }
        EPI_LOOP({ int cc = (col - 3456) & 1023; const f32x4 lb = lbj[j];
                   f32x4 sg = sigm4(v); f32x4 w = lb + (1.f - lb) * sg; f32x4 lf;
                   lf[0] = fmaxf(__logf(w[0]), -60.f); lf[1] = fmaxf(__logf(w[1]), -60.f); lf[2] = fmaxf(__logf(w[2]), -60.f); lf[3] = fmaxf(__logf(w[3]), -60.f);
                   *(f32x4*)(hw + (size_t)row * 1024 + cc) = lf;
                   *(u32x2*)(hk + (size_t)row * 1024 + cc) = pack4v((1.f - lb) * (1.f - sg)); })
      } else if (which == 2) { EPI_LOOP({ int cc = (col - 3456) & 1023; *(u32x2*)(hv + (size_t)row * 1024 + cc) = pack4v(v); }) }
      else { EPI_LOOP({ int cc = (col - 3456) & 1023; *(u32x2*)(hg + (size_t)row * 1024 + cc) = pack4v(sigm4(v)); }) }
    } else if (n0 < 12800) {
      const int c0 = n0 - 7552;
      if (c0 < 2048) { EPI_LOOP({ int c = col - 7552; *(u32x2*)(sz + (size_t)row * 2048 + c) = pack4v(v * sigm4(v)); }) }
      else if (c0 < 5120) { EPI_LOOP({ int c = col - 7552 - 2048; *(u32x2*)(sxbc + ((size_t)((row >> 9) * 515 + 3 + (row & 511))) * 3072 + c) = pack4v(v); }) }
      else {
        f32x4 dbj[4];
#pragma unroll
        for (int j = 0; j < 4; j++) { int c = COLJ(j) - 7552 - 5120; dbj[j] = c < 32 ? *(const f32x4*)(dtb + c) : (f32x4){0.f, 0.f, 0.f, 0.f}; }
        EPI_LOOP({ int c = col - 7552 - 5120; if (c < 32) { f32x4 xx = v + dbj[j]; f32x4 o;
                   o[0] = xx[0] > 20.f ? xx[0] : log1pf(__expf(xx[0])); o[1] = xx[1] > 20.f ? xx[1] : log1pf(__expf(xx[1]));
                   o[2] = xx[2] > 20.f ? xx[2] : log1pf(__expf(xx[2])); o[3] = xx[3] > 20.f ? xx[3] : log1pf(__expf(xx[3]));
                   *(f32x4*)(sdt + (size_t)row * 32 + c) = o; } })
      }
    } else {
      EPI_LOOP({ int c = col - 12800; *(u32x2*)(gates + (size_t)row * 3072 + c) = pack4v(sigm4(v)); })
    }
  }
}

__device__ __forceinline__ void ph_elem(PP p, int layer, int seg, int bid, int nb) {
  const u16* urw = (const u16*)(p->ws + O_URW);
  const float* mu = p->in[3] + layer * 3360;
  u16* law = (u16*)(p->ws + O_LAW); u16* laa = (u16*)(p->ws + O_LAA); u16* lag = (u16*)(p->ws + O_LAG);
  const int gt = bid * NTHR + tidx(), gs = nb * NTHR;
#pragma unroll 1
  for (int idx = gt; idx < RS * 80; idx += gs) {
    const int r = idx / 80, gq = idx - r * 80;
    if (gq >= 72) { u32x2 z; z.x = 0; z.y = 0; *(u32x2*)(lag + (size_t)r * 192 + 160 + (gq - 72) * 4) = z; continue; }
    const int col = 3072 + gq * 4;
    const size_t ro = (size_t)((r >> 9) * 513 + 1 + (r & 511)) * 3456;
    f32x4 cur = cvt4(*(const u32x2*)(urw + ro + col)), prv = cvt4(*(const u32x2*)(urw + ro - 3456 + col));
    f32x4 m4 = *(const f32x4*)(mu + col);
    f32x4 val = cur + (prv - cur) * m4;
    if (gq < 16) *(u32x2*)(law + (size_t)r * 64 + gq * 4) = pack4(tanhf(val[0]), tanhf(val[1]), tanhf(val[2]), tanhf(val[3]));
    else if (gq < 32) *(u32x2*)(laa + (size_t)r * 64 + (gq - 16) * 4) = pack4(val[0], val[1], val[2], val[3]);
    else *(u32x2*)(lag + (size_t)r * 192 + (gq - 32) * 4) = pack4(sigm(val[0]), sigm(val[1]), sigm(val[2]), sigm(val[3]));
  }
  const u16* sxbc = (const u16*)(p->ws + O_SXBC); u16* sx2 = (u16*)(p->ws + O_SX2);
  const float* cw = p->in[16] + (size_t)layer * 3072 * 4; const float* cb = p->in[17] + layer * 3072;
#pragma unroll 1
  for (int idx = gt; idx < (RS / 4) * 384; idx += gs) {
    const int rb = idx / 384, cg = idx - rb * 384, r = rb * 4, ch = cg * 8;
    const size_t ro = (size_t)((r >> 9) * 515 + (r & 511)) * 3072 + ch;
    u32x4 xin[7];
#pragma unroll
    for (int j = 0; j < 7; j++) xin[j] = *(const u32x4*)(sxbc + ro + (size_t)j * 3072);
    f32x4 w4[8];
#pragma unroll
    for (int c = 0; c < 8; c++) w4[c] = *(const f32x4*)(cw + (size_t)(ch + c) * 4);
    f32x4 b0 = *(const f32x4*)(cb + ch), b1 = *(const f32x4*)(cb + ch + 4);
#pragma unroll
    for (int rr = 0; rr < 4; rr++) {
      float o[8];
#pragma unroll
      for (int c = 0; c < 8; c++) {
        float acc = c < 4 ? b0[c] : b1[c - 4];
#pragma unroll
        for (int j = 0; j < 4; j++) {
          const unsigned wd = xin[rr + j][c >> 1];
          const float xv = (c & 1) ? __uint_as_float(wd & 0xffff0000u) : __uint_as_float(wd << 16);
          acc = fmaf(xv, w4[c][j], acc);
        }
        o[c] = acc * sigm(acc);
      }
      u32x4 ov; ov.x = pk2(o[0], o[1]); ov.y = pk2(o[2], o[3]); ov.z = pk2(o[4], o[5]); ov.w = pk2(o[6], o[7]);
      *(u32x4*)(sx2 + (size_t)(r + rr) * 3072 + ch) = ov;
    }
  }
}

__device__ __forceinline__ void ph_lora(PP p, int layer, int bid, int nb, char* smem) {
  const u16* W = (const u16*)(p->ws + O_W) + (size_t)layer * W_LAYER;
  float* rww = (float*)(p->ws + O_RWW); u16* rwa = (u16*)(p->ws + O_RWA); u16* rwg = (u16*)(p->ws + O_RWG);
  const float* w0 = p->in[4] + layer * 1024; const float* a0 = p->in[6] + layer * 1024;
  for (int t = bid; t < 3 * 256; t += nb) {
    const int job = t >> 8, tt = t & 255, m0 = (tt & 31) * 128, n0 = (tt >> 5) * 128;
    f32x4 acc[4][4]; ACC_ZERO(acc);
    if (job == 0) {
      gemm_kloop((const u16*)(p->ws + O_LAW) + (size_t)m0 * 64, 64, W + WWUP + (size_t)n0 * 64, 64, 2, acc, smem);
      f32x4 pj[4];
#pragma unroll
      for (int j = 0; j < 4; j++) pj[j] = *(const f32x4*)(w0 + COLJ(j));
      EPI_LOOP({ f32x4 sg = sigm4(pj[j] + v); f32x4 o; o[0] = __expf(-0.60653066f * sg[0]); o[1] = __expf(-0.60653066f * sg[1]); o[2] = __expf(-0.60653066f * sg[2]); o[3] = __expf(-0.60653066f * sg[3]);
                 *(f32x4*)(rww + (size_t)row * 1024 + col) = o; })
    } else if (job == 1) {
      gemm_kloop((const u16*)(p->ws + O_LAA) + (size_t)m0 * 64, 64, W + WAUP + (size_t)n0 * 64, 64, 2, acc, smem);
      f32x4 pj[4];
#pragma unroll
      for (int j = 0; j < 4; j++) pj[j] = *(const f32x4*)(a0 + COLJ(j));
      EPI_LOOP({ *(u32x2*)(rwa + (size_t)row * 1024 + col) = pack4v(sigm4(pj[j] + v)); })
    } else {
      gemm_kloop((const u16*)(p->ws + O_LAG) + (size_t)m0 * 192, 192, W + WGUP + (size_t)n0 * 192, 192, 6, acc, smem);
      EPI_LOOP({ *(u32x2*)(rwg + (size_t)row * 1024 + col) = pack4v(v); })
    }
  }
}

__device__ __forceinline__ void ph_rprep(PP p, int layer, int bid, int nb) {
  const u16* urw = (const u16*)(p->ws + O_URW); const u16* rwa = (const u16*)(p->ws + O_RWA);
  u16* pr = (u16*)(p->ws + O_PR); u16* pk = (u16*)(p->ws + O_PK); u16* pv = (u16*)(p->ws + O_PV);
  u16* pka = (u16*)(p->ws + O_PKA); u16* pkb = (u16*)(p->ws + O_PKB); float* bonus = (float*)(p->ws + O_BONUS);
  const float* mu = p->in[3] + layer * 3360; const float* kk_ = p->in[9] + layer * 1024; const float* ka_ = p->in[10] + layer * 1024;
  const float* rk_ = p->in[11] + layer * 1024;
  {
    u16* sxbc = (u16*)(p->ws + O_SXBC);
    const int gt = bid * NTHR + tidx(), gs = nb * NTHR;
    for (int idx = gt; idx < 8 * 3 * 3072; idx += gs) { int b = idx / 9216, c = idx - b * 9216; sxbc[(size_t)(b * 515) * 3072 + c] = sxbc[(size_t)(b * 515 + 512) * 3072 + c]; }
  }
  const int lane = tidx() & 63, wv = tidx() >> 6;
#pragma unroll 1
  for (int task = bid * 4 + wv; task < RS * 4; task += nb * 4) {
    const int r = task >> 2, col = (task & 3) * 256 + lane * 4;
    const size_t ro = (size_t)((r >> 9) * 513 + 1 + (r & 511)) * 3456 + col;
    f32x4 rc = cvt4(*(const u32x2*)(urw + ro)), rp = cvt4(*(const u32x2*)(urw + ro - 3456));
    f32x4 kc = cvt4(*(const u32x2*)(urw + ro + 1024)), kp = cvt4(*(const u32x2*)(urw + ro - 3456 + 1024));
    f32x4 vc = cvt4(*(const u32x2*)(urw + ro + 2048)), vp = cvt4(*(const u32x2*)(urw + ro - 3456 + 2048));
    f32x4 a = cvt4(*(const u32x2*)(rwa + (size_t)r * 1024 + col));
    f32x4 rr = rc + (rp - rc) * *(const f32x4*)(mu + col);
    f32x4 k = kc + (kp - kc) * *(const f32x4*)(mu + 1024 + col);
    f32x4 vv = vc + (vp - vc) * *(const f32x4*)(mu + 2048 + col);
    f32x4 kkv = k * *(const f32x4*)(kk_ + col);
    float n2 = red16(kkv[0] * kkv[0] + kkv[1] * kkv[1] + kkv[2] * kkv[2] + kkv[3] * kkv[3]);
    const float inv = 1.f / fmaxf(sqrtf(n2), 1e-12f);
    f32x4 kkn = kkv * inv;
    f32x4 kmod = k * (1.f + (a - 1.f) * *(const f32x4*)(ka_ + col));
    f32x4 bt = rr * kmod * *(const f32x4*)(rk_ + col);
    float bn = red16(bt[0] + bt[1] + bt[2] + bt[3]);
    const size_t o = (size_t)r * 1024 + col;
    *(u32x2*)(pr + o) = pack4(rr[0], rr[1], rr[2], rr[3]);
    *(u32x2*)(pk + o) = pack4(kmod[0], kmod[1], kmod[2], kmod[3]);
    *(u32x2*)(pv + o) = pack4(vv[0], vv[1], vv[2], vv[3]);
    *(u32x2*)(pka + o) = pack4(-kkn[0], -kkn[1], -kkn[2], -kkn[3]);
    *(u32x2*)(pkb + o) = pack4(kkn[0] * a[0], kkn[1] * a[1], kkn[2] * a[2], kkn[3] * a[3]);
    if ((lane & 15) == 0) bonus[r * 16 + (col >> 6)] = bn;
  }
}

struct ScanArgs {
  const u16 *pr, *pk, *pka, *pkb, *pv;
  const float *pw, *pvs;
  float *po, *state;
  int sr, sk, sab, sv, sw, svs, so;
};
#define TB 16
template <int KD, bool DELTA, bool WSCALAR, bool KFROMW, int LPR>
__device__ __forceinline__ void scan_task(const ScanArgs& a, bool first, bool save, char* smem) {
  constexpr int RB = 256 / LPR, GV = RB / 4; constexpr int KE = KD / LPR, NQ = KE / 4, NG = KD / 64, G4 = KD / 4;
  constexpr int OFF_R = 0, OFF_K = KD;
  constexpr int OFF_W = KFROMW ? KD : 2 * KD;
  constexpr int OFF_KA = OFF_W + (WSCALAR ? 0 : KD);
  constexpr int OFF_KB = OFF_KA + (DELTA ? KD : 0);
  constexpr int OFF_V = OFF_KB + (DELTA ? KD : 0);
  constexpr int OFF_S = OFF_V + RB;
  constexpr int STR = OFF_S + 4;
  float* buf0 = (float*)smem; float* buf1 = buf0 + TB * STR; float* obuf = buf1 + TB * STR;
  const int tid = tidx(), ks = tid & (LPR - 1), vr = tid / LPR;
  u32x2 gr[NG], gk[NG], gka[NG], gkb[NG], gv; f32x4 gw[NG]; float gsw = 0.f, gsv = 0.f;
  gv.x = gv.y = 0;
#define LOAD_BLK(blk_) { \
    const int row = (blk_) * TB; \
    _Pragma("unroll") for (int i = 0; i < NG; i++) { \
      const int g = tid + 256 * i, step = g / G4, e4 = g % G4; \
      gr[i] = *(const u32x2*)(a.pr + (size_t)(row + step) * a.sr + e4 * 4); \
      if (!KFROMW) gk[i] = *(const u32x2*)(a.pk + (size_t)(row + step) * a.sk + e4 * 4); \
      if (!WSCALAR) gw[i] = *(const f32x4*)(a.pw + (size_t)(row + step) * a.sw + e4 * 4); \
      if (DELTA) { gka[i] = *(const u32x2*)(a.pka + (size_t)(row + step) * a.sab + e4 * 4); gkb[i] = *(const u32x2*)(a.pkb + (size_t)(row + step) * a.sab + e4 * 4); } \
    } \
    if (tid < TB * GV) { const int step = tid / GV, e4 = tid % GV; gv = *(const u32x2*)(a.pv + (size_t)(row + step) * a.sv + e4 * 4); } \
    if (WSCALAR && tid < TB) { gsw = a.pw[(size_t)(row + tid) * a.sw]; gsv = a.pvs[(size_t)(row + tid) * a.svs]; } }
#define STORE_BLK(buf_) { \
    float* bufp = (buf_); \
    _Pragma("unroll") for (int i = 0; i < NG; i++) { \
      const int g = tid + 256 * i, step = g / G4, e4 = g % G4; \
      float* d = bufp + step * STR + e4 * 4; \
      *(f32x4*)(d + OFF_R) = cvt4(gr[i]); \
      if (!KFROMW) *(f32x4*)(d + OFF_K) = cvt4(gk[i]); \
      if (!WSCALAR) *(f32x4*)(d + OFF_W) = gw[i]; \
      if (DELTA) { *(f32x4*)(d + OFF_KA) = cvt4(gka[i]); *(f32x4*)(d + OFF_KB) = cvt4(gkb[i]); } \
    } \
    if (tid < TB * GV) { const int step = tid / GV, e4 = tid % GV; *(f32x4*)(bufp + step * STR + OFF_V + e4 * 4) = cvt4(gv); } \
    if (WSCALAR && tid < TB) { bufp[tid * STR + OFF_S] = gsw; bufp[tid * STR + OFF_S + 1] = gsv; } }
  float S[KE];
  if (first) {
#pragma unroll
    for (int e = 0; e < KE; e++) S[e] = 0.f;
  } else {
#pragma unroll
    for (int q = 0; q < NQ; q++) { float4 t = *(const float4*)(a.state + (size_t)vr * KD + q * (LPR * 4) + ks * 4); S[q * 4] = t.x; S[q * 4 + 1] = t.y; S[q * 4 + 2] = t.z; S[q * 4 + 3] = t.w; }
  }
  LOAD_BLK(0)
  __syncthreads();
  STORE_BLK(buf0)
  __syncthreads();
  constexpr int NBLK = SL / TB;
  for (int blk = 0; blk < NBLK; blk++) {
    float* buf = (blk & 1) ? buf1 : buf0;
    if (blk + 1 < NBLK) LOAD_BLK(blk + 1)
    {
      float rv1[KE], kb1[KE], kv[2][KE], wv[2][KE], kav[2][KE], vtv[2], wsv[2], vsv[2];
#define LD_STEP(slot, st_) { const float* sp = buf + (st_) * STR; \
        _Pragma("unroll") for (int q = 0; q < NQ; q++) { \
          if (!WSCALAR) { f32x4 u = *(const f32x4*)(sp + OFF_W + q * (LPR * 4) + ks * 4); wv[slot][q * 4] = u[0]; wv[slot][q * 4 + 1] = u[1]; wv[slot][q * 4 + 2] = u[2]; wv[slot][q * 4 + 3] = u[3]; } \
          if (!KFROMW) { f32x4 u = *(const f32x4*)(sp + OFF_K + q * (LPR * 4) + ks * 4); kv[slot][q * 4] = u[0]; kv[slot][q * 4 + 1] = u[1]; kv[slot][q * 4 + 2] = u[2]; kv[slot][q * 4 + 3] = u[3]; } \
          if (DELTA) { f32x4 u = *(const f32x4*)(sp + OFF_KA + q * (LPR * 4) + ks * 4); kav[slot][q * 4] = u[0]; kav[slot][q * 4 + 1] = u[1]; kav[slot][q * 4 + 2] = u[2]; kav[slot][q * 4 + 3] = u[3]; \
                     } \
        } \
        vtv[slot] = sp[OFF_V + vr]; \
        if (WSCALAR) { wsv[slot] = sp[OFF_S]; vsv[slot] = sp[OFF_S + 1]; } }
      LD_STEP(0, 0)
#define DO_STEP(cs, step_) { \
        { const float* spr = buf + (step_) * STR; _Pragma("unroll") for (int q = 0; q < NQ; q++) { f32x4 t = *(const f32x4*)(spr + OFF_R + q * (LPR * 4) + ks * 4); rv1[q * 4] = t[0]; rv1[q * 4 + 1] = t[1]; rv1[q * 4 + 2] = t[2]; rv1[q * 4 + 3] = t[3]; \
            if (DELTA) { f32x4 x = *(const f32x4*)(spr + OFF_KB + q * (LPR * 4) + ks * 4); kb1[q * 4] = x[0]; kb1[q * 4 + 1] = x[1]; kb1[q * 4 + 2] = x[2]; kb1[q * 4 + 3] = x[3]; } } } \
        float vt = vtv[cs]; \
        if (WSCALAR) vt *= vsv[cs]; \
        if (DELTA) { \
          float sa0 = 0.f, sa1 = 0.f, sa2 = 0.f, sa3 = 0.f; \
          _Pragma("unroll") for (int e = 0; e < KE; e += 2) { sa0 = fmaf(S[e], kav[cs][e], sa0); sa1 = fmaf(S[e + 1], kav[cs][e + 1], sa1); } \
          _Pragma("unroll") for (int e = 0; e < KE; e++) S[e] = fmaf(S[e], wv[cs][e], vt * kv[cs][e]); \
          float sa = (LPR == 8) ? red8((sa0 + sa1) + (sa2 + sa3)) : red4((sa0 + sa1) + (sa2 + sa3)); \
          _Pragma("unroll") for (int e = 0; e < KE; e++) S[e] = fmaf(sa, kb1[e], S[e]); \
        } else { \
          _Pragma("unroll") for (int e = 0; e < KE; e++) { \
            float w = WSCALAR ? wsv[cs] : wv[cs][e]; \
            float k = KFROMW ? (1.f - wv[cs][e]) : kv[cs][e]; \
            S[e] = fmaf(S[e], w, vt * k); } \
        } \
        float o0 = 0.f, o1 = 0.f, o2 = 0.f, o3 = 0.f; \
        _Pragma("unroll") for (int e = 0; e < KE; e += 2) { o0 = fmaf(S[e], rv1[e], o0); o1 = fmaf(S[e + 1], rv1[e + 1], o1); } \
        float o = (LPR == 8) ? red8((o0 + o1) + (o2 + o3)) : red4((o0 + o1) + (o2 + o3)); \
        if (ks == 0) obuf[(step_) * RB + vr] = o; }
#pragma unroll 1
      for (int step = 0; step < TB; step += 2) {
        LD_STEP(1, step + 1)
        DO_STEP(0, step)
        if (step + 2 < TB) LD_STEP(0, step + 2)
        DO_STEP(1, step + 1)
      }
    }
    __syncthreads();
    {
      const int row = blk * TB;
#pragma unroll
      for (int i = 0; i < TB * RB / 256; i++) { const int idx = tid + 256 * i, step = idx / RB, v2 = idx % RB; a.po[(size_t)(row + step) * a.so + v2] = obuf[idx]; }
    }
    if (blk + 1 < NBLK) STORE_BLK((blk & 1) ? buf0 : buf1)
    __syncthreads();
  }
  if (save)
#pragma unroll
  for (int q = 0; q < NQ; q++) { float4 t; t.x = S[q * 4]; t.y = S[q * 4 + 1]; t.z = S[q * 4 + 2]; t.w = S[q * 4 + 3]; *(float4*)(a.state + (size_t)vr * KD + q * (LPR * 4) + ks * 4) = t; }
}


struct ChunkArgs { const u16 *q, *k, *v; const float* lf; float* o; float* state; int ld, ldlf; float expA; };
#define QLD 136
#define KHLD 72
template <bool SSM>
__device__ __forceinline__ void chunk_task(const ChunkArgs& a, bool first, bool save, char* smem) {
  u16* QT = (u16*)smem;
  u16* KT = QT + 64 * QLD;
  u16* KH = KT + 64 * QLD;
  u16* VT = KH + 128 * KHLD;
  u16* ST = VT + 32 * KHLD;
  float* gam = (float*)(ST + 32 * QLD); float* em = gam + 128; float* cum = gam + 256; float* dts = gam + 512;
  const int tid = tidx(), lane = tid & 63, g = lane >> 4, c = lane & 15;
  const int w = __builtin_amdgcn_readfirstlane(tid >> 6);
  f32x4 accS[2][2];
#pragma unroll
  for (int i = 0; i < 2; i++)
#pragma unroll
    for (int j = 0; j < 2; j++)
      accS[i][j] = first ? (f32x4){0.f, 0.f, 0.f, 0.f} : *(const f32x4*)(a.state + (size_t)((i * 2 + j) * 256 + tid) * 4);
  float rcn[32]; u16 qan[32], kan[32]; u32x4 cqn[4], ckn[4], vvn; float dtn = 0.f;
#define CH_PREFETCH(chn_) { const int rp = (chn_) * 64; \
    if (!SSM) { const int d = tid & 127, half = tid >> 7; \
      const float* lfp = a.lf + (size_t)(rp + half * 32) * a.ldlf + d; \
      const u16* qp = a.q + (size_t)(rp + half * 32) * a.ld + d; const u16* kp = a.k + (size_t)(rp + half * 32) * a.ld + d; \
      _Pragma("unroll") for (int i = 0; i < 32; i++) rcn[i] = lfp[(size_t)i * a.ldlf]; \
      _Pragma("unroll") for (int i = 0; i < 32; i++) { qan[i] = qp[(size_t)i * a.ld]; kan[i] = kp[(size_t)i * a.ld]; } \
    } else { \
      _Pragma("unroll") for (int i = 0; i < 4; i++) { const int id = tid + 256 * i, s = id >> 4, cc = id & 15; \
        cqn[i] = *(const u32x4*)(a.q + (size_t)(rp + s) * a.ld + cc * 8); ckn[i] = *(const u32x4*)(a.k + (size_t)(rp + s) * a.ld + cc * 8); } \
      if (tid < 64) dtn = a.lf[(size_t)(rp + tid) * a.ldlf]; \
    } \
    { const int s = tid & 63, vg = tid >> 6; vvn = *(const u32x4*)(a.v + (size_t)(rp + s) * a.ld + vg * 8); } }
  CH_PREFETCH(0)
#pragma unroll 1
  for (int ch = 0; ch < SL / 64; ch++) {
    const int r0 = ch * 64;
    float rc[32]; float kf[32]; float rc63 = 0.f;
    if (!SSM) {
      const int d = tid & 127, half = tid >> 7;
#pragma unroll
      for (int i = 0; i < 32; i++) rc[i] = rcn[i];
      float tot = 0.f;
      if (half == 0) {
        float acc = 0.f;
#pragma unroll
        for (int i = 31; i >= 0; i--) { float l = rc[i]; tot += l; rc[i] = acc; acc -= l; }
        em[d] = __expf(tot);
      } else {
        float acc = 0.f;
#pragma unroll
        for (int i = 0; i < 32; i++) { acc += rc[i]; rc[i] = acc; }
        tot = acc;
      }
      cum[half * 128 + d] = tot;
#pragma unroll
      for (int i = 0; i < 32; i++) {
        const int s = half * 32 + i;
        float qv = bf2f(qan[i]); kf[i] = bf2f(kan[i]);
        float r = rc[i];
        QT[s * QLD + d] = f2bf(qv * __expf(fminf(r, 80.f)));
        KT[s * QLD + d] = f2bf(kf[i] * __expf(fminf(-r, 80.f)));
      }
    } else {
#pragma unroll
      for (int i = 0; i < 4; i++) {
        const int id = tid + 256 * i, s = id >> 4, cc = id & 15;
        *(u32x4*)(QT + s * QLD + cc * 8) = cqn[i];
        *(u32x4*)(KT + s * QLD + cc * 8) = ckn[i];
      }
      if (tid < 64) {
        float dtv = dtn;
        float x = -dtv * a.expA;
#pragma unroll
        for (int o = 1; o < 64; o <<= 1) { float y = __shfl_up(x, o); if (lane >= o) x += y; }
        cum[tid] = x; dts[tid] = dtv;
      }
    }
    {
      const int s = tid & 63, vg = tid >> 6;
      u32x4 vv = vvn;
#pragma unroll
      for (int j = 0; j < 4; j++) { VT[(vg * 8 + 2 * j) * KHLD + s] = (u16)(vv[j] & 0xffffu); VT[(vg * 8 + 2 * j + 1) * KHLD + s] = (u16)(vv[j] >> 16); }
    }
    __syncthreads();
#pragma unroll
    for (int dt2 = 0; dt2 < 2; dt2++) {
      const int d0 = (2 * w + dt2) * 16 + 4 * g;
      f32x4 e4 = (f32x4){1.f, 1.f, 1.f, 1.f};
      if (!SSM) e4 = *(const f32x4*)(em + d0);
#pragma unroll
      for (int vt = 0; vt < 2; vt++) {
        f32x4 sv = accS[dt2][vt] * e4;
        u32x2 pk; pk.x = pk2(sv[0], sv[1]); pk.y = pk2(sv[2], sv[3]);
        *(u32x2*)(ST + (16 * vt + c) * QLD + d0) = pk;
      }
    }
    if (!SSM) {
      const int d = tid & 127, half = tid >> 7;
      const float t0 = cum[d], t1 = cum[128 + d];
      rc63 = t1;
      if (half == 0) gam[d] = __expf(t0 + t1);
#pragma unroll
      for (int i = 0; i < 32; i++) KH[d * KHLD + half * 32 + i] = f2bf(kf[i] * __expf(rc63 - rc[i]));
    }
    if (SSM) {
      const int s = tid & 63, ng = tid >> 6;
      const float sc = __expf(cum[63] - cum[s]) * dts[s];
#pragma unroll
      for (int i = 0; i < 4; i++) {
        u32x4 kk = *(const u32x4*)(KT + s * QLD + ng * 32 + i * 8);
#pragma unroll
        for (int j = 0; j < 4; j++) {
          const int n = ng * 32 + i * 8 + 2 * j;
          KH[n * KHLD + s] = f2bf(__uint_as_float(kk[j] << 16) * sc);
          KH[(n + 1) * KHLD + s] = f2bf(__uint_as_float(kk[j] & 0xffff0000u) * sc);
        }
      }
    }
    __syncthreads();
    if (ch + 1 < SL / 64) CH_PREFETCH(ch + 1)
    {
      const int t = 16 * w + c;
      bf16x8 bq[4];
#pragma unroll
      for (int ks = 0; ks < 4; ks++) bq[ks] = *(const bf16x8*)(QT + t * QLD + ks * 32 + g * 8);
      f32x4 accp[4];
#pragma unroll
      for (int st = 0; st < 4; st++) {
        accp[st] = (f32x4){0.f, 0.f, 0.f, 0.f};
        if (st <= w) {
#pragma unroll
          for (int ks = 0; ks < 4; ks++) {
            bf16x8 ak = *(const bf16x8*)(KT + (16 * st + c) * QLD + ks * 32 + g * 8);
            accp[st] = __builtin_amdgcn_mfma_f32_16x16x32_bf16(ak, bq[ks], accp[st], 0, 0, 0);
          }
        }
      }
      float cumt = 0.f;
      if (SSM) cumt = cum[t];
#pragma unroll
      for (int st = 0; st < 4; st++)
#pragma unroll
        for (int r = 0; r < 4; r++) {
          const int s = 16 * st + 4 * g + r;
          float v = accp[st][r];
          if (SSM) v *= __expf(fminf(cumt - cum[s], 0.f)) * dts[s];
          accp[st][r] = (s <= t) ? v : 0.f;
        }
      bf16x8 bp[2];
#pragma unroll
      for (int a2 = 0; a2 < 2; a2++)
#pragma unroll
        for (int j = 0; j < 4; j++) { bp[a2][j] = (short)f2bf(accp[2 * a2][j]); bp[a2][4 + j] = (short)f2bf(accp[2 * a2 + 1][j]); }
      f32x4 acco[2], acco2[2];
#pragma unroll
      for (int vt = 0; vt < 2; vt++) {
        acco[vt] = (f32x4){0.f, 0.f, 0.f, 0.f}; acco2[vt] = (f32x4){0.f, 0.f, 0.f, 0.f};
#pragma unroll
        for (int a2 = 0; a2 < 2; a2++) {
          if (2 * a2 <= w) {
            const u16* vp = VT + (16 * vt + c) * KHLD + 32 * a2 + 4 * g;
            u32x2 lo = *(const u32x2*)vp, hi = *(const u32x2*)(vp + 16);
            u32x4 cmb; cmb.x = lo.x; cmb.y = lo.y; cmb.z = hi.x; cmb.w = hi.y;
            bf16x8 av = __builtin_bit_cast(bf16x8, cmb);
            acco[vt] = __builtin_amdgcn_mfma_f32_16x16x32_bf16(av, bp[a2], acco[vt], 0, 0, 0);
          }
        }
#pragma unroll
        for (int ks = 0; ks < 4; ks++) {
          bf16x8 as = *(const bf16x8*)(ST + (16 * vt + c) * QLD + ks * 32 + g * 8);
          if (SSM) acco2[vt] = __builtin_amdgcn_mfma_f32_16x16x32_bf16(as, bq[ks], acco2[vt], 0, 0, 0);
          else acco[vt] = __builtin_amdgcn_mfma_f32_16x16x32_bf16(as, bq[ks], acco[vt], 0, 0, 0);
        }
        f32x4 ov = acco[vt];
        if (SSM) ov += __expf(cumt) * acco2[vt];
        *(f32x4*)(a.o + (size_t)(r0 + t) * 4096 + 16 * vt + 4 * g) = ov;
      }
#pragma unroll
      for (int dt2 = 0; dt2 < 2; dt2++) {
        const int d0 = (2 * w + dt2) * 16;
        f32x4 gm;
        if (SSM) { float gs = __expf(cum[63]); gm = (f32x4){gs, gs, gs, gs}; }
        else gm = *(const f32x4*)(gam + d0 + 4 * g);
#pragma unroll
        for (int vt = 0; vt < 2; vt++) accS[dt2][vt] *= gm;
#pragma unroll
        for (int a2 = 0; a2 < 2; a2++) {
          bf16x8 ak = *(const bf16x8*)(KH + (d0 + c) * KHLD + 32 * a2 + 8 * g);
#pragma unroll
          for (int vt = 0; vt < 2; vt++) {
            bf16x8 bv = *(const bf16x8*)(VT + (16 * vt + c) * KHLD + 32 * a2 + 8 * g);
            accS[dt2][vt] = __builtin_amdgcn_mfma_f32_16x16x32_bf16(ak, bv, accS[dt2][vt], 0, 0, 0);
          }
        }
      }
    }
    __syncthreads();
  }
  if (save)
#pragma unroll
  for (int i = 0; i < 2; i++)
#pragma unroll
    for (int j = 0; j < 2; j++) *(f32x4*)(a.state + (size_t)((i * 2 + j) * 256 + tid) * 4) = accS[i][j];
}

__device__ __forceinline__ void chunk_dispatch(PP p, int layer, int ct, bool first, bool save, char* smem) {
  float* so = (float*)(p->ws + O_SO);
  ChunkArgs a;
  if (ct < 256) {
    const int vs = ct & 3, h = (ct >> 2) & 7, b = ct >> 5;
    const size_t ro = (size_t)b * SL * 1024 + h * 128;
    a.q = (const u16*)(p->ws + O_HQ) + ro; a.k = (const u16*)(p->ws + O_HK) + ro; a.v = (const u16*)(p->ws + O_HV) + ro + vs * 32;
    a.lf = (const float*)(p->ws + O_HW) + ro; a.o = so + (size_t)b * SL * 4096 + 1024 + h * 128 + vs * 32;
    a.state = (float*)(p->ws + O_STHG) + (size_t)ct * 4096; a.ld = 1024; a.ldlf = 1024; a.expA = 0.f;
    chunk_task<false>(a, first, save, smem);
  } else {
    const int t2 = ct - 256, vs = t2 & 1, hd = (t2 >> 1) & 31, b = t2 >> 6, g = hd >> 3;
    const u16* x2 = (const u16*)(p->ws + O_SX2) + (size_t)b * SL * 3072;
    a.q = x2 + 2560 + g * 128; a.k = x2 + 2048 + g * 128; a.v = x2 + hd * 64 + vs * 32;
    a.lf = (const float*)(p->ws + O_SDT) + (size_t)b * SL * 32 + hd; a.o = so + (size_t)b * SL * 4096 + 2048 + hd * 64 + vs * 32;
    a.state = (float*)(p->ws + O_STSS) + (size_t)t2 * 4096; a.ld = 3072; a.ldlf = 32; a.expA = __expf(p->in[19][layer * 32 + hd]);
    chunk_task<true>(a, first, save, smem);
  }
}
__device__ __forceinline__ void rwkv_dispatch(PP p, int task, bool first, bool save, char* smem) {
  float* so = (float*)(p->ws + O_SO);
  ScanArgs a;
  const int h = task & 15, b = task >> 4;
  const size_t ro = (size_t)b * SL * 1024 + h * 64;
  a.pr = (const u16*)(p->ws + O_PR) + ro; a.pk = (const u16*)(p->ws + O_PK) + ro; a.pka = (const u16*)(p->ws + O_PKA) + ro; a.pkb = (const u16*)(p->ws + O_PKB) + ro;
  a.pv = (const u16*)(p->ws + O_PV) + ro; a.pw = (const float*)(p->ws + O_RWW) + ro; a.pvs = nullptr;
  a.po = so + (size_t)b * SL * 4096 + h * 64; a.state = (float*)(p->ws + O_STRW) + (size_t)(b * 16 + h) * 4096;
  a.sr = a.sk = a.sab = a.sv = a.sw = 1024; a.svs = 0; a.so = 4096;
  __builtin_amdgcn_s_setprio(3);
  scan_task<64, true, false, false, 4>(a, first, save, smem);
  __builtin_amdgcn_s_setprio(0);
}
template <int BR> __device__ __forceinline__ void merge_tile(PP p, int layer, int seg, int t, char* smem);
__device__ __forceinline__ void merge_item(PP p, int layer, int seg, int t, char* smem);
__device__ __forceinline__ void ph_scan(PP p, int layer, int seg, int bid, int nb, char* smem, volatile LAS unsigned* bw) {
  const bool first = (seg == 0);
  unsigned* ctr = (unsigned*)(p->ws + O_BAR) + 3520;
  const unsigned base = (unsigned)(layer * NSEG + seg) * (unsigned)(1024 + nb);
  if (bid < 128) { rwkv_dispatch(p, bid, first, true, smem); __syncthreads(); }
#pragma unroll 1
  for (;;) {
    if (tidx() == 0) *bw = __hip_atomic_fetch_add(ctr, 1u, __ATOMIC_RELAXED, __HIP_MEMORY_SCOPE_AGENT);
    __syncthreads();
    const unsigned it = *bw - base;
    __syncthreads();
    if (it >= 1024u) break;
    if (it < 256u) { if (seg > 0) merge_item(p, layer, seg - 1, (int)it, smem); }
    else chunk_dispatch(p, layer, (int)it - 256, first, true, smem);
    __syncthreads();
  }
}

__device__ __forceinline__ void ph_post(PP p, int layer, int bid, int nb) {
  const float* so = (const float*)(p->ws + O_SO); u16* y = (u16*)(p->ws + O_Y);
  const int lane = tidx() & 63, wv = tidx() >> 6;
  {
    u16* urw = (u16*)(p->ws + O_URW);
    const int gt = bid * NTHR + tidx(), gs = nb * NTHR;
    for (int idx = gt; idx < 8 * 3456; idx += gs) { int b = idx / 3456, c = idx - b * 3456; urw[(size_t)(b * 513) * 3456 + c] = urw[(size_t)(b * 513 + 512) * 3456 + c]; }
  }
  const u16* pv = (const u16*)(p->ws + O_PV); const u16* rwg = (const u16*)(p->ws + O_RWG); const float* bonus = (const float*)(p->ws + O_BONUS);
  const float* gnw = p->in[12] + layer * 1024; const float* gnb = p->in[13] + layer * 1024;
  const u16* hg = (const u16*)(p->ws + O_HG); const float* hgn = p->in[15] + layer * 1024;
  const u16* sx2 = (const u16*)(p->ws + O_SX2); const u16* sz = (const u16*)(p->ws + O_SZ);
  const float* dsk = p->in[20] + layer * 32; const float* sgn = p->in[21] + layer * 2048;
#pragma unroll 1
  for (int task = bid * 4 + wv; task < RS * 12; task += nb * 4) {
    const int r = task / 12, s = task - r * 12;
    if (s < 4) {
      const int col = s * 256 + lane * 4;
      f32x4 o = *(const f32x4*)(so + (size_t)r * 4096 + col);
      const float mean = red16(o[0] + o[1] + o[2] + o[3]) * (1.f / 64.f);
      f32x4 d = o - mean;
      const float var = red16(d[0] * d[0] + d[1] * d[1] + d[2] * d[2] + d[3] * d[3]) * (1.f / 64.f);
      f32x4 on = d * rsqrtf(var + 64e-5f) * *(const f32x4*)(gnw + col) + *(const f32x4*)(gnb + col);
      on += bonus[r * 16 + (col >> 6)] * cvt4(*(const u32x2*)(pv + (size_t)r * 1024 + col));
      on *= cvt4(*(const u32x2*)(rwg + (size_t)r * 1024 + col));
      *(u32x2*)(y + (size_t)r * 4096 + col) = pack4(on[0], on[1], on[2], on[3]);
    } else if (s < 8) {
      const int c = (s - 4) * 256 + lane * 4;
      f32x4 o = *(const f32x4*)(so + (size_t)r * 4096 + 1024 + c);
      float ss = red16(o[0] * o[0] + o[1] * o[1] + o[2] * o[2] + o[3] * o[3]);
      ss += __shfl_xor(ss, 16);
      const float rstd = rsqrtf(ss * (1.f / 128.f) + 1e-5f);
      f32x4 on = o * rstd * *(const f32x4*)(hgn + c) * cvt4(*(const u32x2*)(hg + (size_t)r * 1024 + c));
      *(u32x2*)(y + (size_t)r * 4096 + 1024 + c) = pack4(on[0], on[1], on[2], on[3]);
    } else {
      const int g = s - 8, ch = g * 512 + lane * 8;
      f32x4 o0 = *(const f32x4*)(so + (size_t)r * 4096 + 2048 + ch), o1 = *(const f32x4*)(so + (size_t)r * 4096 + 2048 + ch + 4);
      u32x4 xr = *(const u32x4*)(sx2 + (size_t)r * 3072 + ch), zr = *(const u32x4*)(sz + (size_t)r * 2048 + ch);
      u32x2 t0; t0.x = xr.x; t0.y = xr.y; u32x2 t1; t1.x = xr.z; t1.y = xr.w;
      u32x2 z0; z0.x = zr.x; z0.y = zr.y; u32x2 z1; z1.x = zr.z; z1.y = zr.w;
      const float dk = dsk[ch >> 6];
      f32x4 y0 = (o0 + dk * cvt4(t0)) * cvt4(z0), y1 = (o1 + dk * cvt4(t1)) * cvt4(z1);
      float ss = y0[0] * y0[0] + y0[1] * y0[1] + y0[2] * y0[2] + y0[3] * y0[3] + y1[0] * y1[0] + y1[1] * y1[1] + y1[2] * y1[2] + y1[3] * y1[3];
      ss = red16(ss); ss += __shfl_xor(ss, 16); ss += __shfl_xor(ss, 32);
      const float rstd = rsqrtf(ss * (1.f / 512.f) + 1e-5f);
      y0 = y0 * rstd * *(const f32x4*)(sgn + ch); y1 = y1 * rstd * *(const f32x4*)(sgn + ch + 4);
      u32x4 ov; ov.x = pk2(y0[0], y0[1]); ov.y = pk2(y0[2], y0[3]); ov.z = pk2(y1[0], y1[1]); ov.w = pk2(y1[2], y1[3]);
      *(u32x4*)(y + (size_t)r * 4096 + 2048 + ch) = ov;
    }
  }
}

#define MT_ROW(row) ((size_t)(((row) >> 9) * 515 + 3 + ((row) & 511)) * 1536)
template <int BR>
__device__ __forceinline__ void merge_tile(PP p, int layer, int seg, int t, char* smem) {
  const u16* W = (const u16*)(p->ws + O_W) + (size_t)layer * W_LAYER + WBR;
  const u16* Y = (const u16*)(p->ws + O_Y); const u16* gp = (const u16*)(p->ws + ((seg & 1) ? O_GATES2 : O_GATES)) + BR * 1024; u16* mg = (u16*)(p->ws + O_MERGED);
  float* mt = (float*)(p->ws + O_SXBC);
  constexpr int k0 = BR * 1024, nkt = BR == 2 ? 64 : 32;
  const int m0 = (t & 31) * 128, n0 = (t >> 5) * 128;
  f32x4 acc[4][4]; ACC_ZERO(acc);
  gemm_kloop(Y + (size_t)m0 * 4096 + k0, 4096, W + (size_t)n0 * 4096 + k0, 4096, nkt, acc, smem);
  EPI_LOOP2({ l0[j] = cvt4(*(const u32x2*)(gp + (size_t)row * 3072 + col)); if (BR > 0) l1[j] = *(const f32x4*)(mt + MT_ROW(row) + col); else l1[j] = f4z(); },
            { const f32x4 gsum = l1[j] + l0[j] * v; if (BR < 2) *(f32x4*)(mt + MT_ROW(row) + col) = gsum; else *(u32x2*)(mg + (size_t)row * 1024 + col) = pack4v(gsum); })
}
__device__ __forceinline__ void merge_item(PP p, int layer, int seg, int t, char* smem) {
  merge_tile<0>(p, layer, seg, t, smem);
  merge_tile<1>(p, layer, seg, t, smem);
  merge_tile<2>(p, layer, seg, t, smem);
}
__device__ __forceinline__ void ph_merge(PP p, int layer, int seg, int bid, int nb, char* smem) {
#pragma unroll 1
  for (int t = bid; t < 256; t += nb) merge_item(p, layer, seg, t, smem);
}
__device__ __forceinline__ void ph_out(PP p, int layer, int seg, int bid, int nb, char* smem) {
  const u16* W = (const u16*)(p->ws + O_W) + (size_t)layer * W_LAYER + WOUT;
  const u16* mg = (const u16*)(p->ws + O_MERGED);
  const float* xs = layer == 0 ? p->in[0] : p->out;
  for (int t = bid; t < 256; t += nb) {
    const int m0 = (t & 31) * 128, n0 = (t >> 5) * 128;
    f32x4 acc[4][4]; ACC_ZERO(acc);
    gemm_kloop(mg + (size_t)m0 * 1024, 1024, W + (size_t)n0 * 1024, 1024, 32, acc, smem);
    EPI_LOOP2({ size_t gr = (size_t)(row >> 9) * SEQ + seg * SL + (row & 511); l0[j] = *(const f32x4*)(xs + gr * 1024 + col); },
              { size_t gr = (size_t)(row >> 9) * SEQ + seg * SL + (row & 511); *(f32x4*)(p->out + gr * 1024 + col) = l0[j] + v; })
  }
}
__device__ __forceinline__ void ph_ffi(PP p, int layer, int bid, int nb, char* smem) {
  const u16* W = (const u16*)(p->ws + O_W) + (size_t)layer * W_LAYER + WFFI;
  const u16* H2 = (const u16*)(p->ws + O_H2); u16* hid = (u16*)(p->ws + O_HID);
  for (int t = bid; t < 128 * 44; t += nb) {
    const int m0 = (t & 127) * 256, n0 = (t >> 7) * 128;
    f32x4 acc[8][4]; ACC_ZERO(acc);
    gemm_kloop(H2 + (size_t)m0 * 1024, 1024, W + (size_t)n0 * 1024, 1024, 32, acc, smem);
    const int lane = tidx() & 63, wave = tidx() >> 6, wm = wave >> 1, wn = wave & 1;
#pragma unroll
    for (int i = 0; i < 8; i++)
#pragma unroll
      for (int j = 0; j < 4; j += 2) {
        const int row = m0 + wm * 128 + i * 16 + (lane & 15);
        const int ng = n0 + wn * 64 + j * 16 + (lane >> 4) * 4;
        const int hc = (ng >> 5) * 16 + (ng & 15);
        const f32x4 g = acc[i][j], u = acc[i][j + 1];
        *(u32x2*)(hid + (size_t)row * 2816 + hc) = pack4v(g * sigm4(g) * u);
      }
  }
}
__device__ __forceinline__ void ph_ffo(PP p, int layer, int bid, int nb, char* smem) {
  const u16* W = (const u16*)(p->ws + O_W) + (size_t)layer * W_LAYER + WFFO;
  const u16* hid = (const u16*)(p->ws + O_HID);
  for (int t = bid; t < 128 * 8; t += nb) {
    const int m0 = (t & 127) * 256, n0 = (t >> 7) * 128;
    f32x4 acc[8][4]; ACC_ZERO(acc);
    gemm_kloop(hid + (size_t)m0 * 2816, 2816, W + (size_t)n0 * 2816, 2816, 88, acc, smem);
    float* outp = p->out;
    EPI_LOOP2({ l0[j] = *(const f32x4*)(outp + (size_t)row * 1024 + col); }, { *(f32x4*)(outp + (size_t)row * 1024 + col) = l0[j] + v; })
  }
}

__device__ __forceinline__ void ph_norm1(PP p, int layer, int seg, int bid, int nb) {
  if (seg == 0) {
    u16* urw = (u16*)(p->ws + O_URW); u16* sxbc = (u16*)(p->ws + O_SXBC);
    const int gt = bid * NTHR + tidx(), gs = nb * NTHR;
    for (int idx = gt; idx < 8 * 3456; idx += gs) { int b = idx / 3456, c = idx - b * 3456; urw[(size_t)(b * 513) * 3456 + c] = 0; }
    for (int idx = gt; idx < 8 * 9216; idx += gs) { int b = idx / 9216, c = idx - b * 9216; sxbc[(size_t)(b * 515) * 3072 + c] = 0; }
  }
  rmsnorm_rows(layer == 0 ? p->in[0] : p->out, p->in[1] + layer * 1024, (u16*)(p->ws + O_H), nullptr, RS, 0, seg, bid, nb);
}

#define XB_TMO      128
#define XB_XCNT(j)  (256  + 64 * (j))
#define XB_XSUB(j)  (1280 + 64 * (j))
#define XB_XGEN(j)  (2304 + 64 * (j))
#define XB_TOP      3328
#define XB_TOPGEN   3392
#define XCD_BAR_WORDS 3456
#define XB_SPIN_CAP (1u << 22)
__device__ __forceinline__ unsigned xb_ld(unsigned* p)              { return __hip_atomic_load(p, __ATOMIC_RELAXED, __HIP_MEMORY_SCOPE_AGENT); }
__device__ __forceinline__ unsigned xb_add(unsigned* p, unsigned v) { return __hip_atomic_fetch_add(p, v, __ATOMIC_RELAXED, __HIP_MEMORY_SCOPE_AGENT); }
__device__ __forceinline__ unsigned xb_xcc_id() { return (unsigned)__builtin_amdgcn_s_getreg((3 << 11) | 20) & 0xFu; }
#define XB_SPIN(cond, bar) do { unsigned _sp = 0; while (cond) { __builtin_amdgcn_s_sleep(1); \
    if ((++_sp & 255u) == 0u) { if (xb_ld(&(bar)[XB_TMO])) break; if (_sp > XB_SPIN_CAP) { atomicAdd(&(bar)[XB_TMO], 1u); break; } } } } while (0)
struct XcdBarrier { unsigned* bar; unsigned x; volatile LAS unsigned* st; };
__device__ __forceinline__ XcdBarrier xcd_barrier_post(unsigned* bar, volatile LAS unsigned* st) {
  XcdBarrier b; b.bar = bar; b.x = xb_xcc_id(); b.st = st;
  if (threadIdx.x == 0) (void)xb_add(&bar[XB_XCNT(b.x)], 1u);
  return b;
}
__device__ __forceinline__ void xcd_barrier_complete(unsigned* bar, unsigned x, unsigned& nloc, unsigned& nx) {
  const unsigned G = gridDim.x * gridDim.y * gridDim.z;
  unsigned sum, cnt, mine, sp = 0u;
  for (;;) {
    sum = 0u; cnt = 0u; mine = 0u;
#pragma unroll
    for (unsigned j = 0; j < 16; ++j) { const unsigned c = xb_ld(&bar[XB_XCNT(j)]); sum += c; cnt += (c > 0u) ? 1u : 0u; mine = (j == x) ? c : mine; }
    if (sum == G) break;
    __builtin_amdgcn_s_sleep(1);
    if ((++sp & 255u) == 0u) { if (xb_ld(&bar[XB_TMO])) break; if (sp > XB_SPIN_CAP) { atomicAdd(&bar[XB_TMO], 1u); break; } }
  }
  nloc = mine > 0u ? mine : 1u; nx = cnt > 0u ? cnt : 1u;
}
__device__ __forceinline__ void xcd_barrier(const XcdBarrier& b) {
  asm volatile("s_waitcnt vmcnt(0)" ::: "memory");
  __syncthreads();
  if (threadIdx.x == 0) {
    unsigned* bar = b.bar;
    __builtin_amdgcn_s_waitcnt(0);
    unsigned nloc = b.st[0], nx = b.st[1];
    if (nloc == 0u) { xcd_barrier_complete(bar, b.x, nloc, nx); b.st[0] = nloc; b.st[1] = nx; }
    const unsigned old = xb_add(&bar[XB_XSUB(b.x)], 1u);
    const unsigned gen = old / nloc;
    if (old + 1u == (gen + 1u) * nloc) {
      __builtin_amdgcn_fence(__ATOMIC_RELEASE, "agent");
      asm volatile("s_waitcnt vmcnt(0)" ::: "memory");
      const unsigned og = xb_add(&bar[XB_TOP], 1u);
      const unsigned tg = og / nx;
      if (og + 1u == (tg + 1u) * nx) xb_add(&bar[XB_TOPGEN], 1u);
      else XB_SPIN(xb_ld(&bar[XB_TOPGEN]) == tg, bar);
      __builtin_amdgcn_fence(__ATOMIC_ACQUIRE, "agent");
      xb_add(&bar[XB_XGEN(b.x)], 1u);
      asm volatile("s_waitcnt vmcnt(0)" ::: "memory");
    } else {
      XB_SPIN(xb_ld(&bar[XB_XGEN(b.x)]) == gen, bar);
      __builtin_amdgcn_fence(__ATOMIC_ACQUIRE, "agent");
      asm volatile("s_waitcnt vmcnt(0)" ::: "memory");
    }
  }
  __syncthreads();
}

#define SMEM_BYTES 73728
#ifndef SCANPROBE
#define SCANPROBE 0
#endif
#ifndef PHMASK
#define PHMASK 0xFFFF
#endif
#ifndef DBLMASK
#define DBLMASK 0
#endif
#define RUN(idx, call) { if ((PHMASK >> (idx)) & 1) { if ((DBLMASK >> (idx)) & 1) { call; __syncthreads(); } call; } }
__global__ void __launch_bounds__(NTHR, 2) mega(Params p_) {
  __shared__ __attribute__((aligned(1024))) char smem[SMEM_BYTES + 16];
  uint4& xb_words = *(uint4*)(smem + SMEM_BYTES);
  cg::grid_group grid = cg::this_grid();
  if (threadIdx.x == 0) xb_words = make_uint4(0u, 0u, 0u, 0u);
  __syncthreads();
  XcdBarrier xb = xcd_barrier_post((unsigned*)(p_.ws + O_BAR), (volatile LAS unsigned*)&xb_words);
  {
    PP p = (PP)__builtin_amdgcn_kernarg_segment_ptr();
    RUN(0, ph_wconv(p, blockIdx.x, gridDim.x, smem))
  }
  if (p_.out == nullptr) grid.sync();
  xcd_barrier(xb);
#pragma unroll 1
  for (int pc = 0; pc < 151; pc++) {
    PP p = (PP)__builtin_amdgcn_kernarg_segment_ptr();
    asm volatile("" : "+s"(p));
    int bid = blockIdx.x, nb = gridDim.x;
    asm volatile("" : "+s"(bid), "+s"(nb));
    const int l = pc / 75, q = pc - l * 75;
    bool did = true;
    if (pc == 150) {
      RUN(13, rmsnorm_rows(p->out, p->in[27], nullptr, p->out, TTOK, 2, 0, bid, nb))
      did = false;
    } else if (q >= 72) {
      if (q == 72) RUN(10, rmsnorm_rows(p->out, p->in[24] + l * 1024, (u16*)(p->ws + O_H2), nullptr, TTOK, 1, 0, bid, nb))
      else if (q == 73) RUN(11, ph_ffi(p, l, bid, nb, smem))
      else RUN(12, ph_ffo(p, l, bid, nb, smem))
    } else {
      const int sg = q / 9, st = q - sg * 9;
      switch (st) {
        case 0: if (sg == 0) RUN(1, ph_norm1(p, l, 0, bid, nb)) else did = false; break;
        case 1: RUN(2, ph_inproj(p, l, sg, bid, nb, smem)) break;
        case 2: RUN(3, ph_elem(p, l, sg, bid, nb)) if (sg + 1 < NSEG) RUN(1, ph_norm1(p, l, sg + 1, bid, nb)) break;
        case 3: RUN(4, ph_lora(p, l, bid, nb, smem)) break;
        case 4: RUN(5, ph_rprep(p, l, bid, nb)) break;
        case 5: ph_scan(p, l, sg, bid, nb, smem, ((volatile LAS unsigned*)&xb_words) + 2); break;
        case 6: RUN(7, ph_post(p, l, bid, nb)) if (sg > 0) RUN(9, ph_out(p, l, sg - 1, bid, nb, smem)) break;
        case 7: if (sg == NSEG - 1) RUN(8, ph_merge(p, l, sg, bid, nb, smem)) else did = false; break;
        default: if (sg == NSEG - 1) RUN(9, ph_out(p, l, sg, bid, nb, smem)) else did = false; break;
      }
    }
    if (did) xcd_barrier(xb);
  }
}

extern "C" void kernel_launch(void* const* d_in, const int* in_sizes, int n_in, void* d_out, int out_size, void* d_ws,
                              size_t ws_size, hipStream_t stream) {
  Params p{};
  for (int i = 0; i < 28; i++) p.in[i] = (const float*)d_in[i];
  p.out = (float*)d_out; p.ws = (char*)d_ws;
  static int grid_blocks = 0;
  if (!grid_blocks) {
    int dev = 0, cus = 0, per_cu = 0;
    hipGetDevice(&dev);
    hipDeviceGetAttribute(&cus, hipDeviceAttributeMultiprocessorCount, dev);
    hipOccupancyMaxActiveBlocksPerMultiprocessor(&per_cu, mega, NTHR, 0);
    if (per_cu > 2) per_cu = 2;
    if (per_cu < 1) per_cu = 1;
    grid_blocks = cus * per_cu;
  }
  hipMemsetAsync((char*)d_ws + O_BAR, 0, 16384, stream);
  void* args[] = {&p};
  hipError_t e = hipLaunchCooperativeKernel((void*)mega, dim3(grid_blocks), dim3(NTHR), args, 0, stream);
  if (e != hipSuccess) fprintf(stderr, "cooperative launch failed: %s (grid %d)\n", hipGetErrorString(e), grid_blocks);
}
```

```cpp
#include <hip/hip_runtime.h>
#include <hip/hip_cooperative_groups.h>
#include <stdint.h>
#include <stdio.h>
namespace cg = cooperative_groups;

typedef unsigned short u16;
using bf16x8 = __attribute__((ext_vector_type(8))) short;
using f32x4  = __attribute__((ext_vector_type(4))) float;
using u32x4 = __attribute__((ext_vector_type(4))) unsigned int;
using u32x2 = __attribute__((ext_vector_type(2))) unsigned int;

#define DM 1024
#define SEQ 4096
#define TTOK 32768
#define SL 512
#define NSEG 8
#define RS 4096
#define NTHR 256
#ifndef SCANPROBE
#define SCANPROBE 0
#endif

constexpr size_t al(size_t x) { return (x + 255) & ~(size_t)255; }
constexpr size_t WIN = 0;
constexpr size_t WWUP = WIN + (size_t)15872 * 1024;
constexpr size_t WAUP = WWUP + 65536;
constexpr size_t WGUP = WAUP + 65536;
constexpr size_t WBR = WGUP + 196608;
constexpr size_t WOUT = WBR + 4194304;
constexpr size_t WFFI = WOUT + 1048576;
constexpr size_t WFFO = WFFI + 5767168;
constexpr size_t W_LAYER = WFFO + 2883584;
constexpr size_t O_W = 0;
constexpr size_t O_H = al(O_W + W_LAYER * 2);
constexpr size_t O_URW = al(O_H + (size_t)RS * 1024 * 2);
constexpr size_t O_HQ = al(O_URW + (size_t)8 * 513 * 3456 * 2);
constexpr size_t O_HV = al(O_HQ + (size_t)RS * 1024 * 2);
constexpr size_t O_HG = al(O_HV + (size_t)RS * 1024 * 2);
constexpr size_t O_HW = al(O_HG + (size_t)RS * 1024 * 2);
constexpr size_t O_SZ = al(O_HW + (size_t)RS * 1024 * 4);
constexpr size_t O_SXBC = al(O_SZ + (size_t)RS * 2048 * 2);
constexpr size_t O_SDT = al(O_SXBC + (size_t)8 * 515 * 3072 * 2);
constexpr size_t O_SWD = al(O_SDT + (size_t)RS * 32 * 4);
constexpr size_t O_GATES = al(O_SWD + (size_t)RS * 32 * 4);
constexpr size_t O_LAW = al(O_GATES + (size_t)RS * 3072 * 2);
constexpr size_t O_LAA = al(O_LAW + (size_t)RS * 64 * 2);
constexpr size_t O_LAG = al(O_LAA + (size_t)RS * 64 * 2);
constexpr size_t O_SX2 = al(O_LAG + (size_t)RS * 192 * 2);
constexpr size_t O_RWW = al(O_SX2 + (size_t)RS * 3072 * 2);
constexpr size_t O_RWA = al(O_RWW + (size_t)RS * 1024 * 4);
constexpr size_t O_RWG = al(O_RWA + (size_t)RS * 1024 * 2);
constexpr size_t O_PR = al(O_RWG + (size_t)RS * 1024 * 2);
constexpr size_t O_PK = al(O_PR + (size_t)RS * 1024 * 2);
constexpr size_t O_PV = al(O_PK + (size_t)RS * 1024 * 2);
constexpr size_t O_PKA = al(O_PV + (size_t)RS * 1024 * 2);
constexpr size_t O_PKB = al(O_PKA + (size_t)RS * 1024 * 2);
constexpr size_t O_BONUS = al(O_PKB + (size_t)RS * 1024 * 2);
constexpr size_t O_SO = al(O_BONUS + (size_t)RS * 16 * 4);
constexpr size_t O_Y = al(O_SO + (size_t)RS * 4096 * 4);
constexpr size_t O_MERGED = al(O_Y + (size_t)RS * 4096 * 2);
constexpr size_t O_STRW = al(O_MERGED + (size_t)RS * 1024 * 2);
constexpr size_t O_STHG = al(O_STRW + (size_t)128 * 64 * 64 * 4);
constexpr size_t O_STSS = al(O_STHG + (size_t)64 * 128 * 128 * 4);
constexpr size_t O_END = al(O_STSS + (size_t)256 * 64 * 128 * 4);
constexpr size_t O_H2 = O_H;
constexpr size_t O_HID = al(O_H2 + (size_t)TTOK * 1024 * 2);
constexpr size_t O_END2 = al(O_HID + (size_t)TTOK * 2816 * 2);
constexpr size_t O_HK = O_END;
constexpr size_t O_GATES2 = al(O_HK + (size_t)RS * 1024 * 2);
constexpr size_t O_HG2 = al(O_GATES2 + (size_t)RS * 3072 * 2);
constexpr size_t O_SZ2 = al(O_HG2 + (size_t)RS * 1024 * 2);
constexpr size_t O_SX22 = al(O_SZ2 + (size_t)RS * 2048 * 2);
constexpr size_t O_BAR = al(O_SX22 + (size_t)RS * 3072 * 2);
static_assert(O_BAR + 16384 <= (size_t)536870912, "ws overflow");
static_assert(O_END2 <= (size_t)536870912, "ws overflow2");

#define LAS __attribute__((address_space(3)))
struct Params { const float* in[28]; float* out; char* ws; };
typedef const __attribute__((address_space(4))) Params* PP;

enum { PH_WCONV = 0, PH_NORM1, PH_INPROJ, PH_ELEM, PH_LORA, PH_RPREP, PH_SCAN, PH_POST, PH_MERGE, PH_OUT,
       PH_NORM2, PH_FFI, PH_FFO, PH_FINAL };

__device__ __forceinline__ float bf2f(u16 u) { return __uint_as_float(((unsigned)u) << 16); }
__device__ __forceinline__ u16 f2bf(float f) { unsigned u = __float_as_uint(f); u += 0x7fffu + ((u >> 16) & 1u); return (u16)(u >> 16); }
__device__ __forceinline__ float sigm(float x) { return 1.f / (1.f + __expf(-x)); }
__device__ __forceinline__ float wave_sum(float x) {
#pragma unroll
  for (int o = 32; o; o >>= 1) x += __shfl_xor(x, o);
  return x;
}
__device__ __forceinline__ f32x4 cvt4(u32x2 v) {
  f32x4 r; r.x = __uint_as_float(v.x << 16); r.y = __uint_as_float(v.x & 0xffff0000u);
  r.z = __uint_as_float(v.y << 16); r.w = __uint_as_float(v.y & 0xffff0000u); return r;
}
template <int CTRL> __device__ __forceinline__ float dppf(float x) {
  return __int_as_float(__builtin_amdgcn_update_dpp(0, __float_as_int(x), CTRL, 0xF, 0xF, true));
}
__device__ __forceinline__ float red16(float x) {
  x += dppf<0xB1>(x); x += dppf<0x4E>(x); x += dppf<0x141>(x); x += dppf<0x140>(x); return x;
}
__device__ __forceinline__ unsigned pk2(float a, float b) { return (unsigned)f2bf(a) | ((unsigned)f2bf(b) << 16); }
__device__ __forceinline__ u32x2 pack4(float a, float b, float c, float d) {
  u32x2 r; r.x = (unsigned)f2bf(a) | ((unsigned)f2bf(b) << 16); r.y = (unsigned)f2bf(c) | ((unsigned)f2bf(d) << 16); return r;
}
__device__ __forceinline__ f32x4 f4z() { return (f32x4){0.f, 0.f, 0.f, 0.f}; }
__device__ __forceinline__ f32x4 sigm4(f32x4 x) { f32x4 r; r[0] = sigm(x[0]); r[1] = sigm(x[1]); r[2] = sigm(x[2]); r[3] = sigm(x[3]); return r; }
__device__ __forceinline__ u32x2 pack4v(f32x4 x) { return pack4(x[0], x[1], x[2], x[3]); }
__device__ __forceinline__ float red4(float x) { x += dppf<0xB1>(x); x += dppf<0x4E>(x); return x; }
__device__ __forceinline__ float red8(float x) {
  x += dppf<0xB1>(x); x += dppf<0x4E>(x); x += dppf<0x141>(x); return x;
}

__device__ __forceinline__ int tidx() { int t = threadIdx.x; asm volatile("" : "+v"(t)); return t; }
__device__ __forceinline__ int remap_col(int kind, int n, int nsrc) {
  if (kind == 0) return n < nsrc ? n : -1;
  if (kind == 1) {
    if (n < 3456) return n < 3360 ? n : -1;
    if (n < 7552) return 3360 + (n - 3456);
    if (n < 12800) { int c = n - 7552; return c < 5152 ? 7456 + c : -1; }
    return 12608 + (n - 12800);
  }
  int blk = n >> 5, w = n & 31;
  return w < 16 ? blk * 16 + w : 2816 + blk * 16 + (w - 16);
}
__device__ __forceinline__ void tconv(const float* __restrict__ src, int K, int Nsrc, u16* __restrict__ dst, int Kpad, int Npad,
                      int kind, int bid, int nb, char* smem) {
  float(*tile)[65] = (float(*)[65])smem;
  const int tn = Npad >> 6, tk = Kpad >> 6, tid = tidx();
  for (int t = bid; t < tn * tk; t += nb) {
    const int n0 = (t % tn) << 6, k0 = (t / tn) << 6;
    const int nn4 = (tid & 15) * 4, c = remap_col(kind, n0 + nn4, Nsrc);
#pragma unroll
    for (int i = 0; i < 4; i++) {
      const int kk = (tid >> 4) + 16 * i, k = k0 + kk;
      f32x4 v = (f32x4){0.f, 0.f, 0.f, 0.f};
      if (k < K && c >= 0) v = *(const f32x4*)(src + (size_t)k * Nsrc + c);
      tile[kk][nn4] = v[0]; tile[kk][nn4 + 1] = v[1]; tile[kk][nn4 + 2] = v[2]; tile[kk][nn4 + 3] = v[3];
    }
    __syncthreads();
#pragma unroll
    for (int i = 0; i < 8; i++) {
      const int n2 = (tid >> 5) + 8 * i, kk = (tid & 31) * 2;
      *(unsigned*)(dst + (size_t)(n0 + n2) * Kpad + k0 + kk) = pk2(tile[kk][n2], tile[kk + 1][n2]);
    }
    __syncthreads();
  }
}
__device__ __forceinline__ void ph_wconv(PP p, int l, int bid, int nb, char* smem) {
  {
    u16* W = (u16*)(p->ws + O_W);
    tconv(p->in[2] + (size_t)l * 1024 * 15680, 1024, 15680, W + WIN, 1024, 15872, 1, bid, nb, smem);
    tconv(p->in[5] + (size_t)l * 64 * 1024, 64, 1024, W + WWUP, 64, 1024, 0, bid, nb, smem);
    tconv(p->in[7] + (size_t)l * 64 * 1024, 64, 1024, W + WAUP, 64, 1024, 0, bid, nb, smem);
    tconv(p->in[8] + (size_t)l * 160 * 1024, 160, 1024, W + WGUP, 192, 1024, 0, bid, nb, smem);
    tconv(p->in[22] + (size_t)l * 4096 * 1024, 4096, 1024, W + WBR, 4096, 1024, 0, bid, nb, smem);
    tconv(p->in[23] + (size_t)l * 1024 * 1024, 1024, 1024, W + WOUT, 1024, 1024, 0, bid, nb, smem);
    tconv(p->in[25] + (size_t)l * 1024 * 5632, 1024, 5632, W + WFFI, 1024, 5632, 2, bid, nb, smem);
    tconv(p->in[26] + (size_t)l * 2816 * 1024, 2816, 1024, W + WFFO, 2816, 1024, 0, bid, nb, smem);
  }
}

__device__ __forceinline__ void rmsnorm_rows(const float* __restrict__ xs, const float* __restrict__ gain, u16* dst, float* dstf,
                             int nrows, int mode, int seg, int bid, int nb) {
  const int lane = tidx() & 63, wv = tidx() >> 6;
  for (int r = bid * 4 + wv; r < nrows; r += nb * 4) {
    size_t srow = (mode == 0) ? ((size_t)(r >> 9) * SEQ + seg * SL + (r & 511)) : (size_t)r;
    const float4* xp = (const float4*)(xs + srow * DM);
    float4 v[4]; float ss = 0.f;
#pragma unroll
    for (int i = 0; i < 4; i++) { v[i] = xp[lane + 64 * i]; ss += v[i].x * v[i].x + v[i].y * v[i].y + v[i].z * v[i].z + v[i].w * v[i].w; }
    ss = wave_sum(ss);
    float rstd = rsqrtf(ss * (1.f / DM) + 1e-5f);
#pragma unroll
    for (int i = 0; i < 4; i++) {
      float4 g = ((const float4*)gain)[lane + 64 * i];
      float a = v[i].x * rstd * g.x, b = v[i].y * rstd * g.y, c = v[i].z * rstd * g.z, d = v[i].w * rstd * g.w;
      if (mode == 2) { float4 o; o.x = a; o.y = b; o.z = c; o.w = d; ((float4*)(dstf + (size_t)r * DM))[lane + 64 * i] = o; }
      else { uint2 o; o.x = (unsigned)f2bf(a) | ((unsigned)f2bf(b) << 16); o.y = (unsigned)f2bf(c) | ((unsigned)f2bf(d) << 16);
             ((uint2*)(dst + (size_t)r * DM))[lane + 64 * i] = o; }
    }
  }
}

#define WAIT_V(n) asm volatile("s_waitcnt vmcnt(%0)" ::"n"(n) : "memory")
#define WAIT_L(n) asm volatile("s_waitcnt lgkmcnt(%0)" ::"n"(n) : "memory")
#define RAW_BARRIER() do { WAIT_L(0); __builtin_amdgcn_s_barrier(); } while (0)
template <int MI>
__device__ __forceinline__ void gemm_kloop(const u16* __restrict__ A, int lda, const u16* __restrict__ B, int ldb, int nkt,
                                           f32x4 (&acc)[MI][4], char* smem) {
  constexpr int NA = MI / 2, ABYTES = MI * 32 * 64, STB = ABYTES + 8192, NST = (MI == 4) ? 4 : 3, LPT = NA + 2;
  const int tid = tidx(), lane = tid & 63, wave = tid >> 6, wm = wave >> 1, wn = wave & 1;
  const int wu = __builtin_amdgcn_readfirstlane(wave);
  const u16* ga[NA]; const u16* gb[2];
#pragma unroll
  for (int i = 0; i < NA; i++) {
    const int r = (wu * NA + i) * 16 + (lane >> 2), kc = (lane & 3) ^ ((r >> 2) & 3);
    ga[i] = A + (size_t)r * lda + kc * 8;
  }
#pragma unroll
  for (int i = 0; i < 2; i++) {
    const int r = (wu * 2 + i) * 16 + (lane >> 2), kc = (lane & 3) ^ ((r >> 2) & 3);
    gb[i] = B + (size_t)r * ldb + kc * 8;
  }
  LAS char* sm = (LAS char*)smem;
#define GSTAGE(st_, kt_) { \
    _Pragma("unroll") for (int i = 0; i < NA; i++) \
      __builtin_amdgcn_global_load_lds((const unsigned*)(ga[i] + (kt_) * 32), (LAS unsigned*)(sm + (st_) * STB + (wu * NA + i) * 1024), 16, 0, 0); \
    _Pragma("unroll") for (int i = 0; i < 2; i++) \
      __builtin_amdgcn_global_load_lds((const unsigned*)(gb[i] + (kt_) * 32), (LAS unsigned*)(sm + (st_) * STB + ABYTES + (wu * 2 + i) * 1024), 16, 0, 0); }
#define WAIT_TILES(n_) { if ((n_) >= 3) WAIT_V(3 * LPT); else if ((n_) == 2) WAIT_V(2 * LPT); else if ((n_) == 1) WAIT_V(LPT); else WAIT_V(0); }
#define LDS_RD128(dst_, addr_) asm volatile("ds_read_b128 %0, %1" : "=v"(dst_) : "v"(addr_) : "memory")
#define RD_A(fa_, st_) { const unsigned ab_ = sbase + (st_) * STB + offA; \
    _Pragma("unroll") for (int i = 0; i < MI; i++) LDS_RD128(fa_[i], ab_ + i * 1024); }
#define RD_B(fb_, st_) { const unsigned bb_ = sbase + (st_) * STB + offB; \
    _Pragma("unroll") for (int i = 0; i < 4; i++) LDS_RD128(fb_[i], bb_ + i * 1024); }
#define DO_MFMA(fa_, fb_) { __builtin_amdgcn_s_setprio(1); \
    _Pragma("unroll") for (int i = 0; i < MI; i++) _Pragma("unroll") for (int j = 0; j < 4; j++) \
      acc[i][j] = __builtin_amdgcn_mfma_f32_16x16x32_bf16(__builtin_bit_cast(bf16x8, fb_[j]), __builtin_bit_cast(bf16x8, fa_[i]), acc[i][j], 0, 0, 0); \
    __builtin_amdgcn_s_setprio(0); }
#define KSTEP(fca_, fna_, kt_) { \
    RD_B(fb, st) \
    if ((kt_) + 1 < nkt) { \
      { const int rem_ = nkt - 2 - (kt_); WAIT_TILES(rem_ < NST - 2 ? rem_ : NST - 2) } \
      RAW_BARRIER(); \
      __builtin_amdgcn_sched_barrier(0); \
      if ((kt_) + NST < nkt) GSTAGE(st, (kt_) + NST) \
      st = (st + 1 == NST) ? 0 : st + 1; \
      RD_A(fna_, st) \
    } else { \
      WAIT_L(0); __builtin_amdgcn_sched_barrier(0); \
    } \
    DO_MFMA(fca_, fb) }
  __syncthreads();
#pragma unroll
  for (int s0 = 0; s0 < NST; s0++) if (s0 < nkt) GSTAGE(s0, s0)
  const int frow = lane & 15, fg = lane >> 4;
  const int fo = (frow * 4 + (fg ^ ((frow >> 2) & 3))) * 16;
  const int offA = (wm * MI * 16) * 64 + fo, offB = ABYTES + (wn * 64) * 64 + fo;
  int st = 0;
  const unsigned sbase = (unsigned)(unsigned long)sm;
  u32x4 fa0[MI], fa1[MI], fb[4];
  { const int rem_ = nkt - 1; WAIT_TILES(rem_ < NST - 1 ? rem_ : NST - 1) }
  RAW_BARRIER();
  __builtin_amdgcn_sched_barrier(0);
  RD_A(fa0, 0)
#pragma unroll 1
  for (int kt = 0; kt < nkt; kt += 2) {
    KSTEP(fa0, fa1, kt)
    KSTEP(fa1, fa0, kt + 1)
  }
  RAW_BARRIER();
}
#define ACC_ZERO(acc) { _Pragma("unroll") for (int i = 0; i < (int)(sizeof(acc) / sizeof(acc[0])); i++) _Pragma("unroll") for (int j = 0; j < 4; j++) acc[i][j] = (f32x4){0.f, 0.f, 0.f, 0.f}; }
#define EPI_LOOP(BODY) { constexpr int MI_ = (int)(sizeof(acc) / sizeof(acc[0])); const int lane_ = tidx() & 63, wave_ = tidx() >> 6, wm_ = wave_ >> 1, wn_ = wave_ & 1; \
  _Pragma("unroll") for (int i = 0; i < MI_; i++) { _Pragma("unroll") for (int j = 0; j < 4; j++) { \
    const int row = m0 + wm_ * (MI_ * 16) + i * 16 + (lane_ & 15); const int col = n0 + wn_ * 64 + j * 16 + (lane_ >> 4) * 4; const f32x4 v = acc[i][j]; BODY } \
    asm volatile("" ::: "memory"); } }
#define EPI_LOOP2(LOAD, STORE) { constexpr int MI_ = (int)(sizeof(acc) / sizeof(acc[0])); const int lane_ = tidx() & 63, wave_ = tidx() >> 6, wm_ = wave_ >> 1, wn_ = wave_ & 1; \
  _Pragma("unroll") for (int i = 0; i < MI_; i++) { f32x4 l0[4], l1[4]; \
    _Pragma("unroll") for (int j = 0; j < 4; j++) { \
      const int row = m0 + wm_ * (MI_ * 16) + i * 16 + (lane_ & 15); const int col = n0 + wn_ * 64 + j * 16 + (lane_ >> 4) * 4; LOAD } \
    asm volatile("" ::: "memory"); \
    _Pragma("unroll") for (int j = 0; j < 4; j++) { \
      const int row = m0 + wm_ * (MI_ * 16) + i * 16 + (lane_ & 15); const int col = n0 + wn_ * 64 + j * 16 + (lane_ >> 4) * 4; const f32x4 v = acc[i][j]; STORE } \
    asm volatile("" ::: "memory"); } }
#define COLJ(j) (n0 + ((tidx() >> 6) & 1) * 64 + (j) * 16 + ((tidx() & 63) >> 4) * 4)
__device__ __forceinline__ void ph_inproj(PP p, int layer, int seg, int bid, int nb, char* smem) {
  const u16* W = (const u16*)(p->ws + O_W) + WIN;
  const u16* H = (const u16*)(p->ws + O_H);
  u16* urw = (u16*)(p->ws + O_URW); u16* hq = (u16*)(p->ws + O_HQ); u16* hv = (u16*)(p->ws + O_HV); u16* hg = (u16*)(p->ws + ((seg & 1) ? O_HG2 : O_HG));
  float* hw = (float*)(p->ws + O_HW); u16* hk = (u16*)(p->ws + O_HK); u16* sz = (u16*)(p->ws + ((seg & 1) ? O_SZ2 : O_SZ)); u16* sxbc = (u16*)(p->ws + O_SXBC);
  float* sdt = (float*)(p->ws + O_SDT); u16* gates = (u16*)(p->ws + ((seg & 1) ? O_GATES2 : O_GATES));
  const float* lbl = p->in[14];
  const float* dtb = p->in[18] + layer * 32;
  for (int t = bid; t < 16 * 124; t += nb) {
    const int m0 = (t & 15) * 256, n0 = (t >> 4) * 128;
    f32x4 acc[8][4]; ACC_ZERO(acc);
    gemm_kloop(H + (size_t)m0 * 1024, 1024, W + (size_t)n0 * 1024, 1024, 32, acc, smem);
    if (n0 < 3456) {
      EPI_LOOP({ if (col < 3360) *(u32x2*)(urw + ((size_t)((row >> 9) * 513 + 1 + (row & 511))) * 3456 + col) = pack4v(v); })
    } else if (n0 < 7552) {
      const int which = (n0 - 3456) >> 10;
      if (which == 0) { EPI_LOOP({ int cc = (col - 3456) & 1023; *(u32x2*)(hq + (size_t)row * 1024 + cc) = pack4v(v * sigm4(v)); }) }
      else if (which == 1) {
        f32x4 lbj[4];
#pragma unroll
        for (int j = 0; j < 4; j++) {
          int cc = (COLJ(j) - 3456) & 1023;
          f32x4 l0 = *(const f32x4*)(lbl + cc), l1 = *(const f32x4*)(lbl + 1024 + cc);
#pragma unroll
          for (int e = 0; e < 4; e++) lbj[j][e] = layer == 0 ? 0.f : 1.f / (1.f + __expf(l0[e] - l1[e]));
        }
        EPI_LOOP({ int cc = (col - 3456) & 1023; const f32x4 lb = lbj[j];
                   f32x4 sg = sigm4(v); f32x4 w = lb + (1.f - lb) * sg; f32x4 lf;
                   lf[0] = fmaxf(__logf(w[0]), -60.f); lf[1] = fmaxf(__logf(w[1]), -60.f); lf[2] = fmaxf(__logf(w[2]), -60.f); lf[3] = fmaxf(__logf(w[3]), -60.f);
                   *(f32x4*)(hw + (size_t)row * 1024 + cc) = lf;
                   *(u32x2*)(hk + (size_t)row * 1024 + cc) = pack4v((1.f - lb) * (1.f - sg)); })
      } else if (which == 2) { EPI_LOOP({ int cc = (col - 3456) & 1023; *(u32x2*)(hv + (size_t)row * 1024 + cc) = pack4v(v); }) }
      else { EPI_LOOP({ int cc = (col - 3456) & 1023; *(u32x2*)(hg + (size_t)row * 1024 + cc) = pack4v(sigm4(v)); }) }
    } else if (n0 < 12800) {
      const int c0 = n0 - 7552;
      if (c0 < 2048) { EPI_LOOP({ int c = col - 7552; *(u32x2*)(sz + (size_t)row * 2048 + c) = pack4v(v * sigm4(v)); }) }
      else if (c0 < 5120) { EPI_LOOP({ int c = col - 7552 - 2048; *(u32x2*)(sxbc + ((size_t)((row >> 9) * 515 + 3 + (row & 511))) * 3072 + c) = pack4v(v); }) }
      else {
        f32x4 dbj[4];
#pragma unroll
        for (int j = 0; j < 4; j++) { int c = COLJ(j) - 7552 - 5120; dbj[j] = c < 32 ? *(const f32x4*)(dtb + c) : (f32x4){0.f, 0.f, 0.f, 0.f}; }
        EPI_LOOP({ int c = col - 7552 - 5120; if (c < 32) { f32x4 xx = v + dbj[j]; f32x4 o;
                   o[0] = xx[0] > 20.f ? xx[0] : log1pf(__expf(xx[0])); o[1] = xx[1] > 20.f ? xx[1] : log1pf(__expf(xx[1]));
                   o[2] = xx[2] > 20.f ? xx[2] : log1pf(__expf(xx[2])); o[3] = xx[3] > 20.f ? xx[3] : log1pf(__expf(xx[3]));
                   *(f32x4*)(sdt + (size_t)row * 32 + c) = o; } })
      }
    } else {
      EPI_LOOP({ int c = col - 12800; *(u32x2*)(gates + (size_t)row * 3072 + c) = pack4v(sigm4(v)); })
    }
  }
}

__device__ __forceinline__ void ph_elem(PP p, int layer, int seg, int bid, int nb) {
  const u16* urw = (const u16*)(p->ws + O_URW);
  const float* mu = p->in[3] + layer * 3360;
  u16* law = (u16*)(p->ws + O_LAW); u16* laa = (u16*)(p->ws + O_LAA); u16* lag = (u16*)(p->ws + O_LAG);
  const int gt = bid * NTHR + tidx(), gs = nb * NTHR;
#pragma unroll 1
  for (int idx = gt; idx < RS * 80; idx += gs) {
    const int r = idx / 80, gq = idx - r * 80;
    if (gq >= 72) { u32x2 z; z.x = 0; z.y = 0; *(u32x2*)(lag + (size_t)r * 192 + 160 + (gq - 72) * 4) = z; continue; }
    const int col = 3072 + gq * 4;
    const size_t ro = (size_t)((r >> 9) * 513 + 1 + (r & 511)) * 3456;
    f32x4 cur = cvt4(*(const u32x2*)(urw + ro + col)), prv = cvt4(*(const u32x2*)(urw + ro - 3456 + col));
    f32x4 m4 = *(const f32x4*)(mu + col);
    f32x4 val = cur + (prv - cur) * m4;
    if (gq < 16) *(u32x2*)(law + (size_t)r * 64 + gq * 4) = pack4(tanhf(val[0]), tanhf(val[1]), tanhf(val[2]), tanhf(val[3]));
    else if (gq < 32) *(u32x2*)(laa + (size_t)r * 64 + (gq - 16) * 4) = pack4(val[0], val[1], val[2], val[3]);
    else *(u32x2*)(lag + (size_t)r * 192 + (gq - 32) * 4) = pack4(sigm(val[0]), sigm(val[1]), sigm(val[2]), sigm(val[3]));
  }
  const u16* sxbc = (const u16*)(p->ws + O_SXBC); u16* sx2 = (u16*)(p->ws + ((seg & 1) ? O_SX22 : O_SX2));
  const float* cw = p->in[16] + (size_t)layer * 3072 * 4; const float* cb = p->in[17] + layer * 3072;
#pragma unroll 1
  for (int idx = gt; idx < (RS / 4) * 384; idx += gs) {
    const int rb = idx / 384, cg = idx - rb * 384, r = rb * 4, ch = cg * 8;
    const size_t ro = (size_t)((r >> 9) * 515 + (r & 511)) * 3072 + ch;
    u32x4 xin[7];
#pragma unroll
    for (int j = 0; j < 7; j++) xin[j] = *(const u32x4*)(sxbc + ro + (size_t)j * 3072);
    f32x4 w4[8];
#pragma unroll
    for (int c = 0; c < 8; c++) w4[c] = *(const f32x4*)(cw + (size_t)(ch + c) * 4);
    f32x4 b0 = *(const f32x4*)(cb + ch), b1 = *(const f32x4*)(cb + ch + 4);
#pragma unroll
    for (int rr = 0; rr < 4; rr++) {
      float o[8];
#pragma unroll
      for (int c = 0; c < 8; c++) {
        float acc = c < 4 ? b0[c] : b1[c - 4];
#pragma unroll
        for (int j = 0; j < 4; j++) {
          const unsigned wd = xin[rr + j][c >> 1];
          const float xv = (c & 1) ? __uint_as_float(wd & 0xffff0000u) : __uint_as_float(wd << 16);
          acc = fmaf(xv, w4[c][j], acc);
        }
        o[c] = acc * sigm(acc);
      }
      u32x4 ov; ov.x = pk2(o[0], o[1]); ov.y = pk2(o[2], o[3]); ov.z = pk2(o[4], o[5]); ov.w = pk2(o[6], o[7]);
      *(u32x4*)(sx2 + (size_t)(r + rr) * 3072 + ch) = ov;
    }
  }
}

__device__ __forceinline__ void ph_lora(PP p, int layer, int bid, int nb, char* smem) {
  const u16* W = (const u16*)(p->ws + O_W);
  float* rww = (float*)(p->ws + O_RWW); u16* rwa = (u16*)(p->ws + O_RWA); u16* rwg = (u16*)(p->ws + O_RWG);
  const float* w0 = p->in[4] + layer * 1024; const float* a0 = p->in[6] + layer * 1024;
  for (int t = bid; t < 3 * 256; t += nb) {
    const int job = t >> 8, tt = t & 255, m0 = (tt & 31) * 128, n0 = (tt >> 5) * 128;
    f32x4 acc[4][4]; ACC_ZERO(acc);
    if (job == 0) {
      gemm_kloop((const u16*)(p->ws + O_LAW) + (size_t)m0 * 64, 64, W + WWUP + (size_t)n0 * 64, 64, 2, acc, smem);
      f32x4 pj[4];
#pragma unroll
      for (int j = 0; j < 4; j++) pj[j] = *(const f32x4*)(w0 + COLJ(j));
      EPI_LOOP({ f32x4 sg = sigm4(pj[j] + v); f32x4 o; o[0] = __expf(-0.60653066f * sg[0]); o[1] = __expf(-0.60653066f * sg[1]); o[2] = __expf(-0.60653066f * sg[2]); o[3] = __expf(-0.60653066f * sg[3]);
                 *(f32x4*)(rww + (size_t)row * 1024 + col) = o; })
    } else if (job == 1) {
      gemm_kloop((const u16*)(p->ws + O_LAA) + (size_t)m0 * 64, 64, W + WAUP + (size_t)n0 * 64, 64, 2, acc, smem);
      f32x4 pj[4];
#pragma unroll
      for (int j = 0; j < 4; j++) pj[j] = *(const f32x4*)(a0 + COLJ(j));
      EPI_LOOP({ *(u32x2*)(rwa + (size_t)row * 1024 + col) = pack4v(sigm4(pj[j] + v)); })
    } else {
      gemm_kloop((const u16*)(p->ws + O_LAG) + (size_t)m0 * 192, 192, W + WGUP + (size_t)n0 * 192, 192, 6, acc, smem);
      EPI_LOOP({ *(u32x2*)(rwg + (size_t)row * 1024 + col) = pack4v(v); })
    }
  }
}

__device__ __forceinline__ void ph_rprep(PP p, int layer, int bid, int nb) {
  const u16* urw = (const u16*)(p->ws + O_URW); const u16* rwa = (const u16*)(p->ws + O_RWA);
  u16* pr = (u16*)(p->ws + O_PR); u16* pk = (u16*)(p->ws + O_PK); u16* pv = (u16*)(p->ws + O_PV);
  u16* pka = (u16*)(p->ws + O_PKA); u16* pkb = (u16*)(p->ws + O_PKB); float* bonus = (float*)(p->ws + O_BONUS);
  const float* mu = p->in[3] + layer * 3360; const float* kk_ = p->in[9] + layer * 1024; const float* ka_ = p->in[10] + layer * 1024;
  const float* rk_ = p->in[11] + layer * 1024;
  {
    u16* sxbc = (u16*)(p->ws + O_SXBC);
    const int gt = bid * NTHR + tidx(), gs = nb * NTHR;
    for (int idx = gt; idx < 8 * 3 * 3072; idx += gs) { int b = idx / 9216, c = idx - b * 9216; sxbc[(size_t)(b * 515) * 3072 + c] = sxbc[(size_t)(b * 515 + 512) * 3072 + c]; }
  }
  const int lane = tidx() & 63, wv = tidx() >> 6;
#pragma unroll 1
  for (int task = bid * 4 + wv; task < RS * 4; task += nb * 4) {
    const int r = task >> 2, col = (task & 3) * 256 + lane * 4;
    const size_t ro = (size_t)((r >> 9) * 513 + 1 + (r & 511)) * 3456 + col;
    f32x4 rc = cvt4(*(const u32x2*)(urw + ro)), rp = cvt4(*(const u32x2*)(urw + ro - 3456));
    f32x4 kc = cvt4(*(const u32x2*)(urw + ro + 1024)), kp = cvt4(*(const u32x2*)(urw + ro - 3456 + 1024));
    f32x4 vc = cvt4(*(const u32x2*)(urw + ro + 2048)), vp = cvt4(*(const u32x2*)(urw + ro - 3456 + 2048));
    f32x4 a = cvt4(*(const u32x2*)(rwa + (size_t)r * 1024 + col));
    f32x4 rr = rc + (rp - rc) * *(const f32x4*)(mu + col);
    f32x4 k = kc + (kp - kc) * *(const f32x4*)(mu + 1024 + col);
    f32x4 vv = vc + (vp - vc) * *(const f32x4*)(mu + 2048 + col);
    f32x4 kkv = k * *(const f32x4*)(kk_ + col);
    float n2 = red16(kkv[0] * kkv[0] + kkv[1] * kkv[1] + kkv[2] * kkv[2] + kkv[3] * kkv[3]);
    const float inv = 1.f / fmaxf(sqrtf(n2), 1e-12f);
    f32x4 kkn = kkv * inv;
    f32x4 kmod = k * (1.f + (a - 1.f) * *(const f32x4*)(ka_ + col));
    f32x4 bt = rr * kmod * *(const f32x4*)(rk_ + col);
    float bn = red16(bt[0] + bt[1] + bt[2] + bt[3]);
    const size_t o = (size_t)r * 1024 + col;
    *(u32x2*)(pr + o) = pack4(rr[0], rr[1], rr[2], rr[3]);
    *(u32x2*)(pk + o) = pack4(kmod[0], kmod[1], kmod[2], kmod[3]);
    *(u32x2*)(pv + o) = pack4(vv[0], vv[1], vv[2], vv[3]);
    *(u32x2*)(pka + o) = pack4(-kkn[0], -kkn[1], -kkn[2], -kkn[3]);
    *(u32x2*)(pkb + o) = pack4(kkn[0] * a[0], kkn[1] * a[1], kkn[2] * a[2], kkn[3] * a[3]);
    if ((lane & 15) == 0) bonus[r * 16 + (col >> 6)] = bn;
  }
}

struct ScanArgs {
  const u16 *pr, *pk, *pka, *pkb, *pv;
  const float *pw, *pvs;
  float *po, *state;
  int sr, sk, sab, sv, sw, svs, so;
};
#define TB 16
template <int KD, bool DELTA, bool WSCALAR, bool KFROMW, int LPR>
__device__ __forceinline__ void scan_task(const ScanArgs& a, bool first, bool save, char* smem) {
  constexpr int RB = 256 / LPR, GV = RB / 4; constexpr int KE = KD / LPR, NQ = KE / 4, NG = KD / 64, G4 = KD / 4;
  constexpr int OFF_R = 0, OFF_K = KD;
  constexpr int OFF_W = KFROMW ? KD : 2 * KD;
  constexpr int OFF_KA = OFF_W + (WSCALAR ? 0 : KD);
  constexpr int OFF_KB = OFF_KA + (DELTA ? KD : 0);
  constexpr int OFF_V = OFF_KB + (DELTA ? KD : 0);
  constexpr int OFF_S = OFF_V + RB;
  constexpr int STR = OFF_S + 4;
  float* buf0 = (float*)smem; float* buf1 = buf0 + TB * STR; float* obuf = buf1 + TB * STR;
  const int tid = tidx(), ks = tid & (LPR - 1), vr = tid / LPR;
  u32x2 gr[NG], gk[NG], gka[NG], gkb[NG], gv; f32x4 gw[NG]; float gsw = 0.f, gsv = 0.f;
  gv.x = gv.y = 0;
#define LOAD_BLK(blk_) { \
    const int row = (blk_) * TB; \
    _Pragma("unroll") for (int i = 0; i < NG; i++) { \
      const int g = tid + 256 * i, step = g / G4, e4 = g % G4; \
      gr[i] = *(const u32x2*)(a.pr + (size_t)(row + step) * a.sr + e4 * 4); \
      if (!KFROMW) gk[i] = *(const u32x2*)(a.pk + (size_t)(row + step) * a.sk + e4 * 4); \
      if (!WSCALAR) gw[i] = *(const f32x4*)(a.pw + (size_t)(row + step) * a.sw + e4 * 4); \
      if (DELTA) { gka[i] = *(const u32x2*)(a.pka + (size_t)(row + step) * a.sab + e4 * 4); gkb[i] = *(const u32x2*)(a.pkb + (size_t)(row + step) * a.sab + e4 * 4); } \
    } \
    if (tid < TB * GV) { const int step = tid / GV, e4 = tid % GV; gv = *(const u32x2*)(a.pv + (size_t)(row + step) * a.sv + e4 * 4); } \
    if (WSCALAR && tid < TB) { gsw = a.pw[(size_t)(row + tid) * a.sw]; gsv = a.pvs[(size_t)(row + tid) * a.svs]; } }
#define STORE_BLK(buf_) { \
    float* bufp = (buf_); \
    _Pragma("unroll") for (int i = 0; i < NG; i++) { \
      const int g = tid + 256 * i, step = g / G4, e4 = g % G4; \
      float* d = bufp + step * STR + e4 * 4; \
      *(f32x4*)(d + OFF_R) = cvt4(gr[i]); \
      if (!KFROMW) *(f32x4*)(d + OFF_K) = cvt4(gk[i]); \
      if (!WSCALAR) *(f32x4*)(d + OFF_W) = gw[i]; \
      if (DELTA) { *(f32x4*)(d + OFF_KA) = cvt4(gka[i]); *(f32x4*)(d + OFF_KB) = cvt4(gkb[i]); } \
    } \
    if (tid < TB * GV) { const int step = tid / GV, e4 = tid % GV; *(f32x4*)(bufp + step * STR + OFF_V + e4 * 4) = cvt4(gv); } \
    if (WSCALAR && tid < TB) { bufp[tid * STR + OFF_S] = gsw; bufp[tid * STR + OFF_S + 1] = gsv; } }
  float S[KE];
  if (first) {
#pragma unroll
    for (int e = 0; e < KE; e++) S[e] = 0.f;
  } else {
#pragma unroll
    for (int q = 0; q < NQ; q++) { float4 t = *(const float4*)(a.state + (size_t)vr * KD + q * (LPR * 4) + ks * 4); S[q * 4] = t.x; S[q * 4 + 1] = t.y; S[q * 4 + 2] = t.z; S[q * 4 + 3] = t.w; }
  }
  LOAD_BLK(0)
  __syncthreads();
  STORE_BLK(buf0)
  __syncthreads();
  constexpr int NBLK = SL / TB;
  for (int blk = 0; blk < NBLK; blk++) {
    float* buf = (blk & 1) ? buf1 : buf0;
    if (blk + 1 < NBLK) LOAD_BLK(blk + 1)
    {
      float rv1[KE], kb1[KE], kv[2][KE], wv[2][KE], kav[2][KE], vtv[2], wsv[2], vsv[2];
#define LD_STEP(slot, st_) { const float* sp = buf + (st_) * STR; \
        _Pragma("unroll") for (int q = 0; q < NQ; q++) { \
          if (!WSCALAR) { f32x4 u = *(const f32x4*)(sp + OFF_W + q * (LPR * 4) + ks * 4); wv[slot][q * 4] = u[0]; wv[slot][q * 4 + 1] = u[1]; wv[slot][q * 4 + 2] = u[2]; wv[slot][q * 4 + 3] = u[3]; } \
          if (!KFROMW) { f32x4 u = *(const f32x4*)(sp + OFF_K + q * (LPR * 4) + ks * 4); kv[slot][q * 4] = u[0]; kv[slot][q * 4 + 1] = u[1]; kv[slot][q * 4 + 2] = u[2]; kv[slot][q * 4 + 3] = u[3]; } \
          if (DELTA) { f32x4 u = *(const f32x4*)(sp + OFF_KA + q * (LPR * 4) + ks * 4); kav[slot][q * 4] = u[0]; kav[slot][q * 4 + 1] = u[1]; kav[slot][q * 4 + 2] = u[2]; kav[slot][q * 4 + 3] = u[3]; \
                     } \
        } \
        vtv[slot] = sp[OFF_V + vr]; \
        if (WSCALAR) { wsv[slot] = sp[OFF_S]; vsv[slot] = sp[OFF_S + 1]; } }
      LD_STEP(0, 0)
#define DO_STEP(cs, step_) { \
        { const float* spr = buf + (step_) * STR; _Pragma("unroll") for (int q = 0; q < NQ; q++) { f32x4 t = *(const f32x4*)(spr + OFF_R + q * (LPR * 4) + ks * 4); rv1[q * 4] = t[0]; rv1[q * 4 + 1] = t[1]; rv1[q * 4 + 2] = t[2]; rv1[q * 4 + 3] = t[3]; \
            if (DELTA) { f32x4 x = *(const f32x4*)(spr + OFF_KB + q * (LPR * 4) + ks * 4); kb1[q * 4] = x[0]; kb1[q * 4 + 1] = x[1]; kb1[q * 4 + 2] = x[2]; kb1[q * 4 + 3] = x[3]; } } } \
        float vt = vtv[cs]; \
        if (WSCALAR) vt *= vsv[cs]; \
        if (DELTA) { \
          float sa0 = 0.f, sa1 = 0.f, sa2 = 0.f, sa3 = 0.f; \
          _Pragma("unroll") for (int e = 0; e < KE; e += 2) { sa0 = fmaf(S[e], kav[cs][e], sa0); sa1 = fmaf(S[e + 1], kav[cs][e + 1], sa1); } \
          _Pragma("unroll") for (int e = 0; e < KE; e++) S[e] = fmaf(S[e], wv[cs][e], vt * kv[cs][e]); \
          float sa = (LPR == 8) ? red8((sa0 + sa1) + (sa2 + sa3)) : red4((sa0 + sa1) + (sa2 + sa3)); \
          _Pragma("unroll") for (int e = 0; e < KE; e++) S[e] = fmaf(sa, kb1[e], S[e]); \
        } else { \
          _Pragma("unroll") for (int e = 0; e < KE; e++) { \
            float w = WSCALAR ? wsv[cs] : wv[cs][e]; \
            float k = KFROMW ? (1.f - wv[cs][e]) : kv[cs][e]; \
            S[e] = fmaf(S[e], w, vt * k); } \
        } \
        float o0 = 0.f, o1 = 0.f, o2 = 0.f, o3 = 0.f; \
        _Pragma("unroll") for (int e = 0; e < KE; e += 2) { o0 = fmaf(S[e], rv1[e], o0); o1 = fmaf(S[e + 1], rv1[e + 1], o1); } \
        float o = (LPR == 8) ? red8((o0 + o1) + (o2 + o3)) : red4((o0 + o1) + (o2 + o3)); \
        if (ks == 0) obuf[(step_) * RB + vr] = o; }
#pragma unroll 1
      for (int step = 0; step < TB; step += 2) {
        LD_STEP(1, step + 1)
        DO_STEP(0, step)
        if (step + 2 < TB) LD_STEP(0, step + 2)
        DO_STEP(1, step + 1)
      }
    }
    __syncthreads();
    {
      const int row = blk * TB;
#pragma unroll
      for (int i = 0; i < TB * RB / 256; i++) { const int idx = tid + 256 * i, step = idx / RB, v2 = idx % RB; a.po[(size_t)(row + step) * a.so + v2] = obuf[idx]; }
    }
    if (blk + 1 < NBLK) STORE_BLK((blk & 1) ? buf0 : buf1)
    __syncthreads();
  }
  if (save)
#pragma unroll
  for (int q = 0; q < NQ; q++) { float4 t; t.x = S[q * 4]; t.y = S[q * 4 + 1]; t.z = S[q * 4 + 2]; t.w = S[q * 4 + 3]; *(float4*)(a.state + (size_t)vr * KD + q * (LPR * 4) + ks * 4) = t; }
}


struct ChunkArgs { const u16 *q, *k, *v; const float* lf; float* o; float* state; int ld, ldlf; float expA; };
#define QLD 136
#define KHLD 72
template <bool SSM>
__device__ __forceinline__ void chunk_task(const ChunkArgs& a, bool first, bool save, char* smem) {
  u16* QT = (u16*)smem;
  u16* KT = QT + 64 * QLD;
  u16* KH = KT + 64 * QLD;
  u16* VT = KH + 128 * KHLD;
  u16* ST = VT + 32 * KHLD;
  float* gam = (float*)(ST + 32 * QLD); float* em = gam + 128; float* cum = gam + 256; float* dts = gam + 512;
  const int tid = tidx(), lane = tid & 63, g = lane >> 4, c = lane & 15;
  const int w = __builtin_amdgcn_readfirstlane(tid >> 6);
  f32x4 accS[2][2];
#pragma unroll
  for (int i = 0; i < 2; i++)
#pragma unroll
    for (int j = 0; j < 2; j++)
      accS[i][j] = first ? (f32x4){0.f, 0.f, 0.f, 0.f} : *(const f32x4*)(a.state + (size_t)((i * 2 + j) * 256 + tid) * 4);
  float rcn[32]; u16 qan[32], kan[32]; u32x4 cqn[4], ckn[4], vvn; float dtn = 0.f;
#define CH_PREFETCH(chn_) { const int rp = (chn_) * 64; \
    if (!SSM) { const int d = tid & 127, half = tid >> 7; \
      const float* lfp = a.lf + (size_t)(rp + half * 32) * a.ldlf + d; \
      const u16* qp = a.q + (size_t)(rp + half * 32) * a.ld + d; const u16* kp = a.k + (size_t)(rp + half * 32) * a.ld + d; \
      _Pragma("unroll") for (int i = 0; i < 32; i++) rcn[i] = lfp[(size_t)i * a.ldlf]; \
      _Pragma("unroll") for (int i = 0; i < 32; i++) { qan[i] = qp[(size_t)i * a.ld]; kan[i] = kp[(size_t)i * a.ld]; } \
    } else { \
      _Pragma("unroll") for (int i = 0; i < 4; i++) { const int id = tid + 256 * i, s = id >> 4, cc = id & 15; \
        cqn[i] = *(const u32x4*)(a.q + (size_t)(rp + s) * a.ld + cc * 8); ckn[i] = *(const u32x4*)(a.k + (size_t)(rp + s) * a.ld + cc * 8); } \
      if (tid < 64) dtn = a.lf[(size_t)(rp + tid) * a.ldlf]; \
    } \
    { const int s = tid & 63, vg = tid >> 6; vvn = *(const u32x4*)(a.v + (size_t)(rp + s) * a.ld + vg * 8); } }
  CH_PREFETCH(0)
#pragma unroll 1
  for (int ch = 0; ch < SL / 64; ch++) {
    const int r0 = ch * 64;
    float rc[32]; float kf[32]; float rc63 = 0.f;
    if (!SSM) {
      const int d = tid & 127, half = tid >> 7;
#pragma unroll
      for (int i = 0; i < 32; i++) rc[i] = rcn[i];
      float tot = 0.f;
      if (half == 0) {
        float acc = 0.f;
#pragma unroll
        for (int i = 31; i >= 0; i--) { float l = rc[i]; tot += l; rc[i] = acc; acc -= l; }
        em[d] = __expf(tot);
      } else {
        float acc = 0.f;
#pragma unroll
        for (int i = 0; i < 32; i++) { acc += rc[i]; rc[i] = acc; }
        tot = acc;
      }
      cum[half * 128 + d] = tot;
#pragma unroll
      for (int i = 0; i < 32; i++) {
        const int s = half * 32 + i;
        float qv = bf2f(qan[i]); kf[i] = bf2f(kan[i]);
        float r = rc[i];
        QT[s * QLD + d] = f2bf(qv * __expf(fminf(r, 80.f)));
        KT[s * QLD + d] = f2bf(kf[i] * __expf(fminf(-r, 80.f)));
      }
    } else {
#pragma unroll
      for (int i = 0; i < 4; i++) {
        const int id = tid + 256 * i, s = id >> 4, cc = id & 15;
        *(u32x4*)(QT + s * QLD + cc * 8) = cqn[i];
        *(u32x4*)(KT + s * QLD + cc * 8) = ckn[i];
      }
      if (tid < 64) {
        float dtv = dtn;
        float x = -dtv * a.expA;
#pragma unroll
        for (int o = 1; o < 64; o <<= 1) { float y = __shfl_up(x, o); if (lane >= o) x += y; }
        cum[tid] = x; dts[tid] = dtv;
      }
    }
    {
      const int s = tid & 63, vg = tid >> 6;
      u32x4 vv = vvn;
#pragma unroll
      for (int j = 0; j < 4; j++) { VT[(vg * 8 + 2 * j) * KHLD + s] = (u16)(vv[j] & 0xffffu); VT[(vg * 8 + 2 * j + 1) * KHLD + s] = (u16)(vv[j] >> 16); }
    }
    __syncthreads();
#pragma unroll
    for (int dt2 = 0; dt2 < 2; dt2++) {
      const int d0 = (2 * w + dt2) * 16 + 4 * g;
      f32x4 e4 = (f32x4){1.f, 1.f, 1.f, 1.f};
      if (!SSM) e4 = *(const f32x4*)(em + d0);
#pragma unroll
      for (int vt = 0; vt < 2; vt++) {
        f32x4 sv = accS[dt2][vt] * e4;
        u32x2 pk; pk.x = pk2(sv[0], sv[1]); pk.y = pk2(sv[2], sv[3]);
        *(u32x2*)(ST + (16 * vt + c) * QLD + d0) = pk;
      }
    }
    if (!SSM) {
      const int d = tid & 127, half = tid >> 7;
      const float t0 = cum[d], t1 = cum[128 + d];
      rc63 = t1;
      if (half == 0) gam[d] = __expf(t0 + t1);
#pragma unroll
      for (int i = 0; i < 32; i++) KH[d * KHLD + half * 32 + i] = f2bf(kf[i] * __expf(rc63 - rc[i]));
    }
    if (SSM) {
      const int s = tid & 63, ng = tid >> 6;
      const float sc = __expf(cum[63] - cum[s]) * dts[s];
#pragma unroll
      for (int i = 0; i < 4; i++) {
        u32x4 kk = *(const u32x4*)(KT + s * QLD + ng * 32 + i * 8);
#pragma unroll
        for (int j = 0; j < 4; j++) {
          const int n = ng * 32 + i * 8 + 2 * j;
          KH[n * KHLD + s] = f2bf(__uint_as_float(kk[j] << 16) * sc);
          KH[(n + 1) * KHLD + s] = f2bf(__uint_as_float(kk[j] & 0xffff0000u) * sc);
        }
      }
    }
    __syncthreads();
    if (ch + 1 < SL / 64) CH_PREFETCH(ch + 1)
    {
      const int t = 16 * w + c;
      bf16x8 bq[4];
#pragma unroll
      for (int ks = 0; ks < 4; ks++) bq[ks] = *(const bf16x8*)(QT + t * QLD + ks * 32 + g * 8);
      f32x4 accp[4];
#pragma unroll
      for (int st = 0; st < 4; st++) {
        accp[st] = (f32x4){0.f, 0.f, 0.f, 0.f};
        if (st <= w) {
#pragma unroll
          for (int ks = 0; ks < 4; ks++) {
            bf16x8 ak = *(const bf16x8*)(KT + (16 * st + c) * QLD + ks * 32 + g * 8);
            accp[st] = __builtin_amdgcn_mfma_f32_16x16x32_bf16(ak, bq[ks], accp[st], 0, 0, 0);
          }
        }
      }
      float cumt = 0.f;
      if (SSM) cumt = cum[t];
#pragma unroll
      for (int st = 0; st < 4; st++)
#pragma unroll
        for (int r = 0; r < 4; r++) {
          const int s = 16 * st + 4 * g + r;
          float v = accp[st][r];
          if (SSM) v *= __expf(fminf(cumt - cum[s], 0.f)) * dts[s];
          accp[st][r] = (s <= t) ? v : 0.f;
        }
      bf16x8 bp[2];
#pragma unroll
      for (int a2 = 0; a2 < 2; a2++)
#pragma unroll
        for (int j = 0; j < 4; j++) { bp[a2][j] = (short)f2bf(accp[2 * a2][j]); bp[a2][4 + j] = (short)f2bf(accp[2 * a2 + 1][j]); }
      f32x4 acco[2], acco2[2];
#pragma unroll
      for (int vt = 0; vt < 2; vt++) {
        acco[vt] = (f32x4){0.f, 0.f, 0.f, 0.f}; acco2[vt] = (f32x4){0.f, 0.f, 0.f, 0.f};
#pragma unroll
        for (int a2 = 0; a2 < 2; a2++) {
          if (2 * a2 <= w) {
            const u16* vp = VT + (16 * vt + c) * KHLD + 32 * a2 + 4 * g;
            u32x2 lo = *(const u32x2*)vp, hi = *(const u32x2*)(vp + 16);
            u32x4 cmb; cmb.x = lo.x; cmb.y = lo.y; cmb.z = hi.x; cmb.w = hi.y;
            bf16x8 av = __builtin_bit_cast(bf16x8, cmb);
            acco[vt] = __builtin_amdgcn_mfma_f32_16x16x32_bf16(av, bp[a2], acco[vt], 0, 0, 0);
          }
        }
#pragma unroll
        for (int ks = 0; ks < 4; ks++) {
          bf16x8 as = *(const bf16x8*)(ST + (16 * vt + c) * QLD + ks * 32 + g * 8);
          if (SSM) acco2[vt] = __builtin_amdgcn_mfma_f32_16x16x32_bf16(as, bq[ks], acco2[vt], 0, 0, 0);
          else acco[vt] = __builtin_amdgcn_mfma_f32_16x16x32_bf16(as, bq[ks], acco[vt], 0, 0, 0);
        }
        f32x4 ov = acco[vt];
        if (SSM) ov += __expf(cumt) * acco2[vt];
        *(f32x4*)(a.o + (size_t)(r0 + t) * 4096 + 16 * vt + 4 * g) = ov;
      }
#pragma unroll
      for (int dt2 = 0; dt2 < 2; dt2++) {
        const int d0 = (2 * w + dt2) * 16;
        f32x4 gm;
        if (SSM) { float gs = __expf(cum[63]); gm = (f32x4){gs, gs, gs, gs}; }
        else gm = *(const f32x4*)(gam + d0 + 4 * g);
#pragma unroll
        for (int vt = 0; vt < 2; vt++) accS[dt2][vt] *= gm;
#pragma unroll
        for (int a2 = 0; a2 < 2; a2++) {
          bf16x8 ak = *(const bf16x8*)(KH + (d0 + c) * KHLD + 32 * a2 + 8 * g);
#pragma unroll
          for (int vt = 0; vt < 2; vt++) {
            bf16x8 bv = *(const bf16x8*)(VT + (16 * vt + c) * KHLD + 32 * a2 + 8 * g);
            accS[dt2][vt] = __builtin_amdgcn_mfma_f32_16x16x32_bf16(ak, bv, accS[dt2][vt], 0, 0, 0);
          }
        }
      }
    }
    __syncthreads();
  }
  if (save)
#pragma unroll
  for (int i = 0; i < 2; i++)
#pragma unroll
    for (int j = 0; j < 2; j++) *(f32x4*)(a.state + (size_t)((i * 2 + j) * 256 + tid) * 4) = accS[i][j];
}

__device__ __forceinline__ void chunk_dispatch(PP p, int layer, int seg, int ct, bool first, bool save, char* smem) {
  float* so = (float*)(p->ws + O_SO);
  ChunkArgs a;
  if (ct < 256) {
    const int vs = ct & 3, h = (ct >> 2) & 7, b = ct >> 5;
    const size_t ro = (size_t)b * SL * 1024 + h * 128;
    a.q = (const u16*)(p->ws + O_HQ) + ro; a.k = (const u16*)(p->ws + O_HK) + ro; a.v = (const u16*)(p->ws + O_HV) + ro + vs * 32;
    a.lf = (const float*)(p->ws + O_HW) + ro; a.o = so + (size_t)b * SL * 4096 + 1024 + h * 128 + vs * 32;
    a.state = (float*)(p->ws + O_STHG) + (size_t)ct * 4096; a.ld = 1024; a.ldlf = 1024; a.expA = 0.f;
    chunk_task<false>(a, first, save, smem);
  } else {
    const int t2 = ct - 256, vs = t2 & 1, hd = (t2 >> 1) & 31, b = t2 >> 6, g = hd >> 3;
    const u16* x2 = (const u16*)(p->ws + ((seg & 1) ? O_SX22 : O_SX2)) + (size_t)b * SL * 3072;
    a.q = x2 + 2560 + g * 128; a.k = x2 + 2048 + g * 128; a.v = x2 + hd * 64 + vs * 32;
    a.lf = (const float*)(p->ws + O_SDT) + (size_t)b * SL * 32 + hd; a.o = so + (size_t)b * SL * 4096 + 2048 + hd * 64 + vs * 32;
    a.state = (float*)(p->ws + O_STSS) + (size_t)t2 * 4096; a.ld = 3072; a.ldlf = 32; a.expA = __expf(p->in[19][layer * 32 + hd]);
    chunk_task<true>(a, first, save, smem);
  }
}
__device__ __forceinline__ void rwkv_dispatch(PP p, int task, bool first, bool save, char* smem) {
  float* so = (float*)(p->ws + O_SO);
  ScanArgs a;
  const int h = task & 15, b = task >> 4;
  const size_t ro = (size_t)b * SL * 1024 + h * 64;
  a.pr = (const u16*)(p->ws + O_PR) + ro; a.pk = (const u16*)(p->ws + O_PK) + ro; a.pka = (const u16*)(p->ws + O_PKA) + ro; a.pkb = (const u16*)(p->ws + O_PKB) + ro;
  a.pv = (const u16*)(p->ws + O_PV) + ro; a.pw = (const float*)(p->ws + O_RWW) + ro; a.pvs = nullptr;
  a.po = so + (size_t)b * SL * 4096 + h * 64; a.state = (float*)(p->ws + O_STRW) + (size_t)(b * 16 + h) * 4096;
  a.sr = a.sk = a.sab = a.sv = a.sw = 1024; a.svs = 0; a.so = 4096;
  __builtin_amdgcn_s_setprio(3);
  scan_task<64, true, false, false, 4>(a, first, save, smem);
  __builtin_amdgcn_s_setprio(0);
}
template <int BR> __device__ __forceinline__ void merge_tile(PP p, int layer, int seg, int t, char* smem);
__device__ __forceinline__ void merge_item(PP p, int layer, int seg, int t, char* smem);
__device__ __forceinline__ void ph_scan(PP p, int layer, int seg, int bid, int nb, char* smem, volatile LAS unsigned* bw) {
  const bool first = (seg == 0);
  unsigned* ctr = (unsigned*)(p->ws + O_BAR) + 3520;
  const unsigned base = (unsigned)(layer * NSEG + seg) * (unsigned)(1024 + nb);
  {
    u16* urw = (u16*)(p->ws + O_URW);
    const int gt = bid * NTHR + tidx(), gs = nb * NTHR;
    for (int idx = gt; idx < 8 * 3456; idx += gs) { int b = idx / 3456, c = idx - b * 3456; urw[(size_t)(b * 513) * 3456 + c] = urw[(size_t)(b * 513 + 512) * 3456 + c]; }
  }
  if (bid < 128) { rwkv_dispatch(p, bid, first, true, smem); __syncthreads(); }
#pragma unroll 1
  for (;;) {
    if (tidx() == 0) *bw = __hip_atomic_fetch_add(ctr, 1u, __ATOMIC_RELAXED, __HIP_MEMORY_SCOPE_AGENT);
    __syncthreads();
    const unsigned it = *bw - base;
    __syncthreads();
    if (it >= 1024u) break;
    if (it < 256u) { if (seg > 0) merge_item(p, layer, seg - 1, (int)it, smem); }
    else chunk_dispatch(p, layer, seg, (int)it - 256, first, true, smem);
    __syncthreads();
  }
}

__device__ __forceinline__ void ph_post(PP p, int layer, int seg, int bid, int nb) {
  const float* so = (const float*)(p->ws + O_SO); u16* y = (u16*)(p->ws + O_Y);
  const int lane = tidx() & 63, wv = tidx() >> 6;
  const u16* pv = (const u16*)(p->ws + O_PV); const u16* rwg = (const u16*)(p->ws + O_RWG); const float* bonus = (const float*)(p->ws + O_BONUS);
  const float* gnw = p->in[12] + layer * 1024; const float* gnb = p->in[13] + layer * 1024;
  const u16* hg = (const u16*)(p->ws + ((seg & 1) ? O_HG2 : O_HG)); const float* hgn = p->in[15] + layer * 1024;
  const u16* sx2 = (const u16*)(p->ws + ((seg & 1) ? O_SX22 : O_SX2)); const u16* sz = (const u16*)(p->ws + ((seg & 1) ? O_SZ2 : O_SZ));
  const float* dsk = p->in[20] + layer * 32; const float* sgn = p->in[21] + layer * 2048;
#pragma unroll 1
  for (int task = bid * 4 + wv; task < RS * 12; task += nb * 4) {
    const int r = task / 12, s = task - r * 12;
    if (s < 4) {
      const int col = s * 256 + lane * 4;
      f32x4 o = *(const f32x4*)(so + (size_t)r * 4096 + col);
      const float mean = red16(o[0] + o[1] + o[2] + o[3]) * (1.f / 64.f);
      f32x4 d = o - mean;
      const float var = red16(d[0] * d[0] + d[1] * d[1] + d[2] * d[2] + d[3] * d[3]) * (1.f / 64.f);
      f32x4 on = d * rsqrtf(var + 64e-5f) * *(const f32x4*)(gnw + col) + *(const f32x4*)(gnb + col);
      on += bonus[r * 16 + (col >> 6)] * cvt4(*(const u32x2*)(pv + (size_t)r * 1024 + col));
      on *= cvt4(*(const u32x2*)(rwg + (size_t)r * 1024 + col));
      *(u32x2*)(y + (size_t)r * 4096 + col) = pack4(on[0], on[1], on[2], on[3]);
    } else if (s < 8) {
      const int c = (s - 4) * 256 + lane * 4;
      f32x4 o = *(const f32x4*)(so + (size_t)r * 4096 + 1024 + c);
      float ss = red16(o[0] * o[0] + o[1] * o[1] + o[2] * o[2] + o[3] * o[3]);
      ss += __shfl_xor(ss, 16);
      const float rstd = rsqrtf(ss * (1.f / 128.f) + 1e-5f);
      f32x4 on = o * rstd * *(const f32x4*)(hgn + c) * cvt4(*(const u32x2*)(hg + (size_t)r * 1024 + c));
      *(u32x2*)(y + (size_t)r * 4096 + 1024 + c) = pack4(on[0], on[1], on[2], on[3]);
    } else {
      const int g = s - 8, ch = g * 512 + lane * 8;
      f32x4 o0 = *(const f32x4*)(so + (size_t)r * 4096 + 2048 + ch), o1 = *(const f32x4*)(so + (size_t)r * 4096 + 2048 + ch + 4);
      u32x4 xr = *(const u32x4*)(sx2 + (size_t)r * 3072 + ch), zr = *(const u32x4*)(sz + (size_t)r * 2048 + ch);
      u32x2 t0; t0.x = xr.x; t0.y = xr.y; u32x2 t1; t1.x = xr.z; t1.y = xr.w;
      u32x2 z0; z0.x = zr.x; z0.y = zr.y; u32x2 z1; z1.x = zr.z; z1.y = zr.w;
      const float dk = dsk[ch >> 6];
      f32x4 y0 = (o0 + dk * cvt4(t0)) * cvt4(z0), y1 = (o1 + dk * cvt4(t1)) * cvt4(z1);
      float ss = y0[0] * y0[0] + y0[1] * y0[1] + y0[2] * y0[2] + y0[3] * y0[3] + y1[0] * y1[0] + y1[1] * y1[1] + y1[2] * y1[2] + y1[3] * y1[3];
      ss = red16(ss); ss += __shfl_xor(ss, 16); ss += __shfl_xor(ss, 32);
      const float rstd = rsqrtf(ss * (1.f / 512.f) + 1e-5f);
      y0 = y0 * rstd * *(const f32x4*)(sgn + ch); y1 = y1 * rstd * *(const f32x4*)(sgn + ch + 4);
      u32x4 ov; ov.x = pk2(y0[0], y0[1]); ov.y = pk2(y0[2], y0[3]); ov.z = pk2(y1[0], y1[1]); ov.w = pk2(y1[2], y1[3]);
      *(u32x4*)(y + (size_t)r * 4096 + 2048 + ch) = ov;
    }
  }
}

#define MT_ROW(row) ((size_t)(((row) >> 9) * 515 + 3 + ((row) & 511)) * 1536)
template <int BR>
__device__ __forceinline__ void merge_tile(PP p, int layer, int seg, int t, char* smem) {
  const u16* W = (const u16*)(p->ws + O_W) + WBR;
  const u16* Y = (const u16*)(p->ws + O_Y); const u16* gp = (const u16*)(p->ws + ((seg & 1) ? O_GATES2 : O_GATES)) + BR * 1024; u16* mg = (u16*)(p->ws + O_MERGED);
  float* mt = (float*)(p->ws + O_SXBC);
  constexpr int k0 = BR * 1024, nkt = BR == 2 ? 64 : 32;
  const int m0 = (t & 31) * 128, n0 = (t >> 5) * 128;
  f32x4 acc[4][4]; ACC_ZERO(acc);
  gemm_kloop(Y + (size_t)m0 * 4096 + k0, 4096, W + (size_t)n0 * 4096 + k0, 4096, nkt, acc, smem);
  EPI_LOOP2({ l0[j] = cvt4(*(const u32x2*)(gp + (size_t)row * 3072 + col)); if (BR > 0) l1[j] = *(const f32x4*)(mt + MT_ROW(row) + col); else l1[j] = f4z(); },
            { const f32x4 gsum = l1[j] + l0[j] * v; if (BR < 2) *(f32x4*)(mt + MT_ROW(row) + col) = gsum; else *(u32x2*)(mg + (size_t)row * 1024 + col) = pack4v(gsum); })
}
__device__ __forceinline__ void merge_item(PP p, int layer, int seg, int t, char* smem) {
  merge_tile<0>(p, layer, seg, t, smem);
  merge_tile<1>(p, layer, seg, t, smem);
  merge_tile<2>(p, layer, seg, t, smem);
}
__device__ __forceinline__ void ph_merge(PP p, int layer, int seg, int bid, int nb, char* smem) {
#pragma unroll 1
  for (int t = bid; t < 256; t += nb) merge_item(p, layer, seg, t, smem);
}
__device__ __forceinline__ void ph_out(PP p, int layer, int seg, int bid, int nb, char* smem) {
  const u16* W = (const u16*)(p->ws + O_W) + WOUT;
  const u16* mg = (const u16*)(p->ws + O_MERGED);
  const float* xs = layer == 0 ? p->in[0] : p->out;
  for (int t = bid; t < 256; t += nb) {
    const int m0 = (t & 31) * 128, n0 = (t >> 5) * 128;
    f32x4 acc[4][4]; ACC_ZERO(acc);
    gemm_kloop(mg + (size_t)m0 * 1024, 1024, W + (size_t)n0 * 1024, 1024, 32, acc, smem);
    EPI_LOOP2({ size_t gr = (size_t)(row >> 9) * SEQ + seg * SL + (row & 511); l0[j] = *(const f32x4*)(xs + gr * 1024 + col); },
              { size_t gr = (size_t)(row >> 9) * SEQ + seg * SL + (row & 511); *(f32x4*)(p->out + gr * 1024 + col) = l0[j] + v; })
  }
}
__device__ __forceinline__ void ph_ffi(PP p, int layer, int bid, int nb, char* smem) {
  const u16* W = (const u16*)(p->ws + O_W) + WFFI;
  const u16* H2 = (const u16*)(p->ws + O_H2); u16* hid = (u16*)(p->ws + O_HID);
  for (int t = bid; t < 128 * 44; t += nb) {
    const int m0 = (t & 127) * 256, n0 = (t >> 7) * 128;
    f32x4 acc[8][4]; ACC_ZERO(acc);
    gemm_kloop(H2 + (size_t)m0 * 1024, 1024, W + (size_t)n0 * 1024, 1024, 32, acc, smem);
    const int lane = tidx() & 63, wave = tidx() >> 6, wm = wave >> 1, wn = wave & 1;
#pragma unroll
    for (int i = 0; i < 8; i++)
#pragma unroll
      for (int j = 0; j < 4; j += 2) {
        const int row = m0 + wm * 128 + i * 16 + (lane & 15);
        const int ng = n0 + wn * 64 + j * 16 + (lane >> 4) * 4;
        const int hc = (ng >> 5) * 16 + (ng & 15);
        const f32x4 g = acc[i][j], u = acc[i][j + 1];
        *(u32x2*)(hid + (size_t)row * 2816 + hc) = pack4v(g * sigm4(g) * u);
      }
  }
}
__device__ __forceinline__ void ph_ffo(PP p, int layer, int bid, int nb, char* smem) {
  const u16* W = (const u16*)(p->ws + O_W) + WFFO;
  const u16* hid = (const u16*)(p->ws + O_HID);
  for (int t = bid; t < 128 * 8; t += nb) {
    const int m0 = (t & 127) * 256, n0 = (t >> 7) * 128;
    f32x4 acc[8][4]; ACC_ZERO(acc);
    gemm_kloop(hid + (size_t)m0 * 2816, 2816, W + (size_t)n0 * 2816, 2816, 88, acc, smem);
    float* outp = p->out;
    EPI_LOOP2({ l0[j] = *(const f32x4*)(outp + (size_t)row * 1024 + col); }, { *(f32x4*)(outp + (size_t)row * 1024 + col) = l0[j] + v; })
  }
}

__device__ __forceinline__ void ph_norm1(PP p, int layer, int seg, int bid, int nb) {
  if (seg == 0) {
    u16* urw = (u16*)(p->ws + O_URW); u16* sxbc = (u16*)(p->ws + O_SXBC);
    const int gt = bid * NTHR + tidx(), gs = nb * NTHR;
    for (int idx = gt; idx < 8 * 3456; idx += gs) { int b = idx / 3456, c = idx - b * 3456; urw[(size_t)(b * 513) * 3456 + c] = 0; }
    for (int idx = gt; idx < 8 * 9216; idx += gs) { int b = idx / 9216, c = idx - b * 9216; sxbc[(size_t)(b * 515) * 3072 + c] = 0; }
  }
  rmsnorm_rows(layer == 0 ? p->in[0] : p->out, p->in[1] + layer * 1024, (u16*)(p->ws + O_H), nullptr, RS, 0, seg, bid, nb);
}

#define XB_TMO      128
#define XB_XCNT(j)  (256  + 64 * (j))
#define XB_XSUB(j)  (1280 + 64 * (j))
#define XB_XGEN(j)  (2304 + 64 * (j))
#define XB_TOP      3328
#define XB_TOPGEN   3392
#define XCD_BAR_WORDS 3456
#define XB_SPIN_CAP (1u << 22)
__device__ __forceinline__ unsigned xb_ld(unsigned* p)              { return __hip_atomic_load(p, __ATOMIC_RELAXED, __HIP_MEMORY_SCOPE_AGENT); }
__device__ __forceinline__ unsigned xb_add(unsigned* p, unsigned v) { return __hip_atomic_fetch_add(p, v, __ATOMIC_RELAXED, __HIP_MEMORY_SCOPE_AGENT); }
__device__ __forceinline__ unsigned xb_xcc_id() { return (unsigned)__builtin_amdgcn_s_getreg((3 << 11) | 20) & 0xFu; }
#define XB_SPIN(cond, bar) do { unsigned _sp = 0; while (cond) { __builtin_amdgcn_s_sleep(1); \
    if ((++_sp & 255u) == 0u) { if (xb_ld(&(bar)[XB_TMO])) break; if (_sp > XB_SPIN_CAP) { atomicAdd(&(bar)[XB_TMO], 1u); break; } } } } while (0)
struct XcdBarrier { unsigned* bar; unsigned x; volatile LAS unsigned* st; };
__device__ __forceinline__ XcdBarrier xcd_barrier_post(unsigned* bar, volatile LAS unsigned* st) {
  XcdBarrier b; b.bar = bar; b.x = xb_xcc_id(); b.st = st;
  if (threadIdx.x == 0) (void)xb_add(&bar[XB_XCNT(b.x)], 1u);
  return b;
}
__device__ __forceinline__ void xcd_barrier_complete(unsigned* bar, unsigned x, unsigned& nloc, unsigned& nx) {
  const unsigned G = gridDim.x * gridDim.y * gridDim.z;
  unsigned sum, cnt, mine, sp = 0u;
  for (;;) {
    sum = 0u; cnt = 0u; mine = 0u;
#pragma unroll
    for (unsigned j = 0; j < 16; ++j) { const unsigned c = xb_ld(&bar[XB_XCNT(j)]); sum += c; cnt += (c > 0u) ? 1u : 0u; mine = (j == x) ? c : mine; }
    if (sum == G) break;
    __builtin_amdgcn_s_sleep(1);
    if ((++sp & 255u) == 0u) { if (xb_ld(&bar[XB_TMO])) break; if (sp > XB_SPIN_CAP) { atomicAdd(&bar[XB_TMO], 1u); break; } }
  }
  nloc = mine > 0u ? mine : 1u; nx = cnt > 0u ? cnt : 1u;
}
__device__ __forceinline__ void xcd_barrier(const XcdBarrier& b) {
  asm volatile("s_waitcnt vmcnt(0)" ::: "memory");
  __syncthreads();
  if (threadIdx.x == 0) {
    unsigned* bar = b.bar;
    __builtin_amdgcn_s_waitcnt(0);
    unsigned nloc = b.st[0], nx = b.st[1];
    if (nloc == 0u) { xcd_barrier_complete(bar, b.x, nloc, nx); b.st[0] = nloc; b.st[1] = nx; }
    const unsigned old = xb_add(&bar[XB_XSUB(b.x)], 1u);
    const unsigned gen = old / nloc;
    if (old + 1u == (gen + 1u) * nloc) {
      __builtin_amdgcn_fence(__ATOMIC_RELEASE, "agent");
      asm volatile("s_waitcnt vmcnt(0)" ::: "memory");
      const unsigned og = xb_add(&bar[XB_TOP], 1u);
      const unsigned tg = og / nx;
      if (og + 1u == (tg + 1u) * nx) xb_add(&bar[XB_TOPGEN], 1u);
      else XB_SPIN(xb_ld(&bar[XB_TOPGEN]) == tg, bar);
      __builtin_amdgcn_fence(__ATOMIC_ACQUIRE, "agent");
      xb_add(&bar[XB_XGEN(b.x)], 1u);
      asm volatile("s_waitcnt vmcnt(0)" ::: "memory");
    } else {
      XB_SPIN(xb_ld(&bar[XB_XGEN(b.x)]) == gen, bar);
      __builtin_amdgcn_fence(__ATOMIC_ACQUIRE, "agent");
      asm volatile("s_waitcnt vmcnt(0)" ::: "memory");
    }
  }
  __syncthreads();
}

#define SMEM_BYTES 73728
#ifndef SCANPROBE
#define SCANPROBE 0
#endif
#ifndef PHMASK
#define PHMASK 0xFFFF
#endif
#ifndef DBLMASK
#define DBLMASK 0
#endif
#define RUN(idx, call) { if ((PHMASK >> (idx)) & 1) { if ((DBLMASK >> (idx)) & 1) { call; __syncthreads(); } call; } }
__global__ void __launch_bounds__(NTHR, 2) mega(Params p_) {
  __shared__ __attribute__((aligned(1024))) char smem[SMEM_BYTES + 16];
  uint4& xb_words = *(uint4*)(smem + SMEM_BYTES);
  cg::grid_group grid = cg::this_grid();
  if (threadIdx.x == 0) xb_words = make_uint4(0u, 0u, 0u, 0u);
  __syncthreads();
  XcdBarrier xb = xcd_barrier_post((unsigned*)(p_.ws + O_BAR), (volatile LAS unsigned*)&xb_words);
  {
    PP p = (PP)__builtin_amdgcn_kernarg_segment_ptr();
    RUN(0, ph_wconv(p, 0, blockIdx.x, gridDim.x, smem))
  }
  if (p_.out == nullptr) grid.sync();
  xcd_barrier(xb);
#pragma unroll 1
  for (int pc = 0; pc < 151; pc++) {
    PP p = (PP)__builtin_amdgcn_kernarg_segment_ptr();
    asm volatile("" : "+s"(p));
    int bid = blockIdx.x, nb = gridDim.x;
    asm volatile("" : "+s"(bid), "+s"(nb));
    const int l = pc / 75, q = pc - l * 75;
    bool did = true;
    if (pc == 150) {
      RUN(13, rmsnorm_rows(p->out, p->in[27], nullptr, p->out, TTOK, 2, 0, bid, nb))
      did = false;
    } else if (q >= 72) {
      if (q == 72) RUN(10, rmsnorm_rows(p->out, p->in[24] + l * 1024, (u16*)(p->ws + O_H2), nullptr, TTOK, 1, 0, bid, nb))
      else if (q == 73) RUN(11, ph_ffi(p, l, bid, nb, smem))
      else RUN(12, ph_ffo(p, l, bid, nb, smem))
    } else {
      const int sg = q / 9, st = q - sg * 9;
      switch (st) {
        case 0: if (sg == 0) { if (l > 0) RUN(0, ph_wconv(p, l, bid, nb, smem)) RUN(1, ph_norm1(p, l, 0, bid, nb)) } else did = false; break;
        case 1:
          if (bid * 2 < nb) { if (sg > 0) RUN(7, ph_post(p, l, sg - 1, bid, nb)) RUN(2, ph_inproj(p, l, sg, bid, nb, smem)) }
          else { RUN(2, ph_inproj(p, l, sg, bid, nb, smem)) if (sg > 0) RUN(7, ph_post(p, l, sg - 1, bid, nb)) }
          if (sg > 1) RUN(9, ph_out(p, l, sg - 2, bid, nb, smem))
          break;
        case 2: RUN(3, ph_elem(p, l, sg, bid, nb)) if (sg + 1 < NSEG) RUN(1, ph_norm1(p, l, sg + 1, bid, nb)) break;
        case 3: RUN(4, ph_lora(p, l, bid, nb, smem)) break;
        case 4: RUN(5, ph_rprep(p, l, bid, nb)) break;
        case 5: ph_scan(p, l, sg, bid, nb, smem, ((volatile LAS unsigned*)&xb_words) + 2); break;
        case 6: if (sg == NSEG - 1) { RUN(7, ph_post(p, l, sg, bid, nb)) RUN(9, ph_out(p, l, sg - 1, bid, nb, smem)) } else did = false; break;
        case 7: if (sg == NSEG - 1) RUN(8, ph_merge(p, l, sg, bid, nb, smem)) else did = false; break;
        default: if (sg == NSEG - 1) RUN(9, ph_out(p, l, sg, bid, nb, smem)) else did = false; break;
      }
    }
    if (did) xcd_barrier(xb);
  }
}

extern "C" void kernel_launch(void* const* d_in, const int* in_sizes, int n_in, void* d_out, int out_size, void* d_ws,
                              size_t ws_size, hipStream_t stream) {
  Params p{};
  for (int i = 0; i < 28; i++) p.in[i] = (const float*)d_in[i];
  p.out = (float*)d_out; p.ws = (char*)d_ws;
  static int grid_blocks = 0;
  if (!grid_blocks) {
    int dev = 0, cus = 0, per_cu = 0;
    hipGetDevice(&dev);
    hipDeviceGetAttribute(&cus, hipDeviceAttributeMultiprocessorCount, dev);
    hipOccupancyMaxActiveBlocksPerMultiprocessor(&per_cu, mega, NTHR, 0);
    if (per_cu > 2) per_cu = 2;
    if (per_cu < 1) per_cu = 1;
    grid_blocks = cus * per_cu;
  }
  hipMemsetAsync((char*)d_ws + O_BAR, 0, 16384, stream);
  void* args[] = {&p};
  hipError_t e = hipLaunchCooperativeKernel((void*)mega, dim3(grid_blocks), dim3(NTHR), args, 0, stream);
  if (e != hipSuccess) fprintf(stderr, "cooperative launch failed: %s (grid %d)\n", hipGetErrorString(e), grid_blocks);
}
```

```cpp
#include <hip/hip_runtime.h>
#include <hip/hip_cooperative_groups.h>
#include <stdint.h>
#include <stdio.h>
namespace cg = cooperative_groups;

typedef unsigned short u16;
using bf16x8 = __attribute__((ext_vector_type(8))) short;
using f32x4  = __attribute__((ext_vector_type(4))) float;
using u32x4 = __attribute__((ext_vector_type(4))) unsigned int;
using u32x2 = __attribute__((ext_vector_type(2))) unsigned int;

#define DM 1024
#define SEQ 4096
#define TTOK 32768
#define SL 512
#define NSEG 8
#define RS 4096
#define NTHR 256
#ifndef SCANPROBE
#define SCANPROBE 0
#endif

constexpr size_t al(size_t x) { return (x + 255) & ~(size_t)255; }
constexpr size_t WIN = 0;
constexpr size_t WWUP = WIN + (size_t)15872 * 1024;
constexpr size_t WAUP = WWUP + 65536;
constexpr size_t WGUP = WAUP + 65536;
constexpr size_t WBR = WGUP + 196608;
constexpr size_t WOUT = WBR + 4194304;
constexpr size_t WFFI = WOUT + 1048576;
constexpr size_t WFFO = WFFI + 5767168;
constexpr size_t W_LAYER = WFFO + 2883584;
constexpr size_t O_W = 0;
constexpr size_t O_H = al(O_W + W_LAYER * 2);
constexpr size_t O_URW = al(O_H + (size_t)RS * 1024 * 2);
constexpr size_t O_HQ = al(O_URW + (size_t)8 * 513 * 3456 * 2);
constexpr size_t O_HV = al(O_HQ + (size_t)RS * 1024 * 2);
constexpr size_t O_HG = al(O_HV + (size_t)RS * 1024 * 2);
constexpr size_t O_HW = al(O_HG + (size_t)RS * 1024 * 2);
constexpr size_t O_SZ = al(O_HW + (size_t)RS * 1024 * 4);
constexpr size_t O_SXBC = al(O_SZ + (size_t)RS * 2048 * 2);
constexpr size_t O_SDT = al(O_SXBC + (size_t)8 * 515 * 3072 * 2);
constexpr size_t O_SWD = al(O_SDT + (size_t)RS * 32 * 4);
constexpr size_t O_GATES = al(O_SWD + (size_t)RS * 32 * 4);
constexpr size_t O_LAW = al(O_GATES + (size_t)RS * 3072 * 2);
constexpr size_t O_LAA = al(O_LAW + (size_t)RS * 64 * 2);
constexpr size_t O_LAG = al(O_LAA + (size_t)RS * 64 * 2);
constexpr size_t O_SX2 = al(O_LAG + (size_t)RS * 192 * 2);
constexpr size_t O_RWW = al(O_SX2 + (size_t)RS * 3072 * 2);
constexpr size_t O_RWA = al(O_RWW + (size_t)RS * 1024 * 4);
constexpr size_t O_RWG = al(O_RWA + (size_t)RS * 1024 * 2);
constexpr size_t O_PR = al(O_RWG + (size_t)RS * 1024 * 2);
constexpr size_t O_PK = al(O_PR + (size_t)RS * 1024 * 2);
constexpr size_t O_PV = al(O_PK + (size_t)RS * 1024 * 2);
constexpr size_t O_PKA = al(O_PV + (size_t)RS * 1024 * 2);
constexpr size_t O_PKB = al(O_PKA + (size_t)RS * 1024 * 2);
constexpr size_t O_BONUS = al(O_PKB + (size_t)RS * 1024 * 2);
constexpr size_t O_SO = al(O_BONUS + (size_t)RS * 16 * 4);
constexpr size_t O_Y = al(O_SO + (size_t)RS * 4096 * 4);
constexpr size_t O_MERGED = al(O_Y + (size_t)RS * 4096 * 2);
constexpr size_t O_STRW = al(O_MERGED + (size_t)RS * 1024 * 2);
constexpr size_t O_STHG = al(O_STRW + (size_t)128 * 64 * 64 * 4);
constexpr size_t O_STSS = al(O_STHG + (size_t)64 * 128 * 128 * 4);
constexpr size_t O_END = al(O_STSS + (size_t)256 * 64 * 128 * 4);
constexpr size_t O_H2 = O_H;
constexpr size_t O_HID = al(O_H2 + (size_t)TTOK * 1024 * 2);
constexpr size_t O_END2 = al(O_HID + (size_t)TTOK * 2816 * 2);
constexpr size_t O_HK = O_END;
constexpr size_t O_GATES2 = al(O_HK + (size_t)RS * 1024 * 2);
constexpr size_t O_HG2 = al(O_GATES2 + (size_t)RS * 3072 * 2);
constexpr size_t O_SZ2 = al(O_HG2 + (size_t)RS * 1024 * 2);
constexpr size_t O_SX22 = al(O_SZ2 + (size_t)RS * 2048 * 2);
constexpr size_t O_BAR = al(O_SX22 + (size_t)RS * 3072 * 2);
static_assert(O_BAR + 16384 <= (size_t)536870912, "ws overflow");
static_assert(O_END2 <= (size_t)536870912, "ws overflow2");

#define LAS __attribute__((address_space(3)))
struct Params { const float* in[28]; float* out; char* ws; };
typedef const __attribute__((address_space(4))) Params* PP;

enum { PH_WCONV = 0, PH_NORM1, PH_INPROJ, PH_ELEM, PH_LORA, PH_RPREP, PH_SCAN, PH_POST, PH_MERGE, PH_OUT,
       PH_NORM2, PH_FFI, PH_FFO, PH_FINAL };

__device__ __forceinline__ float bf2f(u16 u) { return __uint_as_float(((unsigned)u) << 16); }
__device__ __forceinline__ u16 f2bf(float f) { unsigned u = __float_as_uint(f); u += 0x7fffu + ((u >> 16) & 1u); return (u16)(u >> 16); }
__device__ __forceinline__ float sigm(float x) { return 1.f / (1.f + __expf(-x)); }
__device__ __forceinline__ float wave_sum(float x) {
#pragma unroll
  for (int o = 32; o; o >>= 1) x += __shfl_xor(x, o);
  return x;
}
__device__ __forceinline__ f32x4 cvt4(u32x2 v) {
  f32x4 r; r.x = __uint_as_float(v.x << 16); r.y = __uint_as_float(v.x & 0xffff0000u);
  r.z = __uint_as_float(v.y << 16); r.w = __uint_as_float(v.y & 0xffff0000u); return r;
}
template <int CTRL> __device__ __forceinline__ float dppf(float x) {
  return __int_as_float(__builtin_amdgcn_update_dpp(0, __float_as_int(x), CTRL, 0xF, 0xF, true));
}
__device__ __forceinline__ float red16(float x) {
  x += dppf<0xB1>(x); x += dppf<0x4E>(x); x += dppf<0x141>(x); x += dppf<0x140>(x); return x;
}
__device__ __forceinline__ unsigned pk2(float a, float b) { return (unsigned)f2bf(a) | ((unsigned)f2bf(b) << 16); }
__device__ __forceinline__ u32x2 pack4(float a, float b, float c, float d) {
  u32x2 r; r.x = (unsigned)f2bf(a) | ((unsigned)f2bf(b) << 16); r.y = (unsigned)f2bf(c) | ((unsigned)f2bf(d) << 16); return r;
}
__device__ __forceinline__ f32x4 f4z() { return (f32x4){0.f, 0.f, 0.f, 0.f}; }
__device__ __forceinline__ f32x4 sigm4(f32x4 x) { f32x4 r; r[0] = sigm(x[0]); r[1] = sigm(x[1]); r[2] = sigm(x[2]); r[3] = sigm(x[3]); return r; }
__device__ __forceinline__ u32x2 pack4v(f32x4 x) { return pack4(x[0], x[1], x[2], x[3]); }
__device__ __forceinline__ float red4(float x) { x += dppf<0xB1>(x); x += dppf<0x4E>(x); return x; }
__device__ __forceinline__ float red8(float x) {
  x += dppf<0xB1>(x); x += dppf<0x4E>(x); x += dppf<0x141>(x); return x;
}

__device__ __forceinline__ int tidx() { int t = threadIdx.x; asm volatile("" : "+v"(t)); return t; }
__device__ __forceinline__ int remap_col(int kind, int n, int nsrc) {
  if (kind == 0) return n < nsrc ? n : -1;
  if (kind == 1) {
    if (n < 3456) return n < 3360 ? n : -1;
    if (n < 7552) return 3360 + (n - 3456);
    if (n < 12800) { int c = n - 7552; return c < 5152 ? 7456 + c : -1; }
    return 12608 + (n - 12800);
  }
  int blk = n >> 5, w = n & 31;
  return w < 16 ? blk * 16 + w : 2816 + blk * 16 + (w - 16);
}
__device__ __forceinline__ void tconv(const float* __restrict__ src, int K, int Nsrc, u16* __restrict__ dst, int Kpad, int Npad,
                      int kind, int bid, int nb, char* smem) {
  float(*tile)[65] = (float(*)[65])smem;
  const int tn = Npad >> 6, tk = Kpad >> 6, tid = tidx();
  for (int t = bid; t < tn * tk; t += nb) {
    const int n0 = (t % tn) << 6, k0 = (t / tn) << 6;
    const int nn4 = (tid & 15) * 4, c = remap_col(kind, n0 + nn4, Nsrc);
#pragma unroll
    for (int i = 0; i < 4; i++) {
      const int kk = (tid >> 4) + 16 * i, k = k0 + kk;
      f32x4 v = (f32x4){0.f, 0.f, 0.f, 0.f};
      if (k < K && c >= 0) v = *(const f32x4*)(src + (size_t)k * Nsrc + c);
      tile[kk][nn4] = v[0]; tile[kk][nn4 + 1] = v[1]; tile[kk][nn4 + 2] = v[2]; tile[kk][nn4 + 3] = v[3];
    }
    __syncthreads();
#pragma unroll
    for (int i = 0; i < 8; i++) {
      const int n2 = (tid >> 5) + 8 * i, kk = (tid & 31) * 2;
      *(unsigned*)(dst + (size_t)(n0 + n2) * Kpad + k0 + kk) = pk2(tile[kk][n2], tile[kk + 1][n2]);
    }
    __syncthreads();
  }
}
__device__ __forceinline__ void ph_wconv(PP p, int l, int bid, int nb, char* smem) {
  {
    u16* W = (u16*)(p->ws + O_W);
    tconv(p->in[2] + (size_t)l * 1024 * 15680, 1024, 15680, W + WIN, 1024, 15872, 1, bid, nb, smem);
    tconv(p->in[5] + (size_t)l * 64 * 1024, 64, 1024, W + WWUP, 64, 1024, 0, bid, nb, smem);
    tconv(p->in[7] + (size_t)l * 64 * 1024, 64, 1024, W + WAUP, 64, 1024, 0, bid, nb, smem);
    tconv(p->in[8] + (size_t)l * 160 * 1024, 160, 1024, W + WGUP, 192, 1024, 0, bid, nb, smem);
    tconv(p->in[22] + (size_t)l * 4096 * 1024, 4096, 1024, W + WBR, 4096, 1024, 0, bid, nb, smem);
    tconv(p->in[23] + (size_t)l * 1024 * 1024, 1024, 1024, W + WOUT, 1024, 1024, 0, bid, nb, smem);
    tconv(p->in[25] + (size_t)l * 1024 * 5632, 1024, 5632, W + WFFI, 1024, 5632, 2, bid, nb, smem);
    tconv(p->in[26] + (size_t)l * 2816 * 1024, 2816, 1024, W + WFFO, 2816, 1024, 0, bid, nb, smem);
  }
}

__device__ __forceinline__ void rmsnorm_rows(const float* __restrict__ xs, const float* __restrict__ gain, u16* dst, float* dstf,
                             int nrows, int mode, int seg, int bid, int nb) {
  const int lane = tidx() & 63, wv = tidx() >> 6;
  for (int r = bid * 4 + wv; r < nrows; r += nb * 4) {
    size_t srow = (mode == 0) ? ((size_t)(r >> 9) * SEQ + seg * SL + (r & 511)) : (size_t)r;
    const float4* xp = (const float4*)(xs + srow * DM);
    float4 v[4]; float ss = 0.f;
#pragma unroll
    for (int i = 0; i < 4; i++) { v[i] = xp[lane + 64 * i]; ss += v[i].x * v[i].x + v[i].y * v[i].y + v[i].z * v[i].z + v[i].w * v[i].w; }
    ss = wave_sum(ss);
    float rstd = rsqrtf(ss * (1.f / DM) + 1e-5f);
#pragma unroll
    for (int i = 0; i < 4; i++) {
      float4 g = ((const float4*)gain)[lane + 64 * i];
      float a = v[i].x * rstd * g.x, b = v[i].y * rstd * g.y, c = v[i].z * rstd * g.z, d = v[i].w * rstd * g.w;
      if (mode == 2) { float4 o; o.x = a; o.y = b; o.z = c; o.w = d; ((float4*)(dstf + (size_t)r * DM))[lane + 64 * i] = o; }
      else { uint2 o; o.x = (unsigned)f2bf(a) | ((unsigned)f2bf(b) << 16); o.y = (unsigned)f2bf(c) | ((unsigned)f2bf(d) << 16);
             ((uint2*)(dst + (size_t)r * DM))[lane + 64 * i] = o; }
    }
  }
}

#define WAIT_V(n) asm volatile("s_waitcnt vmcnt(%0)" ::"n"(n) : "memory")
#define WAIT_L(n) asm volatile("s_waitcnt lgkmcnt(%0)" ::"n"(n) : "memory")
#define RAW_BARRIER() do { WAIT_L(0); __builtin_amdgcn_s_barrier(); } while (0)
template <int MI>
__device__ __forceinline__ void gemm_kloop(const u16* __restrict__ A, int lda, const u16* __restrict__ B, int ldb, int nkt,
                                           f32x4 (&acc)[MI][4], char* smem) {
  constexpr int NA = MI / 2, ABYTES = MI * 32 * 64, STB = ABYTES + 8192, NST = (MI == 4) ? 4 : 3, LPT = NA + 2;
  const int tid = tidx(), lane = tid & 63, wave = tid >> 6, wm = wave >> 1, wn = wave & 1;
  const int wu = __builtin_amdgcn_readfirstlane(wave);
  const u16* ga[NA]; const u16* gb[2];
#pragma unroll
  for (int i = 0; i < NA; i++) {
    const int r = (wu * NA + i) * 16 + (lane >> 2), kc = (lane & 3) ^ ((r >> 2) & 3);
    ga[i] = A + (size_t)r * lda + kc * 8;
  }
#pragma unroll
  for (int i = 0; i < 2; i++) {
    const int r = (wu * 2 + i) * 16 + (lane >> 2), kc = (lane & 3) ^ ((r >> 2) & 3);
    gb[i] = B + (size_t)r * ldb + kc * 8;
  }
  LAS char* sm = (LAS char*)smem;
#define GSTAGE(st_, kt_) { \
    _Pragma("unroll") for (int i = 0; i < NA; i++) \
      __builtin_amdgcn_global_load_lds((const unsigned*)(ga[i] + (kt_) * 32), (LAS unsigned*)(sm + (st_) * STB + (wu * NA + i) * 1024), 16, 0, 0); \
    _Pragma("unroll") for (int i = 0; i < 2; i++) \
      __builtin_amdgcn_global_load_lds((const unsigned*)(gb[i] + (kt_) * 32), (LAS unsigned*)(sm + (st_) * STB + ABYTES + (wu * 2 + i) * 1024), 16, 0, 0); }
#define WAIT_TILES(n_) { if ((n_) >= 3) WAIT_V(3 * LPT); else if ((n_) == 2) WAIT_V(2 * LPT); else if ((n_) == 1) WAIT_V(LPT); else WAIT_V(0); }
#define LDS_RD128(dst_, addr_) asm volatile("ds_read_b128 %0, %1" : "=v"(dst_) : "v"(addr_) : "memory")
#define RD_A(fa_, st_) { const unsigned ab_ = sbase + (st_) * STB + offA; \
    _Pragma("unroll") for (int i = 0; i < MI; i++) LDS_RD128(fa_[i], ab_ + i * 1024); }
#define RD_B(fb_, st_) { const unsigned bb_ = sbase + (st_) * STB + offB; \
    _Pragma("unroll") for (int i = 0; i < 4; i++) LDS_RD128(fb_[i], bb_ + i * 1024); }
#define DO_MFMA(fa_, fb_) { __builtin_amdgcn_s_setprio(1); \
    _Pragma("unroll") for (int i = 0; i < MI; i++) _Pragma("unroll") for (int j = 0; j < 4; j++) \
      acc[i][j] = __builtin_amdgcn_mfma_f32_16x16x32_bf16(__builtin_bit_cast(bf16x8, fb_[j]), __builtin_bit_cast(bf16x8, fa_[i]), acc[i][j], 0, 0, 0); \
    __builtin_amdgcn_s_setprio(0); }
#define KSTEP(fca_, fna_, kt_) { \
    RD_B(fb, st) \
    if ((kt_) + 1 < nkt) { \
      { const int rem_ = nkt - 2 - (kt_); WAIT_TILES(rem_ < NST - 2 ? rem_ : NST - 2) } \
      RAW_BARRIER(); \
      __builtin_amdgcn_sched_barrier(0); \
      if ((kt_) + NST < nkt) GSTAGE(st, (kt_) + NST) \
      st = (st + 1 == NST) ? 0 : st + 1; \
      RD_A(fna_, st) \
    } else { \
      WAIT_L(0); __builtin_amdgcn_sched_barrier(0); \
    } \
    DO_MFMA(fca_, fb) }
  __syncthreads();
#pragma unroll
  for (int s0 = 0; s0 < NST; s0++) if (s0 < nkt) GSTAGE(s0, s0)
  const int frow = lane & 15, fg = lane >> 4;
  const int fo = (frow * 4 + (fg ^ ((frow >> 2) & 3))) * 16;
  const int offA = (wm * MI * 16) * 64 + fo, offB = ABYTES + (wn * 64) * 64 + fo;
  int st = 0;
  const unsigned sbase = (unsigned)(unsigned long)sm;
  u32x4 fa0[MI], fa1[MI], fb[4];
  { const int rem_ = nkt - 1; WAIT_TILES(rem_ < NST - 1 ? rem_ : NST - 1) }
  RAW_BARRIER();
  __builtin_amdgcn_sched_barrier(0);
  RD_A(fa0, 0)
#pragma unroll 1
  for (int kt = 0; kt < nkt; kt += 2) {
    KSTEP(fa0, fa1, kt)
    KSTEP(fa1, fa0, kt + 1)
  }
  RAW_BARRIER();
}
#define ACC_ZERO(acc) { _Pragma("unroll") for (int i = 0; i < (int)(sizeof(acc) / sizeof(acc[0])); i++) _Pragma("unroll") for (int j = 0; j < 4; j++) acc[i][j] = (f32x4){0.f, 0.f, 0.f, 0.f}; }
#define EPI_LOOP(BODY) { constexpr int MI_ = (int)(sizeof(acc) / sizeof(acc[0])); const int lane_ = tidx() & 63, wave_ = tidx() >> 6, wm_ = wave_ >> 1, wn_ = wave_ & 1; \
  _Pragma("unroll") for (int i = 0; i < MI_; i++) { _Pragma("unroll") for (int j = 0; j < 4; j++) { \
    const int row = m0 + wm_ * (MI_ * 16) + i * 16 + (lane_ & 15); const int col = n0 + wn_ * 64 + j * 16 + (lane_ >> 4) * 4; const f32x4 v = acc[i][j]; BODY } \
    asm volatile("" ::: "memory"); } }
#define EPI_LOOP2(LOAD, STORE) { constexpr int MI_ = (int)(sizeof(acc) / sizeof(acc[0])); const int lane_ = tidx() & 63, wave_ = tidx() >> 6, wm_ = wave_ >> 1, wn_ = wave_ & 1; \
  _Pragma("unroll") for (int i = 0; i < MI_; i++) { f32x4 l0[4], l1[4]; \
    _Pragma("unroll") for (int j = 0; j < 4; j++) { \
      const int row = m0 + wm_ * (MI_ * 16) + i * 16 + (lane_ & 15); const int col = n0 + wn_ * 64 + j * 16 + (lane_ >> 4) * 4; LOAD } \
    asm volatile("" ::: "memory"); \
    _Pragma("unroll") for (int j = 0; j < 4; j++) { \
      const int row = m0 + wm_ * (MI_ * 16) + i * 16 + (lane_ & 15); const int col = n0 + wn_ * 64 + j * 16 + (lane_ >> 4) * 4; const f32x4 v = acc[i][j]; STORE } \
    asm volatile("" ::: "memory"); } }
#define COLJ(j) (n0 + ((tidx() >> 6) & 1) * 64 + (j) * 16 + ((tidx() & 63) >> 4) * 4)
__device__ __forceinline__ void ph_inproj(PP p, int layer, int seg, int bid, int nb, char* smem) {
  const u16* W = (const u16*)(p->ws + O_W) + WIN;
  const u16* H = (const u16*)(p->ws + O_H);
  u16* urw = (u16*)(p->ws + O_URW); u16* hq = (u16*)(p->ws + O_HQ); u16* hv = (u16*)(p->ws + O_HV); u16* hg = (u16*)(p->ws + ((seg & 1) ? O_HG2 : O_HG));
  float* hw = (float*)(p->ws + O_HW); u16* hk = (u16*)(p->ws + O_HK); u16* sz = (u16*)(p->ws + ((seg & 1) ? O_SZ2 : O_SZ)); u16* sxbc = (u16*)(p->ws + O_SXBC);
  float* sdt = (float*)(p->ws + O_SDT); u16* gates = (u16*)(p->ws + ((seg & 1) ? O_GATES2 : O_GATES));
  const float* lbl = p->in[14];
  const float* dtb = p->in[18] + layer * 32;
  for (int t = bid; t < 16 * 124; t += nb) {
    const int m0 = (t & 15) * 256, n0 = (t >> 4) * 128;
    f32x4 acc[8][4]; ACC_ZERO(acc);
    gemm_kloop(H + (size_t)m0 * 1024, 1024, W + (size_t)n0 * 1024, 1024, 32, acc, smem);
    if (n0 < 3456) {
      EPI_LOOP({ if (col < 3360) *(u32x2*)(urw + ((size_t)((row >> 9) * 513 + 1 + (row & 511))) * 3456 + col) = pack4v(v); })
    } else if (n0 < 7552) {
      const int which = (n0 - 3456) >> 10;
      if (which == 0) { EPI_LOOP({ int cc = (col - 3456) & 1023; *(u32x2*)(hq + (size_t)row * 1024 + cc) = pack4v(v * sigm4(v)); }) }
      else if (which == 1) {
        f32x4 lbj[4];
#pragma unroll
        for (int j = 0; j < 4; j++) {
          int cc = (COLJ(j) - 3456) & 1023;
          f32x4 l0 = *(const f32x4*)(lbl + cc), l1 = *(const f32x4*)(lbl + 1024 + cc);
#pragma unroll
          for (int e = 0; e < 4; e++) lbj[j][e] = layer == 0 ? 0.f : 1.f / (1.f + __expf(l0[e] - l1[e]));
        }
        EPI_LOOP({ int cc = (col - 3456) & 1023; const f32x4 lb = lbj[j];
                   f32x4 sg = sigm4(v); f32x4 w = lb + (1.f - lb) * sg; f32x4 lf;
                   lf[0] = fmaxf(__logf(w[0]), -60.f); lf[1] = fmaxf(__logf(w[1]), -60.f); lf[2] = fmaxf(__logf(w[2]), -60.f); lf[3] = fmaxf(__logf(w[3]), -60.f);
                   *(f32x4*)(hw + (size_t)row * 1024 + cc) = lf;
                   *(u32x2*)(hk + (size_t)row * 1024 + cc) = pack4v((1.f - lb) * (1.f - sg)); })
      } else if (which == 2) { EPI_LOOP({ int cc = (col - 3456) & 1023; *(u32x2*)(hv + (size_t)row * 1024 + cc) = pack4v(v); }) }
      else { EPI_LOOP({ int cc = (col - 3456) & 1023; *(u32x2*)(hg + (size_t)row * 1024 + cc) = pack4v(sigm4(v)); }) }
    } else if (n0 < 12800) {
      const int c0 = n0 - 7552;
      if (c0 < 2048) { EPI_LOOP({ int c = col - 7552; *(u32x2*)(sz + (size_t)row * 2048 + c) = pack4v(v * sigm4(v)); }) }
      else if (c0 < 5120) { EPI_LOOP({ int c = col - 7552 - 2048; *(u32x2*)(sxbc + ((size_t)((row >> 9) * 515 + 3 + (row & 511))) * 3072 + c) = pack4v(v); }) }
      else {
        f32x4 dbj[4];
#pragma unroll
        for (int j = 0; j < 4; j++) { int c = COLJ(j) - 7552 - 5120; dbj[j] = c < 32 ? *(const f32x4*)(dtb + c) : (f32x4){0.f, 0.f, 0.f, 0.f}; }
        EPI_LOOP({ int c = col - 7552 - 5120; if (c < 32) { f32x4 xx = v + dbj[j]; f32x4 o;
                   o[0] = xx[0] > 20.f ? xx[0] : log1pf(__expf(xx[0])); o[1] = xx[1] > 20.f ? xx[1] : log1pf(__expf(xx[1]));
                   o[2] = xx[2] > 20.f ? xx[2] : log1pf(__expf(xx[2])); o[3] = xx[3] > 20.f ? xx[3] : log1pf(__expf(xx[3]));
                   *(f32x4*)(sdt + (size_t)row * 32 + c) = o; } })
      }
    } else {
      EPI_LOOP({ int c = col - 12800; *(u32x2*)(gates + (size_t)row * 3072 + c) = pack4v(sigm4(v)); })
    }
  }
}

__device__ __forceinline__ void ph_elem(PP p, int layer, int seg, int bid, int nb) {
  const u16* urw = (const u16*)(p->ws + O_URW);
  const float* mu = p->in[3] + layer * 3360;
  u16* law = (u16*)(p->ws + O_LAW); u16* laa = (u16*)(p->ws + O_LAA); u16* lag = (u16*)(p->ws + O_LAG);
  const int gt = bid * NTHR + tidx(), gs = nb * NTHR;
#pragma unroll 1
  for (int idx = gt; idx < RS * 80; idx += gs) {
    const int r = idx / 80, gq = idx - r * 80;
    if (gq >= 72) { u32x2 z; z.x = 0; z.y = 0; *(u32x2*)(lag + (size_t)r * 192 + 160 + (gq - 72) * 4) = z; continue; }
    const int col = 3072 + gq * 4;
    const size_t ro = (size_t)((r >> 9) * 513 + 1 + (r & 511)) * 3456;
    f32x4 cur = cvt4(*(const u32x2*)(urw + ro + col)), prv = cvt4(*(const u32x2*)(urw + ro - 3456 + col));
    f32x4 m4 = *(const f32x4*)(mu + col);
    f32x4 val = cur + (prv - cur) * m4;
    if (gq < 16) *(u32x2*)(law + (size_t)r * 64 + gq * 4) = pack4(tanhf(val[0]), tanhf(val[1]), tanhf(val[2]), tanhf(val[3]));
    else if (gq < 32) *(u32x2*)(laa + (size_t)r * 64 + (gq - 16) * 4) = pack4(val[0], val[1], val[2], val[3]);
    else *(u32x2*)(lag + (size_t)r * 192 + (gq - 32) * 4) = pack4(sigm(val[0]), sigm(val[1]), sigm(val[2]), sigm(val[3]));
  }
  const u16* sxbc = (const u16*)(p->ws + O_SXBC); u16* sx2 = (u16*)(p->ws + ((seg & 1) ? O_SX22 : O_SX2));
  const float* cw = p->in[16] + (size_t)layer * 3072 * 4; const float* cb = p->in[17] + layer * 3072;
#pragma unroll 1
  for (int idx = gt; idx < (RS / 4) * 384; idx += gs) {
    const int rb = idx / 384, cg = idx - rb * 384, r = rb * 4, ch = cg * 8;
    const size_t ro = (size_t)((r >> 9) * 515 + (r & 511)) * 3072 + ch;
    u32x4 xin[7];
#pragma unroll
    for (int j = 0; j < 7; j++) xin[j] = *(const u32x4*)(sxbc + ro + (size_t)j * 3072);
    f32x4 w4[8];
#pragma unroll
    for (int c = 0; c < 8; c++) w4[c] = *(const f32x4*)(cw + (size_t)(ch + c) * 4);
    f32x4 b0 = *(const f32x4*)(cb + ch), b1 = *(const f32x4*)(cb + ch + 4);
#pragma unroll
    for (int rr = 0; rr < 4; rr++) {
      float o[8];
#pragma unroll
      for (int c = 0; c < 8; c++) {
        float acc = c < 4 ? b0[c] : b1[c - 4];
#pragma unroll
        for (int j = 0; j < 4; j++) {
          const unsigned wd = xin[rr + j][c >> 1];
          const float xv = (c & 1) ? __uint_as_float(wd & 0xffff0000u) : __uint_as_float(wd << 16);
          acc = fmaf(xv, w4[c][j], acc);
        }
        o[c] = acc * sigm(acc);
      }
      u32x4 ov; ov.x = pk2(o[0], o[1]); ov.y = pk2(o[2], o[3]); ov.z = pk2(o[4], o[5]); ov.w = pk2(o[6], o[7]);
      *(u32x4*)(sx2 + (size_t)(r + rr) * 3072 + ch) = ov;
    }
  }
}

__device__ __forceinline__ void ph_lora(PP p, int layer, int bid, int nb, char* smem) {
  const u16* W = (const u16*)(p->ws + O_W);
  float* rww = (float*)(p->ws + O_RWW); u16* rwa = (u16*)(p->ws + O_RWA); u16* rwg = (u16*)(p->ws + O_RWG);
  const float* w0 = p->in[4] + layer * 1024; const float* a0 = p->in[6] + layer * 1024;
  for (int t = bid; t < 3 * 256; t += nb) {
    const int job = t >> 8, tt = t & 255, m0 = (tt & 31) * 128, n0 = (tt >> 5) * 128;
    f32x4 acc[4][4]; ACC_ZERO(acc);
    if (job == 0) {
      gemm_kloop((const u16*)(p->ws + O_LAW) + (size_t)m0 * 64, 64, W + WWUP + (size_t)n0 * 64, 64, 2, acc, smem);
      f32x4 pj[4];
#pragma unroll
      for (int j = 0; j < 4; j++) pj[j] = *(const f32x4*)(w0 + COLJ(j));
      EPI_LOOP({ f32x4 sg = sigm4(pj[j] + v); f32x4 o; o[0] = __expf(-0.60653066f * sg[0]); o[1] = __expf(-0.60653066f * sg[1]); o[2] = __expf(-0.60653066f * sg[2]); o[3] = __expf(-0.60653066f * sg[3]);
                 *(f32x4*)(rww + (size_t)row * 1024 + col) = o; })
    } else if (job == 1) {
      gemm_kloop((const u16*)(p->ws + O_LAA) + (size_t)m0 * 64, 64, W + WAUP + (size_t)n0 * 64, 64, 2, acc, smem);
      f32x4 pj[4];
#pragma unroll
      for (int j = 0; j < 4; j++) pj[j] = *(const f32x4*)(a0 + COLJ(j));
      EPI_LOOP({ *(u32x2*)(rwa + (size_t)row * 1024 + col) = pack4v(sigm4(pj[j] + v)); })
    } else {
      gemm_kloop((const u16*)(p->ws + O_LAG) + (size_t)m0 * 192, 192, W + WGUP + (size_t)n0 * 192, 192, 6, acc, smem);
      EPI_LOOP({ *(u32x2*)(rwg + (size_t)row * 1024 + col) = pack4v(v); })
    }
  }
}

__device__ __forceinline__ void ph_rprep(PP p, int layer, int bid, int nb) {
  const u16* urw = (const u16*)(p->ws + O_URW); const u16* rwa = (const u16*)(p->ws + O_RWA);
  u16* pr = (u16*)(p->ws + O_PR); u16* pk = (u16*)(p->ws + O_PK); u16* pv = (u16*)(p->ws + O_PV);
  u16* pka = (u16*)(p->ws + O_PKA); u16* pkb = (u16*)(p->ws + O_PKB); float* bonus = (float*)(p->ws + O_BONUS);
  const float* mu = p->in[3] + layer * 3360; const float* kk_ = p->in[9] + layer * 1024; const float* ka_ = p->in[10] + layer * 1024;
  const float* rk_ = p->in[11] + layer * 1024;
  {
    u16* sxbc = (u16*)(p->ws + O_SXBC);
    const int gt = bid * NTHR + tidx(), gs = nb * NTHR;
    for (int idx = gt; idx < 8 * 3 * 3072; idx += gs) { int b = idx / 9216, c = idx - b * 9216; sxbc[(size_t)(b * 515) * 3072 + c] = sxbc[(size_t)(b * 515 + 512) * 3072 + c]; }
  }
  const int lane = tidx() & 63, wv = tidx() >> 6;
#pragma unroll 1
  for (int task = bid * 4 + wv; task < RS * 4; task += nb * 4) {
    const int r = task >> 2, col = (task & 3) * 256 + lane * 4;
    const size_t ro = (size_t)((r >> 9) * 513 + 1 + (r & 511)) * 3456 + col;
    f32x4 rc = cvt4(*(const u32x2*)(urw + ro)), rp = cvt4(*(const u32x2*)(urw + ro - 3456));
    f32x4 kc = cvt4(*(const u32x2*)(urw + ro + 1024)), kp = cvt4(*(const u32x2*)(urw + ro - 3456 + 1024));
    f32x4 vc = cvt4(*(const u32x2*)(urw + ro + 2048)), vp = cvt4(*(const u32x2*)(urw + ro - 3456 + 2048));
    f32x4 a = cvt4(*(const u32x2*)(rwa + (size_t)r * 1024 + col));
    f32x4 rr = rc + (rp - rc) * *(const f32x4*)(mu + col);
    f32x4 k = kc + (kp - kc) * *(const f32x4*)(mu + 1024 + col);
    f32x4 vv = vc + (vp - vc) * *(const f32x4*)(mu + 2048 + col);
    f32x4 kkv = k * *(const f32x4*)(kk_ + col);
    float n2 = red16(kkv[0] * kkv[0] + kkv[1] * kkv[1] + kkv[2] * kkv[2] + kkv[3] * kkv[3]);
    const float inv = 1.f / fmaxf(sqrtf(n2), 1e-12f);
    f32x4 kkn = kkv * inv;
    f32x4 kmod = k * (1.f + (a - 1.f) * *(const f32x4*)(ka_ + col));
    f32x4 bt = rr * kmod * *(const f32x4*)(rk_ + col);
    float bn = red16(bt[0] + bt[1] + bt[2] + bt[3]);
    const size_t o = (size_t)r * 1024 + col;
    *(u32x2*)(pr + o) = pack4(rr[0], rr[1], rr[2], rr[3]);
    *(u32x2*)(pk + o) = pack4(kmod[0], kmod[1], kmod[2], kmod[3]);
    *(u32x2*)(pv + o) = pack4(vv[0], vv[1], vv[2], vv[3]);
    *(u32x2*)(pka + o) = pack4(-kkn[0], -kkn[1], -kkn[2], -kkn[3]);
    *(u32x2*)(pkb + o) = pack4(kkn[0] * a[0], kkn[1] * a[1], kkn[2] * a[2], kkn[3] * a[3]);
    if ((lane & 15) == 0) bonus[r * 16 + (col >> 6)] = bn;
  }
}

struct ScanArgs {
  const u16 *pr, *pk, *pka, *pkb, *pv;
  const float *pw, *pvs;
  u16* po; float* state;
  int sr, sk, sab, sv, sw, svs, so;
};
#define TB 16
template <int KD, bool DELTA, bool WSCALAR, bool KFROMW, int LPR>
__device__ __forceinline__ void scan_task(const ScanArgs& a, bool first, bool save, char* smem) {
  constexpr int RB = 256 / LPR, GV = RB / 4; constexpr int KE = KD / LPR, NQ = KE / 4, NG = KD / 64, G4 = KD / 4;
  constexpr int OFF_R = 0, OFF_K = KD;
  constexpr int OFF_W = KFROMW ? KD : 2 * KD;
  constexpr int OFF_KA = OFF_W + (WSCALAR ? 0 : KD);
  constexpr int OFF_KB = OFF_KA + (DELTA ? KD : 0);
  constexpr int OFF_V = OFF_KB + (DELTA ? KD : 0);
  constexpr int OFF_S = OFF_V + RB;
  constexpr int STR = OFF_S + 4;
  float* buf0 = (float*)smem; float* buf1 = buf0 + TB * STR; float* obuf = buf1 + TB * STR;
  const int tid = tidx(), ks = tid & (LPR - 1), vr = tid / LPR;
  u32x2 gr[NG], gk[NG], gka[NG], gkb[NG], gv; f32x4 gw[NG]; float gsw = 0.f, gsv = 0.f;
  gv.x = gv.y = 0;
#define LOAD_BLK(blk_) { \
    const int row = (blk_) * TB; \
    _Pragma("unroll") for (int i = 0; i < NG; i++) { \
      const int g = tid + 256 * i, step = g / G4, e4 = g % G4; \
      gr[i] = *(const u32x2*)(a.pr + (size_t)(row + step) * a.sr + e4 * 4); \
      if (!KFROMW) gk[i] = *(const u32x2*)(a.pk + (size_t)(row + step) * a.sk + e4 * 4); \
      if (!WSCALAR) gw[i] = *(const f32x4*)(a.pw + (size_t)(row + step) * a.sw + e4 * 4); \
      if (DELTA) { gka[i] = *(const u32x2*)(a.pka + (size_t)(row + step) * a.sab + e4 * 4); gkb[i] = *(const u32x2*)(a.pkb + (size_t)(row + step) * a.sab + e4 * 4); } \
    } \
    if (tid < TB * GV) { const int step = tid / GV, e4 = tid % GV; gv = *(const u32x2*)(a.pv + (size_t)(row + step) * a.sv + e4 * 4); } \
    if (WSCALAR && tid < TB) { gsw = a.pw[(size_t)(row + tid) * a.sw]; gsv = a.pvs[(size_t)(row + tid) * a.svs]; } }
#define STORE_BLK(buf_) { \
    float* bufp = (buf_); \
    _Pragma("unroll") for (int i = 0; i < NG; i++) { \
      const int g = tid + 256 * i, step = g / G4, e4 = g % G4; \
      float* d = bufp + step * STR + e4 * 4; \
      *(f32x4*)(d + OFF_R) = cvt4(gr[i]); \
      if (!KFROMW) *(f32x4*)(d + OFF_K) = cvt4(gk[i]); \
      if (!WSCALAR) *(f32x4*)(d + OFF_W) = gw[i]; \
      if (DELTA) { *(f32x4*)(d + OFF_KA) = cvt4(gka[i]); *(f32x4*)(d + OFF_KB) = cvt4(gkb[i]); } \
    } \
    if (tid < TB * GV) { const int step = tid / GV, e4 = tid % GV; *(f32x4*)(bufp + step * STR + OFF_V + e4 * 4) = cvt4(gv); } \
    if (WSCALAR && tid < TB) { bufp[tid * STR + OFF_S] = gsw; bufp[tid * STR + OFF_S + 1] = gsv; } }
  float S[KE];
  if (first) {
#pragma unroll
    for (int e = 0; e < KE; e++) S[e] = 0.f;
  } else {
#pragma unroll
    for (int q = 0; q < NQ; q++) { float4 t = *(const float4*)(a.state + (size_t)vr * KD + q * (LPR * 4) + ks * 4); S[q * 4] = t.x; S[q * 4 + 1] = t.y; S[q * 4 + 2] = t.z; S[q * 4 + 3] = t.w; }
  }
  LOAD_BLK(0)
  __syncthreads();
  STORE_BLK(buf0)
  __syncthreads();
  constexpr int NBLK = SL / TB;
  for (int blk = 0; blk < NBLK; blk++) {
    float* buf = (blk & 1) ? buf1 : buf0;
    if (blk + 1 < NBLK) LOAD_BLK(blk + 1)
    {
      float rv1[KE], kb1[KE], kv[2][KE], wv[2][KE], kav[2][KE], vtv[2], wsv[2], vsv[2];
#define LD_STEP(slot, st_) { const float* sp = buf + (st_) * STR; \
        _Pragma("unroll") for (int q = 0; q < NQ; q++) { \
          if (!WSCALAR) { f32x4 u = *(const f32x4*)(sp + OFF_W + q * (LPR * 4) + ks * 4); wv[slot][q * 4] = u[0]; wv[slot][q * 4 + 1] = u[1]; wv[slot][q * 4 + 2] = u[2]; wv[slot][q * 4 + 3] = u[3]; } \
          if (!KFROMW) { f32x4 u = *(const f32x4*)(sp + OFF_K + q * (LPR * 4) + ks * 4); kv[slot][q * 4] = u[0]; kv[slot][q * 4 + 1] = u[1]; kv[slot][q * 4 + 2] = u[2]; kv[slot][q * 4 + 3] = u[3]; } \
          if (DELTA) { f32x4 u = *(const f32x4*)(sp + OFF_KA + q * (LPR * 4) + ks * 4); kav[slot][q * 4] = u[0]; kav[slot][q * 4 + 1] = u[1]; kav[slot][q * 4 + 2] = u[2]; kav[slot][q * 4 + 3] = u[3]; \
                     } \
        } \
        vtv[slot] = sp[OFF_V + vr]; \
        if (WSCALAR) { wsv[slot] = sp[OFF_S]; vsv[slot] = sp[OFF_S + 1]; } }
      LD_STEP(0, 0)
#define DO_STEP(cs, step_) { \
        { const float* spr = buf + (step_) * STR; _Pragma("unroll") for (int q = 0; q < NQ; q++) { f32x4 t = *(const f32x4*)(spr + OFF_R + q * (LPR * 4) + ks * 4); rv1[q * 4] = t[0]; rv1[q * 4 + 1] = t[1]; rv1[q * 4 + 2] = t[2]; rv1[q * 4 + 3] = t[3]; \
            if (DELTA) { f32x4 x = *(const f32x4*)(spr + OFF_KB + q * (LPR * 4) + ks * 4); kb1[q * 4] = x[0]; kb1[q * 4 + 1] = x[1]; kb1[q * 4 + 2] = x[2]; kb1[q * 4 + 3] = x[3]; } } } \
        float vt = vtv[cs]; \
        if (WSCALAR) vt *= vsv[cs]; \
        if (DELTA) { \
          float sa0 = 0.f, sa1 = 0.f, sa2 = 0.f, sa3 = 0.f; \
          _Pragma("unroll") for (int e = 0; e < KE; e += 2) { sa0 = fmaf(S[e], kav[cs][e], sa0); sa1 = fmaf(S[e + 1], kav[cs][e + 1], sa1); } \
          _Pragma("unroll") for (int e = 0; e < KE; e++) S[e] = fmaf(S[e], wv[cs][e], vt * kv[cs][e]); \
          float sa = (LPR == 8) ? red8((sa0 + sa1) + (sa2 + sa3)) : red4((sa0 + sa1) + (sa2 + sa3)); \
          _Pragma("unroll") for (int e = 0; e < KE; e++) S[e] = fmaf(sa, kb1[e], S[e]); \
        } else { \
          _Pragma("unroll") for (int e = 0; e < KE; e++) { \
            float w = WSCALAR ? wsv[cs] : wv[cs][e]; \
            float k = KFROMW ? (1.f - wv[cs][e]) : kv[cs][e]; \
            S[e] = fmaf(S[e], w, vt * k); } \
        } \
        float o0 = 0.f, o1 = 0.f, o2 = 0.f, o3 = 0.f; \
        _Pragma("unroll") for (int e = 0; e < KE; e += 2) { o0 = fmaf(S[e], rv1[e], o0); o1 = fmaf(S[e + 1], rv1[e + 1], o1); } \
        float o = (LPR == 8) ? red8((o0 + o1) + (o2 + o3)) : red4((o0 + o1) + (o2 + o3)); \
        if (ks == 0) obuf[(step_) * RB + vr] = o; }
#pragma unroll 1
      for (int step = 0; step < TB; step += 2) {
        LD_STEP(1, step + 1)
        DO_STEP(0, step)
        if (step + 2 < TB) LD_STEP(0, step + 2)
        DO_STEP(1, step + 1)
      }
    }
    __syncthreads();
    {
      const int row = blk * TB;
#pragma unroll
      for (int i = 0; i < TB * RB / 512; i++) { const int idx = (tid + 256 * i) * 2, step = idx / RB, v2 = idx % RB; *(unsigned*)(a.po + (size_t)(row + step) * a.so + v2) = pk2(obuf[idx], obuf[idx + 1]); }
    }
    if (blk + 1 < NBLK) STORE_BLK((blk & 1) ? buf0 : buf1)
    __syncthreads();
  }
  if (save)
#pragma unroll
  for (int q = 0; q < NQ; q++) { float4 t; t.x = S[q * 4]; t.y = S[q * 4 + 1]; t.z = S[q * 4 + 2]; t.w = S[q * 4 + 3]; *(float4*)(a.state + (size_t)vr * KD + q * (LPR * 4) + ks * 4) = t; }
}


struct ChunkArgs { const u16 *q, *k, *v; const float* lf; u16* o; float* state; int ld, ldlf; float expA; };
#define QLD 136
#define KHLD 72
template <bool SSM>
__device__ __forceinline__ void chunk_task(const ChunkArgs& a, bool first, bool save, char* smem) {
  u16* QT = (u16*)smem;
  u16* KT = QT + 64 * QLD;
  u16* KH = KT + 64 * QLD;
  u16* VT = KH + 128 * KHLD;
  u16* ST = VT + 32 * KHLD;
  float* gam = (float*)(ST + 32 * QLD); float* em = gam + 128; float* cum = gam + 256; float* dts = gam + 512;
  const int tid = tidx(), lane = tid & 63, g = lane >> 4, c = lane & 15;
  const int w = __builtin_amdgcn_readfirstlane(tid >> 6);
  f32x4 accS[2][2];
#pragma unroll
  for (int i = 0; i < 2; i++)
#pragma unroll
    for (int j = 0; j < 2; j++)
      accS[i][j] = first ? (f32x4){0.f, 0.f, 0.f, 0.f} : *(const f32x4*)(a.state + (size_t)((i * 2 + j) * 256 + tid) * 4);
  float rcn[32]; u16 qan[32], kan[32]; u32x4 cqn[4], ckn[4], vvn; float dtn = 0.f;
#define CH_PREFETCH(chn_) { const int rp = (chn_) * 64; \
    if (!SSM) { const int d = tid & 127, half = tid >> 7; \
      const float* lfp = a.lf + (size_t)(rp + half * 32) * a.ldlf + d; \
      const u16* qp = a.q + (size_t)(rp + half * 32) * a.ld + d; const u16* kp = a.k + (size_t)(rp + half * 32) * a.ld + d; \
      _Pragma("unroll") for (int i = 0; i < 32; i++) rcn[i] = lfp[(size_t)i * a.ldlf]; \
      _Pragma("unroll") for (int i = 0; i < 32; i++) { qan[i] = qp[(size_t)i * a.ld]; kan[i] = kp[(size_t)i * a.ld]; } \
    } else { \
      _Pragma("unroll") for (int i = 0; i < 4; i++) { const int id = tid + 256 * i, s = id >> 4, cc = id & 15; \
        cqn[i] = *(const u32x4*)(a.q + (size_t)(rp + s) * a.ld + cc * 8); ckn[i] = *(const u32x4*)(a.k + (size_t)(rp + s) * a.ld + cc * 8); } \
      if (tid < 64) dtn = a.lf[(size_t)(rp + tid) * a.ldlf]; \
    } \
    { const int s = tid & 63, vg = tid >> 6; vvn = *(const u32x4*)(a.v + (size_t)(rp + s) * a.ld + vg * 8); } }
  CH_PREFETCH(0)
#pragma unroll 1
  for (int ch = 0; ch < SL / 64; ch++) {
    const int r0 = ch * 64;
    float rc[32]; float kf[32]; float rc63 = 0.f;
    if (!SSM) {
      const int d = tid & 127, half = tid >> 7;
#pragma unroll
      for (int i = 0; i < 32; i++) rc[i] = rcn[i];
      float tot = 0.f;
      if (half == 0) {
        float acc = 0.f;
#pragma unroll
        for (int i = 31; i >= 0; i--) { float l = rc[i]; tot += l; rc[i] = acc; acc -= l; }
        em[d] = __expf(tot);
      } else {
        float acc = 0.f;
#pragma unroll
        for (int i = 0; i < 32; i++) { acc += rc[i]; rc[i] = acc; }
        tot = acc;
      }
      cum[half * 128 + d] = tot;
#pragma unroll
      for (int i = 0; i < 32; i++) {
        const int s = half * 32 + i;
        float qv = bf2f(qan[i]); kf[i] = bf2f(kan[i]);
        float r = rc[i];
        QT[s * QLD + d] = f2bf(qv * __expf(fminf(r, 80.f)));
        KT[s * QLD + d] = f2bf(kf[i] * __expf(fminf(-r, 80.f)));
      }
    } else {
#pragma unroll
      for (int i = 0; i < 4; i++) {
        const int id = tid + 256 * i, s = id >> 4, cc = id & 15;
        *(u32x4*)(QT + s * QLD + cc * 8) = cqn[i];
        *(u32x4*)(KT + s * QLD + cc * 8) = ckn[i];
      }
      if (tid < 64) {
        float dtv = dtn;
        float x = -dtv * a.expA;
#pragma unroll
        for (int o = 1; o < 64; o <<= 1) { float y = __shfl_up(x, o); if (lane >= o) x += y; }
        cum[tid] = x; dts[tid] = dtv;
      }
    }
    {
      const int s = tid & 63, vg = tid >> 6;
      u32x4 vv = vvn;
#pragma unroll
      for (int j = 0; j < 4; j++) { VT[(vg * 8 + 2 * j) * KHLD + s] = (u16)(vv[j] & 0xffffu); VT[(vg * 8 + 2 * j + 1) * KHLD + s] = (u16)(vv[j] >> 16); }
    }
    __syncthreads();
#pragma unroll
    for (int dt2 = 0; dt2 < 2; dt2++) {
      const int d0 = (2 * w + dt2) * 16 + 4 * g;
      f32x4 e4 = (f32x4){1.f, 1.f, 1.f, 1.f};
      if (!SSM) e4 = *(const f32x4*)(em + d0);
#pragma unroll
      for (int vt = 0; vt < 2; vt++) {
        f32x4 sv = accS[dt2][vt] * e4;
        u32x2 pk; pk.x = pk2(sv[0], sv[1]); pk.y = pk2(sv[2], sv[3]);
        *(u32x2*)(ST + (16 * vt + c) * QLD + d0) = pk;
      }
    }
    if (!SSM) {
      const int d = tid & 127, half = tid >> 7;
      const float t0 = cum[d], t1 = cum[128 + d];
      rc63 = t1;
      if (half == 0) gam[d] = __expf(t0 + t1);
#pragma unroll
      for (int i = 0; i < 32; i++) KH[d * KHLD + half * 32 + i] = f2bf(kf[i] * __expf(rc63 - rc[i]));
    }
    if (SSM) {
      const int s = tid & 63, ng = tid >> 6;
      const float sc = __expf(cum[63] - cum[s]) * dts[s];
#pragma unroll
      for (int i = 0; i < 4; i++) {
        u32x4 kk = *(const u32x4*)(KT + s * QLD + ng * 32 + i * 8);
#pragma unroll
        for (int j = 0; j < 4; j++) {
          const int n = ng * 32 + i * 8 + 2 * j;
          KH[n * KHLD + s] = f2bf(__uint_as_float(kk[j] << 16) * sc);
          KH[(n + 1) * KHLD + s] = f2bf(__uint_as_float(kk[j] & 0xffff0000u) * sc);
        }
      }
    }
    __syncthreads();
    if (ch + 1 < SL / 64) CH_PREFETCH(ch + 1)
    {
      const int t = 16 * w + c;
      bf16x8 bq[4];
#pragma unroll
      for (int ks = 0; ks < 4; ks++) bq[ks] = *(const bf16x8*)(QT + t * QLD + ks * 32 + g * 8);
      f32x4 accp[4];
#pragma unroll
      for (int st = 0; st < 4; st++) {
        accp[st] = (f32x4){0.f, 0.f, 0.f, 0.f};
        if (st <= w) {
#pragma unroll
          for (int ks = 0; ks < 4; ks++) {
            bf16x8 ak = *(const bf16x8*)(KT + (16 * st + c) * QLD + ks * 32 + g * 8);
            accp[st] = __builtin_amdgcn_mfma_f32_16x16x32_bf16(ak, bq[ks], accp[st], 0, 0, 0);
          }
        }
      }
      float cumt = 0.f;
      if (SSM) cumt = cum[t];
#pragma unroll
      for (int st = 0; st < 4; st++)
#pragma unroll
        for (int r = 0; r < 4; r++) {
          const int s = 16 * st + 4 * g + r;
          float v = accp[st][r];
          if (SSM) v *= __expf(fminf(cumt - cum[s], 0.f)) * dts[s];
          accp[st][r] = (s <= t) ? v : 0.f;
        }
      bf16x8 bp[2];
#pragma unroll
      for (int a2 = 0; a2 < 2; a2++)
#pragma unroll
        for (int j = 0; j < 4; j++) { bp[a2][j] = (short)f2bf(accp[2 * a2][j]); bp[a2][4 + j] = (short)f2bf(accp[2 * a2 + 1][j]); }
      f32x4 acco[2], acco2[2];
#pragma unroll
      for (int vt = 0; vt < 2; vt++) {
        acco[vt] = (f32x4){0.f, 0.f, 0.f, 0.f}; acco2[vt] = (f32x4){0.f, 0.f, 0.f, 0.f};
#pragma unroll
        for (int a2 = 0; a2 < 2; a2++) {
          if (2 * a2 <= w) {
            const u16* vp = VT + (16 * vt + c) * KHLD + 32 * a2 + 4 * g;
            u32x2 lo = *(const u32x2*)vp, hi = *(const u32x2*)(vp + 16);
            u32x4 cmb; cmb.x = lo.x; cmb.y = lo.y; cmb.z = hi.x; cmb.w = hi.y;
            bf16x8 av = __builtin_bit_cast(bf16x8, cmb);
            acco[vt] = __builtin_amdgcn_mfma_f32_16x16x32_bf16(av, bp[a2], acco[vt], 0, 0, 0);
          }
        }
#pragma unroll
        for (int ks = 0; ks < 4; ks++) {
          bf16x8 as = *(const bf16x8*)(ST + (16 * vt + c) * QLD + ks * 32 + g * 8);
          if (SSM) acco2[vt] = __builtin_amdgcn_mfma_f32_16x16x32_bf16(as, bq[ks], acco2[vt], 0, 0, 0);
          else acco[vt] = __builtin_amdgcn_mfma_f32_16x16x32_bf16(as, bq[ks], acco[vt], 0, 0, 0);
        }
        f32x4 ov = acco[vt];
        if (SSM) ov += __expf(cumt) * acco2[vt];
        *(u32x2*)(a.o + (size_t)(r0 + t) * 4096 + 16 * vt + 4 * g) = pack4v(ov);
      }
#pragma unroll
      for (int dt2 = 0; dt2 < 2; dt2++) {
        const int d0 = (2 * w + dt2) * 16;
        f32x4 gm;
        if (SSM) { float gs = __expf(cum[63]); gm = (f32x4){gs, gs, gs, gs}; }
        else gm = *(const f32x4*)(gam + d0 + 4 * g);
#pragma unroll
        for (int vt = 0; vt < 2; vt++) accS[dt2][vt] *= gm;
#pragma unroll
        for (int a2 = 0; a2 < 2; a2++) {
          bf16x8 ak = *(const bf16x8*)(KH + (d0 + c) * KHLD + 32 * a2 + 8 * g);
#pragma unroll
          for (int vt = 0; vt < 2; vt++) {
            bf16x8 bv = *(const bf16x8*)(VT + (16 * vt + c) * KHLD + 32 * a2 + 8 * g);
            accS[dt2][vt] = __builtin_amdgcn_mfma_f32_16x16x32_bf16(ak, bv, accS[dt2][vt], 0, 0, 0);
          }
        }
      }
    }
    __syncthreads();
  }
  if (save)
#pragma unroll
  for (int i = 0; i < 2; i++)
#pragma unroll
    for (int j = 0; j < 2; j++) *(f32x4*)(a.state + (size_t)((i * 2 + j) * 256 + tid) * 4) = accS[i][j];
}

__device__ __forceinline__ void chunk_dispatch(PP p, int layer, int seg, int ct, bool first, bool save, char* smem) {
  u16* so = (u16*)(p->ws + O_SO);
  ChunkArgs a;
  if (ct < 256) {
    const int vs = ct & 3, h = (ct >> 2) & 7, b = ct >> 5;
    const size_t ro = (size_t)b * SL * 1024 + h * 128;
    a.q = (const u16*)(p->ws + O_HQ) + ro; a.k = (const u16*)(p->ws + O_HK) + ro; a.v = (const u16*)(p->ws + O_HV) + ro + vs * 32;
    a.lf = (const float*)(p->ws + O_HW) + ro; a.o = so + (size_t)b * SL * 4096 + 1024 + h * 128 + vs * 32;
    a.state = (float*)(p->ws + O_STHG) + (size_t)ct * 4096; a.ld = 1024; a.ldlf = 1024; a.expA = 0.f;
    chunk_task<false>(a, first, save, smem);
  } else {
    const int t2 = ct - 256, vs = t2 & 1, hd = (t2 >> 1) & 31, b = t2 >> 6, g = hd >> 3;
    const u16* x2 = (const u16*)(p->ws + ((seg & 1) ? O_SX22 : O_SX2)) + (size_t)b * SL * 3072;
    a.q = x2 + 2560 + g * 128; a.k = x2 + 2048 + g * 128; a.v = x2 + hd * 64 + vs * 32;
    a.lf = (const float*)(p->ws + O_SDT) + (size_t)b * SL * 32 + hd; a.o = so + (size_t)b * SL * 4096 + 2048 + hd * 64 + vs * 32;
    a.state = (float*)(p->ws + O_STSS) + (size_t)t2 * 4096; a.ld = 3072; a.ldlf = 32; a.expA = __expf(p->in[19][layer * 32 + hd]);
    chunk_task<true>(a, first, save, smem);
  }
}
__device__ __forceinline__ void rwkv_dispatch(PP p, int task, bool first, bool save, char* smem) {
  u16* so = (u16*)(p->ws + O_SO);
  ScanArgs a;
  const int h = task & 15, b = task >> 4;
  const size_t ro = (size_t)b * SL * 1024 + h * 64;
  a.pr = (const u16*)(p->ws + O_PR) + ro; a.pk = (const u16*)(p->ws + O_PK) + ro; a.pka = (const u16*)(p->ws + O_PKA) + ro; a.pkb = (const u16*)(p->ws + O_PKB) + ro;
  a.pv = (const u16*)(p->ws + O_PV) + ro; a.pw = (const float*)(p->ws + O_RWW) + ro; a.pvs = nullptr;
  a.po = so + (size_t)b * SL * 4096 + h * 64; a.state = (float*)(p->ws + O_STRW) + (size_t)(b * 16 + h) * 4096;
  a.sr = a.sk = a.sab = a.sv = a.sw = 1024; a.svs = 0; a.so = 4096;
  __builtin_amdgcn_s_setprio(3);
  scan_task<64, true, false, false, 4>(a, first, save, smem);
  __builtin_amdgcn_s_setprio(0);
}
template <int BR> __device__ __forceinline__ void merge_tile(PP p, int layer, int seg, int t, char* smem);
__device__ __forceinline__ void merge_item(PP p, int layer, int seg, int t, char* smem);
__device__ __forceinline__ void ph_scan(PP p, int layer, int seg, int bid, int nb, char* smem, volatile LAS unsigned* bw) {
  const bool first = (seg == 0);
  unsigned* ctr = (unsigned*)(p->ws + O_BAR) + 3520;
  const unsigned base = (unsigned)(layer * NSEG + seg) * (unsigned)(1024 + nb);
  {
    u16* urw = (u16*)(p->ws + O_URW);
    const int gt = bid * NTHR + tidx(), gs = nb * NTHR;
    for (int idx = gt; idx < 8 * 3456; idx += gs) { int b = idx / 3456, c = idx - b * 3456; urw[(size_t)(b * 513) * 3456 + c] = urw[(size_t)(b * 513 + 512) * 3456 + c]; }
  }
  if (bid < 128) { rwkv_dispatch(p, bid, first, true, smem); __syncthreads(); }
#pragma unroll 1
  for (;;) {
    if (tidx() == 0) *bw = __hip_atomic_fetch_add(ctr, 1u, __ATOMIC_RELAXED, __HIP_MEMORY_SCOPE_AGENT);
    __syncthreads();
    const unsigned it = *bw - base;
    __syncthreads();
    if (it >= 1024u) break;
    if (it < 256u) { if (seg > 0) merge_item(p, layer, seg - 1, (int)it, smem); }
    else chunk_dispatch(p, layer, seg, (int)it - 256, first, true, smem);
    __syncthreads();
  }
}

__device__ __forceinline__ void ph_post(PP p, int layer, int seg, int bid, int nb) {
  const u16* so = (const u16*)(p->ws + O_SO); u16* y = (u16*)(p->ws + O_Y);
  const int lane = tidx() & 63, wv = tidx() >> 6;
  const u16* pv = (const u16*)(p->ws + O_PV); const u16* rwg = (const u16*)(p->ws + O_RWG); const float* bonus = (const float*)(p->ws + O_BONUS);
  const float* gnw = p->in[12] + layer * 1024; const float* gnb = p->in[13] + layer * 1024;
  const u16* hg = (const u16*)(p->ws + ((seg & 1) ? O_HG2 : O_HG)); const float* hgn = p->in[15] + layer * 1024;
  const u16* sx2 = (const u16*)(p->ws + ((seg & 1) ? O_SX22 : O_SX2)); const u16* sz = (const u16*)(p->ws + ((seg & 1) ? O_SZ2 : O_SZ));
  const float* dsk = p->in[20] + layer * 32; const float* sgn = p->in[21] + layer * 2048;
#pragma unroll 1
  for (int task = bid * 4 + wv; task < RS * 12; task += nb * 4) {
    const int r = task / 12, s = task - r * 12;
    if (s < 4) {
      const int col = s * 256 + lane * 4;
      f32x4 o = cvt4(*(const u32x2*)(so + (size_t)r * 4096 + col));
      const float mean = red16(o[0] + o[1] + o[2] + o[3]) * (1.f / 64.f);
      f32x4 d = o - mean;
      const float var = red16(d[0] * d[0] + d[1] * d[1] + d[2] * d[2] + d[3] * d[3]) * (1.f / 64.f);
      f32x4 on = d * rsqrtf(var + 64e-5f) * *(const f32x4*)(gnw + col) + *(const f32x4*)(gnb + col);
      on += bonus[r * 16 + (col >> 6)] * cvt4(*(const u32x2*)(pv + (size_t)r * 1024 + col));
      on *= cvt4(*(const u32x2*)(rwg + (size_t)r * 1024 + col));
      *(u32x2*)(y + (size_t)r * 4096 + col) = pack4(on[0], on[1], on[2], on[3]);
    } else if (s < 8) {
      const int c = (s - 4) * 256 + lane * 4;
      f32x4 o = cvt4(*(const u32x2*)(so + (size_t)r * 4096 + 1024 + c));
      float ss = red16(o[0] * o[0] + o[1] * o[1] + o[2] * o[2] + o[3] * o[3]);
      ss += __shfl_xor(ss, 16);
      const float rstd = rsqrtf(ss * (1.f / 128.f) + 1e-5f);
      f32x4 on = o * rstd * *(const f32x4*)(hgn + c) * cvt4(*(const u32x2*)(hg + (size_t)r * 1024 + c));
      *(u32x2*)(y + (size_t)r * 4096 + 1024 + c) = pack4(on[0], on[1], on[2], on[3]);
    } else {
      const int g = s - 8, ch = g * 512 + lane * 8;
      const u32x4 orw = *(const u32x4*)(so + (size_t)r * 4096 + 2048 + ch);
      u32x2 oa; oa.x = orw.x; oa.y = orw.y; u32x2 ob; ob.x = orw.z; ob.y = orw.w;
      f32x4 o0 = cvt4(oa), o1 = cvt4(ob);
      u32x4 xr = *(const u32x4*)(sx2 + (size_t)r * 3072 + ch), zr = *(const u32x4*)(sz + (size_t)r * 2048 + ch);
      u32x2 t0; t0.x = xr.x; t0.y = xr.y; u32x2 t1; t1.x = xr.z; t1.y = xr.w;
      u32x2 z0; z0.x = zr.x; z0.y = zr.y; u32x2 z1; z1.x = zr.z; z1.y = zr.w;
      const float dk = dsk[ch >> 6];
      f32x4 y0 = (o0 + dk * cvt4(t0)) * cvt4(z0), y1 = (o1 + dk * cvt4(t1)) * cvt4(z1);
      float ss = y0[0] * y0[0] + y0[1] * y0[1] + y0[2] * y0[2] + y0[3] * y0[3] + y1[0] * y1[0] + y1[1] * y1[1] + y1[2] * y1[2] + y1[3] * y1[3];
      ss = red16(ss); ss += __shfl_xor(ss, 16); ss += __shfl_xor(ss, 32);
      const float rstd = rsqrtf(ss * (1.f / 512.f) + 1e-5f);
      y0 = y0 * rstd * *(const f32x4*)(sgn + ch); y1 = y1 * rstd * *(const f32x4*)(sgn + ch + 4);
      u32x4 ov; ov.x = pk2(y0[0], y0[1]); ov.y = pk2(y0[2], y0[3]); ov.z = pk2(y1[0], y1[1]); ov.w = pk2(y1[2], y1[3]);
      *(u32x4*)(y + (size_t)r * 4096 + 2048 + ch) = ov;
    }
  }
}

#define MT_ROW(row) ((size_t)(((row) >> 9) * 515 + 3 + ((row) & 511)) * 1536)
template <int BR>
__device__ __forceinline__ void merge_tile(PP p, int layer, int seg, int t, char* smem) {
  const u16* W = (const u16*)(p->ws + O_W) + WBR;
  const u16* Y = (const u16*)(p->ws + O_Y); const u16* gp = (const u16*)(p->ws + ((seg & 1) ? O_GATES2 : O_GATES)) + BR * 1024; u16* mg = (u16*)(p->ws + O_MERGED);
  float* mt = (float*)(p->ws + O_SXBC);
  constexpr int k0 = BR * 1024, nkt = BR == 2 ? 64 : 32;
  const int m0 = (t & 31) * 128, n0 = (t >> 5) * 128;
  f32x4 acc[4][4]; ACC_ZERO(acc);
  gemm_kloop(Y + (size_t)m0 * 4096 + k0, 4096, W + (size_t)n0 * 4096 + k0, 4096, nkt, acc, smem);
  EPI_LOOP2({ l0[j] = cvt4(*(const u32x2*)(gp + (size_t)row * 3072 + col)); if (BR > 0) l1[j] = *(const f32x4*)(mt + MT_ROW(row) + col); else l1[j] = f4z(); },
            { const f32x4 gsum = l1[j] + l0[j] * v; if (BR < 2) *(f32x4*)(mt + MT_ROW(row) + col) = gsum; else *(u32x2*)(mg + (size_t)row * 1024 + col) = pack4v(gsum); })
}
__device__ __forceinline__ void merge_item(PP p, int layer, int seg, int t, char* smem) {
  merge_tile<0>(p, layer, seg, t, smem);
  merge_tile<1>(p, layer, seg, t, smem);
  merge_tile<2>(p, layer, seg, t, smem);
}
__device__ __forceinline__ void ph_merge(PP p, int layer, int seg, int bid, int nb, char* smem) {
#pragma unroll 1
  for (int t = bid; t < 256; t += nb) merge_item(p, layer, seg, t, smem);
}
__device__ __forceinline__ void ph_out(PP p, int layer, int seg, int bid, int nb, char* smem) {
  const u16* W = (const u16*)(p->ws + O_W) + WOUT;
  const u16* mg = (const u16*)(p->ws + O_MERGED);
  const float* xs = layer == 0 ? p->in[0] : p->out;
  for (int t = bid; t < 256; t += nb) {
    const int m0 = (t & 31) * 128, n0 = (t >> 5) * 128;
    f32x4 acc[4][4]; ACC_ZERO(acc);
    gemm_kloop(mg + (size_t)m0 * 1024, 1024, W + (size_t)n0 * 1024, 1024, 32, acc, smem);
    EPI_LOOP2({ size_t gr = (size_t)(row >> 9) * SEQ + seg * SL + (row & 511); l0[j] = *(const f32x4*)(xs + gr * 1024 + col); },
              { size_t gr = (size_t)(row >> 9) * SEQ + seg * SL + (row & 511); *(f32x4*)(p->out + gr * 1024 + col) = l0[j] + v; })
  }
}
__device__ __forceinline__ void ph_ffi(PP p, int layer, int bid, int nb, char* smem) {
  const u16* W = (const u16*)(p->ws + O_W) + WFFI;
  const u16* H2 = (const u16*)(p->ws + O_H2); u16* hid = (u16*)(p->ws + O_HID);
  for (int t = bid; t < 128 * 44; t += nb) {
    const int m0 = (t & 127) * 256, n0 = (t >> 7) * 128;
    f32x4 acc[8][4]; ACC_ZERO(acc);
    gemm_kloop(H2 + (size_t)m0 * 1024, 1024, W + (size_t)n0 * 1024, 1024, 32, acc, smem);
    const int lane = tidx() & 63, wave = tidx() >> 6, wm = wave >> 1, wn = wave & 1;
#pragma unroll
    for (int i = 0; i < 8; i++)
#pragma unroll
      for (int j = 0; j < 4; j += 2) {
        const int row = m0 + wm * 128 + i * 16 + (lane & 15);
        const int ng = n0 + wn * 64 + j * 16 + (lane >> 4) * 4;
        const int hc = (ng >> 5) * 16 + (ng & 15);
        const f32x4 g = acc[i][j], u = acc[i][j + 1];
        *(u32x2*)(hid + (size_t)row * 2816 + hc) = pack4v(g * sigm4(g) * u);
      }
  }
}
__device__ __forceinline__ void ph_ffo(PP p, int layer, int bid, int nb, char* smem) {
  const u16* W = (const u16*)(p->ws + O_W) + WFFO;
  const u16* hid = (const u16*)(p->ws + O_HID);
  for (int t = bid; t < 128 * 8; t += nb) {
    const int m0 = (t & 127) * 256, n0 = (t >> 7) * 128;
    f32x4 acc[8][4]; ACC_ZERO(acc);
    gemm_kloop(hid + (size_t)m0 * 2816, 2816, W + (size_t)n0 * 2816, 2816, 88, acc, smem);
    float* outp = p->out;
    EPI_LOOP2({ l0[j] = *(const f32x4*)(outp + (size_t)row * 1024 + col); }, { *(f32x4*)(outp + (size_t)row * 1024 + col) = l0[j] + v; })
  }
}

__device__ __forceinline__ void ph_norm1(PP p, int layer, int seg, int bid, int nb) {
  if (seg == 0) {
    u16* urw = (u16*)(p->ws + O_URW); u16* sxbc = (u16*)(p->ws + O_SXBC);
    const int gt = bid * NTHR + tidx(), gs = nb * NTHR;
    for (int idx = gt; idx < 8 * 3456; idx += gs) { int b = idx / 3456, c = idx - b * 3456; urw[(size_t)(b * 513) * 3456 + c] = 0; }
    for (int idx = gt; idx < 8 * 9216; idx += gs) { int b = idx / 9216, c = idx - b * 9216; sxbc[(size_t)(b * 515) * 3072 + c] = 0; }
  }
  rmsnorm_rows(layer == 0 ? p->in[0] : p->out, p->in[1] + layer * 1024, (u16*)(p->ws + O_H), nullptr, RS, 0, seg, bid, nb);
}

#define XB_TMO      128
#define XB_XCNT(j)  (256  + 64 * (j))
#define XB_XSUB(j)  (1280 + 64 * (j))
#define XB_XGEN(j)  (2304 + 64 * (j))
#define XB_TOP      3328
#define XB_TOPGEN   3392
#define XCD_BAR_WORDS 3456
#define XB_SPIN_CAP (1u << 22)
__device__ __forceinline__ unsigned xb_ld(unsigned* p)              { return __hip_atomic_load(p, __ATOMIC_RELAXED, __HIP_MEMORY_SCOPE_AGENT); }
__device__ __forceinline__ unsigned xb_add(unsigned* p, unsigned v) { return __hip_atomic_fetch_add(p, v, __ATOMIC_RELAXED, __HIP_MEMORY_SCOPE_AGENT); }
__device__ __forceinline__ unsigned xb_xcc_id() { return (unsigned)__builtin_amdgcn_s_getreg((3 << 11) | 20) & 0xFu; }
#define XB_SPIN(cond, bar) do { unsigned _sp = 0; while (cond) { __builtin_amdgcn_s_sleep(1); \
    if ((++_sp & 255u) == 0u) { if (xb_ld(&(bar)[XB_TMO])) break; if (_sp > XB_SPIN_CAP) { atomicAdd(&(bar)[XB_TMO], 1u); break; } } } } while (0)
struct XcdBarrier { unsigned* bar; unsigned x; volatile LAS unsigned* st; };
__device__ __forceinline__ XcdBarrier xcd_barrier_post(unsigned* bar, volatile LAS unsigned* st) {
  XcdBarrier b; b.bar = bar; b.x = xb_xcc_id(); b.st = st;
  if (threadIdx.x == 0) (void)xb_add(&bar[XB_XCNT(b.x)], 1u);
  return b;
}
__device__ __forceinline__ void xcd_barrier_complete(unsigned* bar, unsigned x, unsigned& nloc, unsigned& nx) {
  const unsigned G = gridDim.x * gridDim.y * gridDim.z;
  unsigned sum, cnt, mine, sp = 0u;
  for (;;) {
    sum = 0u; cnt = 0u; mine = 0u;
#pragma unroll
    for (unsigned j = 0; j < 16; ++j) { const unsigned c = xb_ld(&bar[XB_XCNT(j)]); sum += c; cnt += (c > 0u) ? 1u : 0u; mine = (j == x) ? c : mine; }
    if (sum == G) break;
    __builtin_amdgcn_s_sleep(1);
    if ((++sp & 255u) == 0u) { if (xb_ld(&bar[XB_TMO])) break; if (sp > XB_SPIN_CAP) { atomicAdd(&bar[XB_TMO], 1u); break; } }
  }
  nloc = mine > 0u ? mine : 1u; nx = cnt > 0u ? cnt : 1u;
}
__device__ __forceinline__ void xcd_barrier(const XcdBarrier& b) {
  asm volatile("s_waitcnt vmcnt(0)" ::: "memory");
  __syncthreads();
  if (threadIdx.x == 0) {
    unsigned* bar = b.bar;
    __builtin_amdgcn_s_waitcnt(0);
    unsigned nloc = b.st[0], nx = b.st[1];
    if (nloc == 0u) { xcd_barrier_complete(bar, b.x, nloc, nx); b.st[0] = nloc; b.st[1] = nx; }
    const unsigned old = xb_add(&bar[XB_XSUB(b.x)], 1u);
    const unsigned gen = old / nloc;
    if (old + 1u == (gen + 1u) * nloc) {
      __builtin_amdgcn_fence(__ATOMIC_RELEASE, "agent");
      asm volatile("s_waitcnt vmcnt(0)" ::: "memory");
      const unsigned og = xb_add(&bar[XB_TOP], 1u);
      const unsigned tg = og / nx;
      if (og + 1u == (tg + 1u) * nx) xb_add(&bar[XB_TOPGEN], 1u);
      else XB_SPIN(xb_ld(&bar[XB_TOPGEN]) == tg, bar);
      __builtin_amdgcn_fence(__ATOMIC_ACQUIRE, "agent");
      xb_add(&bar[XB_XGEN(b.x)], 1u);
      asm volatile("s_waitcnt vmcnt(0)" ::: "memory");
    } else {
      XB_SPIN(xb_ld(&bar[XB_XGEN(b.x)]) == gen, bar);
      __builtin_amdgcn_fence(__ATOMIC_ACQUIRE, "agent");
      asm volatile("s_waitcnt vmcnt(0)" ::: "memory");
    }
  }
  __syncthreads();
}

#define SMEM_BYTES 73728
#ifndef SCANPROBE
#define SCANPROBE 0
#endif
#ifndef PHMASK
#define PHMASK 0xFFFF
#endif
#ifndef DBLMASK
#define DBLMASK 0
#endif
#define RUN(idx, call) { if ((PHMASK >> (idx)) & 1) { if ((DBLMASK >> (idx)) & 1) { call; __syncthreads(); } call; } }
__global__ void __launch_bounds__(NTHR, 2) mega(Params p_) {
  __shared__ __attribute__((aligned(1024))) char smem[SMEM_BYTES + 16];
  uint4& xb_words = *(uint4*)(smem + SMEM_BYTES);
  cg::grid_group grid = cg::this_grid();
  if (threadIdx.x == 0) xb_words = make_uint4(0u, 0u, 0u, 0u);
  __syncthreads();
  XcdBarrier xb = xcd_barrier_post((unsigned*)(p_.ws + O_BAR), (volatile LAS unsigned*)&xb_words);
  {
    PP p = (PP)__builtin_amdgcn_kernarg_segment_ptr();
    RUN(0, ph_wconv(p, 0, blockIdx.x, gridDim.x, smem))
  }
  if (p_.out == nullptr) grid.sync();
  xcd_barrier(xb);
#pragma unroll 1
  for (int pc = 0; pc < 151; pc++) {
    PP p = (PP)__builtin_amdgcn_kernarg_segment_ptr();
    asm volatile("" : "+s"(p));
    int bid = blockIdx.x, nb = gridDim.x;
    asm volatile("" : "+s"(bid), "+s"(nb));
    const int l = pc / 75, q = pc - l * 75;
    bool did = true;
    if (pc == 150) {
      RUN(13, rmsnorm_rows(p->out, p->in[27], nullptr, p->out, TTOK, 2, 0, bid, nb))
      did = false;
    } else if (q >= 72) {
      if (q == 72) RUN(10, rmsnorm_rows(p->out, p->in[24] + l * 1024, (u16*)(p->ws + O_H2), nullptr, TTOK, 1, 0, bid, nb))
      else if (q == 73) RUN(11, ph_ffi(p, l, bid, nb, smem))
      else RUN(12, ph_ffo(p, l, bid, nb, smem))
    } else {
      const int sg = q / 9, st = q - sg * 9;
      switch (st) {
        case 0: if (sg == 0) { if (l > 0) RUN(0, ph_wconv(p, l, bid, nb, smem)) RUN(1, ph_norm1(p, l, 0, bid, nb)) } else did = false; break;
        case 1:
          if (bid * 2 < nb) { if (sg > 0) RUN(7, ph_post(p, l, sg - 1, bid, nb)) RUN(2, ph_inproj(p, l, sg, bid, nb, smem)) }
          else { RUN(2, ph_inproj(p, l, sg, bid, nb, smem)) if (sg > 0) RUN(7, ph_post(p, l, sg - 1, bid, nb)) }
          if (sg > 1) RUN(9, ph_out(p, l, sg - 2, bid, nb, smem))
          break;
        case 2: RUN(3, ph_elem(p, l, sg, bid, nb)) if (sg + 1 < NSEG) RUN(1, ph_norm1(p, l, sg + 1, bid, nb)) break;
        case 3: RUN(4, ph_lora(p, l, bid, nb, smem)) break;
        case 4: RUN(5, ph_rprep(p, l, bid, nb)) break;
        case 5: ph_scan(p, l, sg, bid, nb, smem, ((volatile LAS unsigned*)&xb_words) + 2); break;
        case 6: if (sg == NSEG - 1) { RUN(7, ph_post(p, l, sg, bid, nb)) RUN(9, ph_out(p, l, sg - 1, bid, nb, smem)) } else did = false; break;
        case 7: if (sg == NSEG - 1) RUN(8, ph_merge(p, l, sg, bid, nb, smem)) else did = false; break;
        default: if (sg == NSEG - 1) RUN(9, ph_out(p, l, sg, bid, nb, smem)) else did = false; break;
      }
    }
    if (did) xcd_barrier(xb);
  }
}

extern "C" void kernel_launch(void* const* d_in, const int* in_sizes, int n_in, void* d_out, int out_size, void* d_ws,
                              size_t ws_size, hipStream_t stream) {
  Params p{};
  for (int i = 0; i < 28; i++) p.in[i] = (const float*)d_in[i];
  p.out = (float*)d_out; p.ws = (char*)d_ws;
  static int grid_blocks = 0;
  if (!grid_blocks) {
    int dev = 0, cus = 0, per_cu = 0;
    hipGetDevice(&dev);
    hipDeviceGetAttribute(&cus, hipDeviceAttributeMultiprocessorCount, dev);
    hipOccupancyMaxActiveBlocksPerMultiprocessor(&per_cu, mega, NTHR, 0);
    if (per_cu > 2) per_cu = 2;
    if (per_cu < 1) per_cu = 1;
    grid_blocks = cus * per_cu;
  }
  hipMemsetAsync((char*)d_ws + O_BAR, 0, 16384, stream);
  void* args[] = {&p};
  hipError_t e = hipLaunchCooperativeKernel((void*)mega, dim3(grid_blocks), dim3(NTHR), args, 0, stream);
  if (e != hipSuccess) fprintf(stderr, "cooperative launch failed: %s (grid %d)\n", hipGetErrorString(e), grid_blocks);
}
```

```cpp
#include <hip/hip_runtime.h>
#include <hip/hip_cooperative_groups.h>
#include <stdint.h>
#include <stdio.h>
namespace cg = cooperative_groups;

typedef unsigned short u16;
using bf16x8 = __attribute__((ext_vector_type(8))) short;
using f32x4  = __attribute__((ext_vector_type(4))) float;
using u32x4 = __attribute__((ext_vector_type(4))) unsigned int;
using u32x2 = __attribute__((ext_vector_type(2))) unsigned int;

#define DM 1024
#define SEQ 4096
#define TTOK 32768
#define SL 512
#define NSEG 8
#define RS 4096
#define NTHR 256
#ifndef SCANPROBE
#define SCANPROBE 0
#endif

constexpr size_t al(size_t x) { return (x + 255) & ~(size_t)255; }
constexpr size_t WIN = 0;
constexpr size_t WWUP = WIN + (size_t)15872 * 1024;
constexpr size_t WAUP = WWUP + 65536;
constexpr size_t WGUP = WAUP + 65536;
constexpr size_t WBR = WGUP + 196608;
constexpr size_t WOUT = WBR + 4194304;
constexpr size_t WFFI = WOUT + 1048576;
constexpr size_t WFFO = WFFI + 5767168;
constexpr size_t W_LAYER = WFFO + 2883584;
constexpr size_t O_W = 0;
constexpr size_t O_H = al(O_W + W_LAYER * 2);
constexpr size_t O_URW = al(O_H + (size_t)RS * 1024 * 2);
constexpr size_t O_HQ = al(O_URW + (size_t)8 * 513 * 3456 * 2);
constexpr size_t O_HV = al(O_HQ + (size_t)RS * 1024 * 2);
constexpr size_t O_HG = al(O_HV + (size_t)RS * 1024 * 2);
constexpr size_t O_HW = al(O_HG + (size_t)RS * 1024 * 2);
constexpr size_t O_SZ = al(O_HW + (size_t)RS * 1024 * 4);
constexpr size_t O_SXBC = al(O_SZ + (size_t)RS * 2048 * 2);
constexpr size_t O_SDT = al(O_SXBC + (size_t)8 * 515 * 3072 * 2);
constexpr size_t O_SWD = al(O_SDT + (size_t)RS * 32 * 4);
constexpr size_t O_GATES = al(O_SWD + (size_t)RS * 32 * 4);
constexpr size_t O_LAW = al(O_GATES + (size_t)RS * 3072 * 2);
constexpr size_t O_LAA = al(O_LAW + (size_t)RS * 64 * 2);
constexpr size_t O_LAG = al(O_LAA + (size_t)RS * 64 * 2);
constexpr size_t O_SX2 = al(O_LAG + (size_t)RS * 192 * 2);
constexpr size_t O_RWW = al(O_SX2 + (size_t)RS * 3072 * 2);
constexpr size_t O_RWA = al(O_RWW + (size_t)RS * 1024 * 4);
constexpr size_t O_RWG = al(O_RWA + (size_t)RS * 1024 * 2);
constexpr size_t O_PR = al(O_RWG + (size_t)RS * 1024 * 2);
constexpr size_t O_PK = al(O_PR + (size_t)RS * 1024 * 2);
constexpr size_t O_PV = al(O_PK + (size_t)RS * 1024 * 2);
constexpr size_t O_PKA = al(O_PV + (size_t)RS * 1024 * 2);
constexpr size_t O_PKB = al(O_PKA + (size_t)RS * 1024 * 2);
constexpr size_t O_BONUS = al(O_PKB + (size_t)RS * 1024 * 2);
constexpr size_t O_SO = al(O_BONUS + (size_t)RS * 16 * 4);
constexpr size_t O_Y = al(O_SO + (size_t)RS * 4096 * 4);
constexpr size_t O_MERGED = al(O_Y + (size_t)RS * 4096 * 2);
constexpr size_t O_STRW = al(O_MERGED + (size_t)RS * 1024 * 2);
constexpr size_t O_STHG = al(O_STRW + (size_t)128 * 64 * 64 * 4);
constexpr size_t O_STSS = al(O_STHG + (size_t)64 * 128 * 128 * 4);
constexpr size_t O_END = al(O_STSS + (size_t)256 * 64 * 128 * 4);
constexpr size_t O_H2 = O_H;
constexpr size_t O_HID = al(O_H2 + (size_t)TTOK * 1024 * 2);
constexpr size_t O_END2 = al(O_HID + (size_t)TTOK * 2816 * 2);
constexpr size_t O_HK = O_END;
constexpr size_t O_GATES2 = al(O_HK + (size_t)RS * 1024 * 2);
constexpr size_t O_HG2 = al(O_GATES2 + (size_t)RS * 3072 * 2);
constexpr size_t O_SZ2 = al(O_HG2 + (size_t)RS * 1024 * 2);
constexpr size_t O_SX22 = al(O_SZ2 + (size_t)RS * 2048 * 2);
constexpr size_t O_BAR = al(O_SX22 + (size_t)RS * 3072 * 2);
static_assert(O_BAR + 16384 <= (size_t)536870912, "ws overflow");
static_assert(O_END2 <= (size_t)536870912, "ws overflow2");

#define LAS __attribute__((address_space(3)))
struct Params { const float* in[28]; float* out; char* ws; };
typedef const __attribute__((address_space(4))) Params* PP;

enum { PH_WCONV = 0, PH_NORM1, PH_INPROJ, PH_ELEM, PH_LORA, PH_RPREP, PH_SCAN, PH_POST, PH_MERGE, PH_OUT,
       PH_NORM2, PH_FFI, PH_FFO, PH_FINAL };

__device__ __forceinline__ float bf2f(u16 u) { return __uint_as_float(((unsigned)u) << 16); }
__device__ __forceinline__ u16 f2bf(float f) { unsigned u = __float_as_uint(f); u += 0x7fffu + ((u >> 16) & 1u); return (u16)(u >> 16); }
__device__ __forceinline__ float sigm(float x) { return 1.f / (1.f + __expf(-x)); }
__device__ __forceinline__ float wave_sum(float x) {
#pragma unroll
  for (int o = 32; o; o >>= 1) x += __shfl_xor(x, o);
  return x;
}
__device__ __forceinline__ f32x4 cvt4(u32x2 v) {
  f32x4 r; r.x = __uint_as_float(v.x << 16); r.y = __uint_as_float(v.x & 0xffff0000u);
  r.z = __uint_as_float(v.y << 16); r.w = __uint_as_float(v.y & 0xffff0000u); return r;
}
template <int CTRL> __device__ __forceinline__ float dppf(float x) {
  return __int_as_float(__builtin_amdgcn_update_dpp(0, __float_as_int(x), CTRL, 0xF, 0xF, true));
}
__device__ __forceinline__ float red16(float x) {
  x += dppf<0xB1>(x); x += dppf<0x4E>(x); x += dppf<0x141>(x); x += dppf<0x140>(x); return x;
}
__device__ __forceinline__ unsigned pk2(float a, float b) { return (unsigned)f2bf(a) | ((unsigned)f2bf(b) << 16); }
__device__ __forceinline__ u32x2 pack4(float a, float b, float c, float d) {
  u32x2 r; r.x = (unsigned)f2bf(a) | ((unsigned)f2bf(b) << 16); r.y = (unsigned)f2bf(c) | ((unsigned)f2bf(d) << 16); return r;
}
__device__ __forceinline__ f32x4 f4z() { return (f32x4){0.f, 0.f, 0.f, 0.f}; }
__device__ __forceinline__ f32x4 sigm4(f32x4 x) { f32x4 r; r[0] = sigm(x[0]); r[1] = sigm(x[1]); r[2] = sigm(x[2]); r[3] = sigm(x[3]); return r; }
__device__ __forceinline__ u32x2 pack4v(f32x4 x) { return pack4(x[0], x[1], x[2], x[3]); }
__device__ __forceinline__ float red4(float x) { x += dppf<0xB1>(x); x += dppf<0x4E>(x); return x; }
__device__ __forceinline__ float red8(float x) {
  x += dppf<0xB1>(x); x += dppf<0x4E>(x); x += dppf<0x141>(x); return x;
}

__device__ __forceinline__ int tidx() { int t = threadIdx.x; asm volatile("" : "+v"(t)); return t; }
__device__ __forceinline__ int remap_col(int kind, int n, int nsrc) {
  if (kind == 0) return n < nsrc ? n : -1;
  if (kind == 1) {
    if (n < 3456) return n < 3360 ? n : -1;
    if (n < 7552) return 3360 + (n - 3456);
    if (n < 12800) { int c = n - 7552; return c < 5152 ? 7456 + c : -1; }
    return 12608 + (n - 12800);
  }
  int blk = n >> 5, w = n & 31;
  return w < 16 ? blk * 16 + w : 2816 + blk * 16 + (w - 16);
}
__device__ __forceinline__ void tconv(const float* __restrict__ src, int K, int Nsrc, u16* __restrict__ dst, int Kpad, int Npad,
                      int kind, int bid, int nb, char* smem) {
  float(*tile)[65] = (float(*)[65])smem;
  const int tn = Npad >> 6, tk = Kpad >> 6, tid = tidx();
  for (int t = bid; t < tn * tk; t += nb) {
    const int n0 = (t % tn) << 6, k0 = (t / tn) << 6;
    const int nn4 = (tid & 15) * 4, c = remap_col(kind, n0 + nn4, Nsrc);
#pragma unroll
    for (int i = 0; i < 4; i++) {
      const int kk = (tid >> 4) + 16 * i, k = k0 + kk;
      f32x4 v = (f32x4){0.f, 0.f, 0.f, 0.f};
      if (k < K && c >= 0) v = *(const f32x4*)(src + (size_t)k * Nsrc + c);
      tile[kk][nn4] = v[0]; tile[kk][nn4 + 1] = v[1]; tile[kk][nn4 + 2] = v[2]; tile[kk][nn4 + 3] = v[3];
    }
    __syncthreads();
#pragma unroll
    for (int i = 0; i < 8; i++) {
      const int n2 = (tid >> 5) + 8 * i, kk = (tid & 31) * 2;
      *(unsigned*)(dst + (size_t)(n0 + n2) * Kpad + k0 + kk) = pk2(tile[kk][n2], tile[kk + 1][n2]);
    }
    __syncthreads();
  }
}
__device__ __forceinline__ void ph_wconv(PP p, int l, int bid, int nb, char* smem) {
  {
    u16* W = (u16*)(p->ws + O_W);
    tconv(p->in[2] + (size_t)l * 1024 * 15680, 1024, 15680, W + WIN, 1024, 15872, 1, bid, nb, smem);
    tconv(p->in[5] + (size_t)l * 64 * 1024, 64, 1024, W + WWUP, 64, 1024, 0, bid, nb, smem);
    tconv(p->in[7] + (size_t)l * 64 * 1024, 64, 1024, W + WAUP, 64, 1024, 0, bid, nb, smem);
    tconv(p->in[8] + (size_t)l * 160 * 1024, 160, 1024, W + WGUP, 192, 1024, 0, bid, nb, smem);
    tconv(p->in[22] + (size_t)l * 4096 * 1024, 4096, 1024, W + WBR, 4096, 1024, 0, bid, nb, smem);
    tconv(p->in[23] + (size_t)l * 1024 * 1024, 1024, 1024, W + WOUT, 1024, 1024, 0, bid, nb, smem);
    tconv(p->in[25] + (size_t)l * 1024 * 5632, 1024, 5632, W + WFFI, 1024, 5632, 2, bid, nb, smem);
    tconv(p->in[26] + (size_t)l * 2816 * 1024, 2816, 1024, W + WFFO, 2816, 1024, 0, bid, nb, smem);
  }
}

__device__ __forceinline__ void rmsnorm_rows(const float* __restrict__ xs, const float* __restrict__ gain, u16* dst, float* dstf,
                             int nrows, int mode, int seg, int bid, int nb) {
  const int lane = tidx() & 63, wv = tidx() >> 6;
  for (int r = bid * 4 + wv; r < nrows; r += nb * 4) {
    size_t srow = (mode == 0) ? ((size_t)(r >> 9) * SEQ + seg * SL + (r & 511)) : (size_t)r;
    const float4* xp = (const float4*)(xs + srow * DM);
    float4 v[4]; float ss = 0.f;
#pragma unroll
    for (int i = 0; i < 4; i++) { v[i] = xp[lane + 64 * i]; ss += v[i].x * v[i].x + v[i].y * v[i].y + v[i].z * v[i].z + v[i].w * v[i].w; }
    ss = wave_sum(ss);
    float rstd = rsqrtf(ss * (1.f / DM) + 1e-5f);
#pragma unroll
    for (int i = 0; i < 4; i++) {
      float4 g = ((const float4*)gain)[lane + 64 * i];
      float a = v[i].x * rstd * g.x, b = v[i].y * rstd * g.y, c = v[i].z * rstd * g.z, d = v[i].w * rstd * g.w;
      if (mode == 2) { float4 o; o.x = a; o.y = b; o.z = c; o.w = d; ((float4*)(dstf + (size_t)r * DM))[lane + 64 * i] = o; }
      else { uint2 o; o.x = (unsigned)f2bf(a) | ((unsigned)f2bf(b) << 16); o.y = (unsigned)f2bf(c) | ((unsigned)f2bf(d) << 16);
             ((uint2*)(dst + (size_t)r * DM))[lane + 64 * i] = o; }
    }
  }
}

#define WAIT_V(n) asm volatile("s_waitcnt vmcnt(%0)" ::"n"(n) : "memory")
#define WAIT_L(n) asm volatile("s_waitcnt lgkmcnt(%0)" ::"n"(n) : "memory")
#define RAW_BARRIER() do { WAIT_L(0); __builtin_amdgcn_s_barrier(); } while (0)
template <int MI>
__device__ __forceinline__ void gemm_kloop(const u16* __restrict__ A, int lda, const u16* __restrict__ B, int ldb, int nkt,
                                           f32x4 (&acc)[MI][4], char* smem) {
  constexpr int NA = MI / 2, ABYTES = MI * 32 * 64, STB = ABYTES + 8192, NST = (MI == 4) ? 4 : 3, LPT = NA + 2;
  const int tid = tidx(), lane = tid & 63, wave = tid >> 6, wm = wave >> 1, wn = wave & 1;
  const int wu = __builtin_amdgcn_readfirstlane(wave);
  const u16* ga[NA]; const u16* gb[2];
#pragma unroll
  for (int i = 0; i < NA; i++) {
    const int r = (wu * NA + i) * 16 + (lane >> 2), kc = (lane & 3) ^ ((r >> 2) & 3);
    ga[i] = A + (size_t)r * lda + kc * 8;
  }
#pragma unroll
  for (int i = 0; i < 2; i++) {
    const int r = (wu * 2 + i) * 16 + (lane >> 2), kc = (lane & 3) ^ ((r >> 2) & 3);
    gb[i] = B + (size_t)r * ldb + kc * 8;
  }
  LAS char* sm = (LAS char*)smem;
#define GSTAGE(st_, kt_) { \
    _Pragma("unroll") for (int i = 0; i < NA; i++) \
      __builtin_amdgcn_global_load_lds((const unsigned*)(ga[i] + (kt_) * 32), (LAS unsigned*)(sm + (st_) * STB + (wu * NA + i) * 1024), 16, 0, 0); \
    _Pragma("unroll") for (int i = 0; i < 2; i++) \
      __builtin_amdgcn_global_load_lds((const unsigned*)(gb[i] + (kt_) * 32), (LAS unsigned*)(sm + (st_) * STB + ABYTES + (wu * 2 + i) * 1024), 16, 0, 0); }
#define WAIT_TILES(n_) { if ((n_) >= 3) WAIT_V(3 * LPT); else if ((n_) == 2) WAIT_V(2 * LPT); else if ((n_) == 1) WAIT_V(LPT); else WAIT_V(0); }
#define LDS_RD128(dst_, addr_) asm volatile("ds_read_b128 %0, %1" : "=v"(dst_) : "v"(addr_) : "memory")
#define RD_A(fa_, st_) { const unsigned ab_ = sbase + (st_) * STB + offA; \
    _Pragma("unroll") for (int i = 0; i < MI; i++) LDS_RD128(fa_[i], ab_ + i * 1024); }
#define RD_B(fb_, st_) { const unsigned bb_ = sbase + (st_) * STB + offB; \
    _Pragma("unroll") for (int i = 0; i < 4; i++) LDS_RD128(fb_[i], bb_ + i * 1024); }
#define DO_MFMA(fa_, fb_) { __builtin_amdgcn_s_setprio(1); \
    _Pragma("unroll") for (int i = 0; i < MI; i++) _Pragma("unroll") for (int j = 0; j < 4; j++) \
      acc[i][j] = __builtin_amdgcn_mfma_f32_16x16x32_bf16(__builtin_bit_cast(bf16x8, fb_[j]), __builtin_bit_cast(bf16x8, fa_[i]), acc[i][j], 0, 0, 0); \
    __builtin_amdgcn_s_setprio(0); }
#define KSTEP(fca_, fna_, kt_) { \
    RD_B(fb, st) \
    if ((kt_) + 1 < nkt) { \
      { const int rem_ = nkt - 2 - (kt_); WAIT_TILES(rem_ < NST - 2 ? rem_ : NST - 2) } \
      RAW_BARRIER(); \
      __builtin_amdgcn_sched_barrier(0); \
      if ((kt_) + NST < nkt) GSTAGE(st, (kt_) + NST) \
      st = (st + 1 == NST) ? 0 : st + 1; \
      RD_A(fna_, st) \
    } else { \
      WAIT_L(0); __builtin_amdgcn_sched_barrier(0); \
    } \
    DO_MFMA(fca_, fb) }
  __syncthreads();
#pragma unroll
  for (int s0 = 0; s0 < NST; s0++) if (s0 < nkt) GSTAGE(s0, s0)
  const int frow = lane & 15, fg = lane >> 4;
  const int fo = (frow * 4 + (fg ^ ((frow >> 2) & 3))) * 16;
  const int offA = (wm * MI * 16) * 64 + fo, offB = ABYTES + (wn * 64) * 64 + fo;
  int st = 0;
  const unsigned sbase = (unsigned)(unsigned long)sm;
  u32x4 fa0[MI], fa1[MI], fb[4];
  { const int rem_ = nkt - 1; WAIT_TILES(rem_ < NST - 1 ? rem_ : NST - 1) }
  RAW_BARRIER();
  __builtin_amdgcn_sched_barrier(0);
  RD_A(fa0, 0)
#pragma unroll 1
  for (int kt = 0; kt < nkt; kt += 2) {
    KSTEP(fa0, fa1, kt)
    KSTEP(fa1, fa0, kt + 1)
  }
  RAW_BARRIER();
}
#define ACC_ZERO(acc) { _Pragma("unroll") for (int i = 0; i < (int)(sizeof(acc) / sizeof(acc[0])); i++) _Pragma("unroll") for (int j = 0; j < 4; j++) acc[i][j] = (f32x4){0.f, 0.f, 0.f, 0.f}; }
#define EPI_LOOP(BODY) { constexpr int MI_ = (int)(sizeof(acc) / sizeof(acc[0])); const int lane_ = tidx() & 63, wave_ = tidx() >> 6, wm_ = wave_ >> 1, wn_ = wave_ & 1; \
  _Pragma("unroll") for (int i = 0; i < MI_; i++) { _Pragma("unroll") for (int j = 0; j < 4; j++) { \
    const int row = m0 + wm_ * (MI_ * 16) + i * 16 + (lane_ & 15); const int col = n0 + wn_ * 64 + j * 16 + (lane_ >> 4) * 4; const f32x4 v = acc[i][j]; BODY } \
    asm volatile("" ::: "memory"); } }
#define EPI_LOOP2(LOAD, STORE) { constexpr int MI_ = (int)(sizeof(acc) / sizeof(acc[0])); const int lane_ = tidx() & 63, wave_ = tidx() >> 6, wm_ = wave_ >> 1, wn_ = wave_ & 1; \
  _Pragma("unroll") for (int i = 0; i < MI_; i++) { f32x4 l0[4], l1[4]; \
    _Pragma("unroll") for (int j = 0; j < 4; j++) { \
      const int row = m0 + wm_ * (MI_ * 16) + i * 16 + (lane_ & 15); const int col = n0 + wn_ * 64 + j * 16 + (lane_ >> 4) * 4; LOAD } \
    asm volatile("" ::: "memory"); \
    _Pragma("unroll") for (int j = 0; j < 4; j++) { \
      const int row = m0 + wm_ * (MI_ * 16) + i * 16 + (lane_ & 15); const int col = n0 + wn_ * 64 + j * 16 + (lane_ >> 4) * 4; const f32x4 v = acc[i][j]; STORE } \
    asm volatile("" ::: "memory"); } }
#define COLJ(j) (n0 + ((tidx() >> 6) & 1) * 64 + (j) * 16 + ((tidx() & 63) >> 4) * 4)
__device__ __forceinline__ void ph_inproj(PP p, int layer, int seg, int bid, int nb, char* smem) {
  const u16* W = (const u16*)(p->ws + O_W) + WIN;
  const u16* H = (const u16*)(p->ws + O_H);
  u16* urw = (u16*)(p->ws + O_URW); u16* hq = (u16*)(p->ws + O_HQ); u16* hv = (u16*)(p->ws + O_HV); u16* hg = (u16*)(p->ws + ((seg & 1) ? O_HG2 : O_HG));
  float* hw = (float*)(p->ws + O_HW); u16* hk = (u16*)(p->ws + O_HK); u16* sz = (u16*)(p->ws + ((seg & 1) ? O_SZ2 : O_SZ)); u16* sxbc = (u16*)(p->ws + O_SXBC);
  float* sdt = (float*)(p->ws + O_SDT); u16* gates = (u16*)(p->ws + ((seg & 1) ? O_GATES2 : O_GATES));
  const float* lbl = p->in[14];
  const float* dtb = p->in[18] + layer * 32;
  for (int t = bid; t < 16 * 124; t += nb) {
    const int m0 = (t & 15) * 256, n0 = (t >> 4) * 128;
    f32x4 acc[8][4]; ACC_ZERO(acc);
    gemm_kloop(H + (size_t)m0 * 1024, 1024, W + (size_t)n0 * 1024, 1024, 32, acc, smem);
    if (n0 < 3456) {
      EPI_LOOP({ if (col < 3360) *(u32x2*)(urw + ((size_t)((row >> 9) * 513 + 1 + (row & 511))) * 3456 + col) = pack4v(v); })
    } else if (n0 < 7552) {
      const int which = (n0 - 3456) >> 10;
      if (which == 0) { EPI_LOOP({ int cc = (col - 3456) & 1023; *(u32x2*)(hq + (size_t)row * 1024 + cc) = pack4v(v * sigm4(v)); }) }
      else if (which == 1) {
        f32x4 lbj[4];
#pragma unroll
        for (int j = 0; j < 4; j++) {
          int cc = (COLJ(j) - 3456) & 1023;
          f32x4 l0 = *(const f32x4*)(lbl + cc), l1 = *(const f32x4*)(lbl + 1024 + cc);
#pragma unroll
          for (int e = 0; e < 4; e++) lbj[j][e] = layer == 0 ? 0.f : 1.f / (1.f + __expf(l0[e] - l1[e]));
        }
        EPI_LOOP({ int cc = (col - 3456) & 1023; const f32x4 lb = lbj[j];
                   f32x4 sg = sigm4(v); f32x4 w = lb + (1.f - lb) * sg; f32x4 lf;
                   lf[0] = fmaxf(__logf(w[0]), -60.f); lf[1] = fmaxf(__logf(w[1]), -60.f); lf[2] = fmaxf(__logf(w[2]), -60.f); lf[3] = fmaxf(__logf(w[3]), -60.f);
                   *(f32x4*)(hw + (size_t)row * 1024 + cc) = lf;
                   *(u32x2*)(hk + (size_t)row * 1024 + cc) = pack4v((1.f - lb) * (1.f - sg)); })
      } else if (which == 2) { EPI_LOOP({ int cc = (col - 3456) & 1023; *(u32x2*)(hv + (size_t)row * 1024 + cc) = pack4v(v); }) }
      else { EPI_LOOP({ int cc = (col - 3456) & 1023; *(u32x2*)(hg + (size_t)row * 1024 + cc) = pack4v(sigm4(v)); }) }
    } else if (n0 < 12800) {
      const int c0 = n0 - 7552;
      if (c0 < 2048) { EPI_LOOP({ int c = col - 7552; *(u32x2*)(sz + (size_t)row * 2048 + c) = pack4v(v * sigm4(v)); }) }
      else if (c0 < 5120) { EPI_LOOP({ int c = col - 7552 - 2048; *(u32x2*)(sxbc + ((size_t)((row >> 9) * 515 + 3 + (row & 511))) * 3072 + c) = pack4v(v); }) }
      else {
        f32x4 dbj[4];
#pragma unroll
        for (int j = 0; j < 4; j++) { int c = COLJ(j) - 7552 - 5120; dbj[j] = c < 32 ? *(const f32x4*)(dtb + c) : (f32x4){0.f, 0.f, 0.f, 0.f}; }
        EPI_LOOP({ int c = col - 7552 - 5120; if (c < 32) { f32x4 xx = v + dbj[j]; f32x4 o;
                   o[0] = xx[0] > 20.f ? xx[0] : log1pf(__expf(xx[0])); o[1] = xx[1] > 20.f ? xx[1] : log1pf(__expf(xx[1]));
                   o[2] = xx[2] > 20.f ? xx[2] : log1pf(__expf(xx[2])); o[3] = xx[3] > 20.f ? xx[3] : log1pf(__expf(xx[3]));
                   *(f32x4*)(sdt + (size_t)row * 32 + c) = o; } })
      }
    } else {
      EPI_LOOP({ int c = col - 12800; *(u32x2*)(gates + (size_t)row * 3072 + c) = pack4v(sigm4(v)); })
    }
  }
}

__device__ __forceinline__ void ph_elem(PP p, int layer, int seg, int bid, int nb) {
  const u16* urw = (const u16*)(p->ws + O_URW);
  const float* mu = p->in[3] + layer * 3360;
  u16* law = (u16*)(p->ws + O_LAW); u16* laa = (u16*)(p->ws + O_LAA); u16* lag = (u16*)(p->ws + O_LAG);
  const int gt = bid * NTHR + tidx(), gs = nb * NTHR;
#pragma unroll 1
  for (int idx = gt; idx < RS * 80; idx += gs) {
    const int r = idx / 80, gq = idx - r * 80;
    if (gq >= 72) { u32x2 z; z.x = 0; z.y = 0; *(u32x2*)(lag + (size_t)r * 192 + 160 + (gq - 72) * 4) = z; continue; }
    const int col = 3072 + gq * 4;
    const size_t ro = (size_t)((r >> 9) * 513 + 1 + (r & 511)) * 3456;
    f32x4 cur = cvt4(*(const u32x2*)(urw + ro + col)), prv = cvt4(*(const u32x2*)(urw + ro - 3456 + col));
    f32x4 m4 = *(const f32x4*)(mu + col);
    f32x4 val = cur + (prv - cur) * m4;
    if (gq < 16) *(u32x2*)(law + (size_t)r * 64 + gq * 4) = pack4(tanhf(val[0]), tanhf(val[1]), tanhf(val[2]), tanhf(val[3]));
    else if (gq < 32) *(u32x2*)(laa + (size_t)r * 64 + (gq - 16) * 4) = pack4(val[0], val[1], val[2], val[3]);
    else *(u32x2*)(lag + (size_t)r * 192 + (gq - 32) * 4) = pack4(sigm(val[0]), sigm(val[1]), sigm(val[2]), sigm(val[3]));
  }
  const u16* sxbc = (const u16*)(p->ws + O_SXBC); u16* sx2 = (u16*)(p->ws + ((seg & 1) ? O_SX22 : O_SX2));
  const float* cw = p->in[16] + (size_t)layer * 3072 * 4; const float* cb = p->in[17] + layer * 3072;
#pragma unroll 1
  for (int idx = gt; idx < (RS / 4) * 384; idx += gs) {
    const int rb = idx / 384, cg = idx - rb * 384, r = rb * 4, ch = cg * 8;
    const size_t ro = (size_t)((r >> 9) * 515 + (r & 511)) * 3072 + ch;
    u32x4 xin[7];
#pragma unroll
    for (int j = 0; j < 7; j++) xin[j] = *(const u32x4*)(sxbc + ro + (size_t)j * 3072);
    f32x4 w4[8];
#pragma unroll
    for (int c = 0; c < 8; c++) w4[c] = *(const f32x4*)(cw + (size_t)(ch + c) * 4);
    f32x4 b0 = *(const f32x4*)(cb + ch), b1 = *(const f32x4*)(cb + ch + 4);
#pragma unroll
    for (int rr = 0; rr < 4; rr++) {
      float o[8];
#pragma unroll
      for (int c = 0; c < 8; c++) {
        float acc = c < 4 ? b0[c] : b1[c - 4];
#pragma unroll
        for (int j = 0; j < 4; j++) {
          const unsigned wd = xin[rr + j][c >> 1];
          const float xv = (c & 1) ? __uint_as_float(wd & 0xffff0000u) : __uint_as_float(wd << 16);
          acc = fmaf(xv, w4[c][j], acc);
        }
        o[c] = acc * sigm(acc);
      }
      u32x4 ov; ov.x = pk2(o[0], o[1]); ov.y = pk2(o[2], o[3]); ov.z = pk2(o[4], o[5]); ov.w = pk2(o[6], o[7]);
      *(u32x4*)(sx2 + (size_t)(r + rr) * 3072 + ch) = ov;
    }
  }
}

__device__ __forceinline__ void ph_lora(PP p, int layer, int bid, int nb, char* smem) {
  const u16* W = (const u16*)(p->ws + O_W);
  float* rww = (float*)(p->ws + O_RWW); u16* rwa = (u16*)(p->ws + O_RWA); u16* rwg = (u16*)(p->ws + O_RWG);
  const float* w0 = p->in[4] + layer * 1024; const float* a0 = p->in[6] + layer * 1024;
  for (int t = bid; t < 3 * 256; t += nb) {
    const int job = t >> 8, tt = t & 255, m0 = (tt & 31) * 128, n0 = (tt >> 5) * 128;
    f32x4 acc[4][4]; ACC_ZERO(acc);
    if (job == 0) {
      gemm_kloop((const u16*)(p->ws + O_LAW) + (size_t)m0 * 64, 64, W + WWUP + (size_t)n0 * 64, 64, 2, acc, smem);
      f32x4 pj[4];
#pragma unroll
      for (int j = 0; j < 4; j++) pj[j] = *(const f32x4*)(w0 + COLJ(j));
      EPI_LOOP({ f32x4 sg = sigm4(pj[j] + v); f32x4 o; o[0] = __expf(-0.60653066f * sg[0]); o[1] = __expf(-0.60653066f * sg[1]); o[2] = __expf(-0.60653066f * sg[2]); o[3] = __expf(-0.60653066f * sg[3]);
                 *(f32x4*)(rww + (size_t)row * 1024 + col) = o; })
    } else if (job == 1) {
      gemm_kloop((const u16*)(p->ws + O_LAA) + (size_t)m0 * 64, 64, W + WAUP + (size_t)n0 * 64, 64, 2, acc, smem);
      f32x4 pj[4];
#pragma unroll
      for (int j = 0; j < 4; j++) pj[j] = *(const f32x4*)(a0 + COLJ(j));
      EPI_LOOP({ *(u32x2*)(rwa + (size_t)row * 1024 + col) = pack4v(sigm4(pj[j] + v)); })
    } else {
      gemm_kloop((const u16*)(p->ws + O_LAG) + (size_t)m0 * 192, 192, W + WGUP + (size_t)n0 * 192, 192, 6, acc, smem);
      EPI_LOOP({ *(u32x2*)(rwg + (size_t)row * 1024 + col) = pack4v(v); })
    }
  }
}

__device__ __forceinline__ void ph_rprep(PP p, int layer, int bid, int nb) {
  const u16* urw = (const u16*)(p->ws + O_URW); const u16* rwa = (const u16*)(p->ws + O_RWA);
  u16* pr = (u16*)(p->ws + O_PR); u16* pk = (u16*)(p->ws + O_PK); u16* pv = (u16*)(p->ws + O_PV);
  u16* pka = (u16*)(p->ws + O_PKA); u16* pkb = (u16*)(p->ws + O_PKB); float* bonus = (float*)(p->ws + O_BONUS);
  const float* mu = p->in[3] + layer * 3360; const float* kk_ = p->in[9] + layer * 1024; const float* ka_ = p->in[10] + layer * 1024;
  const float* rk_ = p->in[11] + layer * 1024;
  {
    u16* sxbc = (u16*)(p->ws + O_SXBC);
    const int gt = bid * NTHR + tidx(), gs = nb * NTHR;
    for (int idx = gt; idx < 8 * 3 * 3072; idx += gs) { int b = idx / 9216, c = idx - b * 9216; sxbc[(size_t)(b * 515) * 3072 + c] = sxbc[(size_t)(b * 515 + 512) * 3072 + c]; }
  }
  const int lane = tidx() & 63, wv = tidx() >> 6;
#pragma unroll 1
  for (int task = bid * 4 + wv; task < RS * 4; task += nb * 4) {
    const int r = task >> 2, col = (task & 3) * 256 + lane * 4;
    const size_t ro = (size_t)((r >> 9) * 513 + 1 + (r & 511)) * 3456 + col;
    f32x4 rc = cvt4(*(const u32x2*)(urw + ro)), rp = cvt4(*(const u32x2*)(urw + ro - 3456));
    f32x4 kc = cvt4(*(const u32x2*)(urw + ro + 1024)), kp = cvt4(*(const u32x2*)(urw + ro - 3456 + 1024));
    f32x4 vc = cvt4(*(const u32x2*)(urw + ro + 2048)), vp = cvt4(*(const u32x2*)(urw + ro - 3456 + 2048));
    f32x4 a = cvt4(*(const u32x2*)(rwa + (size_t)r * 1024 + col));
    f32x4 rr = rc + (rp - rc) * *(const f32x4*)(mu + col);
    f32x4 k = kc + (kp - kc) * *(const f32x4*)(mu + 1024 + col);
    f32x4 vv = vc + (vp - vc) * *(const f32x4*)(mu + 2048 + col);
    f32x4 kkv = k * *(const f32x4*)(kk_ + col);
    float n2 = red16(kkv[0] * kkv[0] + kkv[1] * kkv[1] + kkv[2] * kkv[2] + kkv[3] * kkv[3]);
    const float inv = 1.f / fmaxf(sqrtf(n2), 1e-12f);
    f32x4 kkn = kkv * inv;
    f32x4 kmod = k * (1.f + (a - 1.f) * *(const f32x4*)(ka_ + col));
    f32x4 bt = rr * kmod * *(const f32x4*)(rk_ + col);
    float bn = red16(bt[0] + bt[1] + bt[2] + bt[3]);
    const size_t o = (size_t)r * 1024 + col;
    *(u32x2*)(pr + o) = pack4(rr[0], rr[1], rr[2], rr[3]);
    *(u32x2*)(pk + o) = pack4(kmod[0], kmod[1], kmod[2], kmod[3]);
    *(u32x2*)(pv + o) = pack4(vv[0], vv[1], vv[2], vv[3]);
    *(u32x2*)(pka + o) = pack4(-kkn[0], -kkn[1], -kkn[2], -kkn[3]);
    *(u32x2*)(pkb + o) = pack4(kkn[0] * a[0], kkn[1] * a[1], kkn[2] * a[2], kkn[3] * a[3]);
    if ((lane & 15) == 0) bonus[r * 16 + (col >> 6)] = bn;
  }
}

struct ScanArgs {
  const u16 *pr, *pk, *pka, *pkb, *pv;
  const float *pw, *pvs;
  u16* po; float* state;
  int sr, sk, sab, sv, sw, svs, so;
};
#define TB 16
template <int KD, bool DELTA, bool WSCALAR, bool KFROMW, int LPR>
__device__ __forceinline__ void scan_task(const ScanArgs& a, bool first, bool save, char* smem) {
  constexpr int RB = 256 / LPR, GV = RB / 4; constexpr int KE = KD / LPR, NQ = KE / 4, NG = KD / 64, G4 = KD / 4;
  constexpr int OFF_R = 0, OFF_K = KD;
  constexpr int OFF_W = KFROMW ? KD : 2 * KD;
  constexpr int OFF_KA = OFF_W + (WSCALAR ? 0 : KD);
  constexpr int OFF_KB = OFF_KA + (DELTA ? KD : 0);
  constexpr int OFF_V = OFF_KB + (DELTA ? KD : 0);
  constexpr int OFF_S = OFF_V + RB;
  constexpr int STR = OFF_S + 4;
  float* buf0 = (float*)smem; float* buf1 = buf0 + TB * STR; float* obuf = buf1 + TB * STR;
  const int tid = tidx(), ks = tid & (LPR - 1), vr = tid / LPR;
  u32x2 gr[NG], gk[NG], gka[NG], gkb[NG], gv; f32x4 gw[NG]; float gsw = 0.f, gsv = 0.f;
  gv.x = gv.y = 0;
#define LOAD_BLK(blk_) { \
    const int row = (blk_) * TB; \
    _Pragma("unroll") for (int i = 0; i < NG; i++) { \
      const int g = tid + 256 * i, step = g / G4, e4 = g % G4; \
      gr[i] = *(const u32x2*)(a.pr + (size_t)(row + step) * a.sr + e4 * 4); \
      if (!KFROMW) gk[i] = *(const u32x2*)(a.pk + (size_t)(row + step) * a.sk + e4 * 4); \
      if (!WSCALAR) gw[i] = *(const f32x4*)(a.pw + (size_t)(row + step) * a.sw + e4 * 4); \
      if (DELTA) { gka[i] = *(const u32x2*)(a.pka + (size_t)(row + step) * a.sab + e4 * 4); gkb[i] = *(const u32x2*)(a.pkb + (size_t)(row + step) * a.sab + e4 * 4); } \
    } \
    if (tid < TB * GV) { const int step = tid / GV, e4 = tid % GV; gv = *(const u32x2*)(a.pv + (size_t)(row + step) * a.sv + e4 * 4); } \
    if (WSCALAR && tid < TB) { gsw = a.pw[(size_t)(row + tid) * a.sw]; gsv = a.pvs[(size_t)(row + tid) * a.svs]; } }
#define STORE_BLK(buf_) { \
    float* bufp = (buf_); \
    _Pragma("unroll") for (int i = 0; i < NG; i++) { \
      const int g = tid + 256 * i, step = g / G4, e4 = g % G4; \
      float* d = bufp + step * STR + e4 * 4; \
      *(f32x4*)(d + OFF_R) = cvt4(gr[i]); \
      if (!KFROMW) *(f32x4*)(d + OFF_K) = cvt4(gk[i]); \
      if (!WSCALAR) *(f32x4*)(d + OFF_W) = gw[i]; \
      if (DELTA) { *(f32x4*)(d + OFF_KA) = cvt4(gka[i]); *(f32x4*)(d + OFF_KB) = cvt4(gkb[i]); } \
    } \
    if (tid < TB * GV) { const int step = tid / GV, e4 = tid % GV; *(f32x4*)(bufp + step * STR + OFF_V + e4 * 4) = cvt4(gv); } \
    if (WSCALAR && tid < TB) { bufp[tid * STR + OFF_S] = gsw; bufp[tid * STR + OFF_S + 1] = gsv; } }
  float S[KE];
  if (first) {
#pragma unroll
    for (int e = 0; e < KE; e++) S[e] = 0.f;
  } else {
#pragma unroll
    for (int q = 0; q < NQ; q++) { float4 t = *(const float4*)(a.state + (size_t)vr * KD + q * (LPR * 4) + ks * 4); S[q * 4] = t.x; S[q * 4 + 1] = t.y; S[q * 4 + 2] = t.z; S[q * 4 + 3] = t.w; }
  }
  LOAD_BLK(0)
  __syncthreads();
  STORE_BLK(buf0)
  __syncthreads();
  constexpr int NBLK = SL / TB;
  for (int blk = 0; blk < NBLK; blk++) {
    float* buf = (blk & 1) ? buf1 : buf0;
    if (blk + 1 < NBLK) LOAD_BLK(blk + 1)
    {
      float rv1[KE], kb1[KE], kv[2][KE], wv[2][KE], kav[2][KE], vtv[2], wsv[2], vsv[2];
#define LD_STEP(slot, st_) { const float* sp = buf + (st_) * STR; \
        _Pragma("unroll") for (int q = 0; q < NQ; q++) { \
          if (!WSCALAR) { f32x4 u = *(const f32x4*)(sp + OFF_W + q * (LPR * 4) + ks * 4); wv[slot][q * 4] = u[0]; wv[slot][q * 4 + 1] = u[1]; wv[slot][q * 4 + 2] = u[2]; wv[slot][q * 4 + 3] = u[3]; } \
          if (!KFROMW) { f32x4 u = *(const f32x4*)(sp + OFF_K + q * (LPR * 4) + ks * 4); kv[slot][q * 4] = u[0]; kv[slot][q * 4 + 1] = u[1]; kv[slot][q * 4 + 2] = u[2]; kv[slot][q * 4 + 3] = u[3]; } \
          if (DELTA) { f32x4 u = *(const f32x4*)(sp + OFF_KA + q * (LPR * 4) + ks * 4); kav[slot][q * 4] = u[0]; kav[slot][q * 4 + 1] = u[1]; kav[slot][q * 4 + 2] = u[2]; kav[slot][q * 4 + 3] = u[3]; \
                     } \
        } \
        vtv[slot] = sp[OFF_V + vr]; \
        if (WSCALAR) { wsv[slot] = sp[OFF_S]; vsv[slot] = sp[OFF_S + 1]; } }
      LD_STEP(0, 0)
#define DO_STEP(cs, step_) { \
        { const float* spr = buf + (step_) * STR; _Pragma("unroll") for (int q = 0; q < NQ; q++) { f32x4 t = *(const f32x4*)(spr + OFF_R + q * (LPR * 4) + ks * 4); rv1[q * 4] = t[0]; rv1[q * 4 + 1] = t[1]; rv1[q * 4 + 2] = t[2]; rv1[q * 4 + 3] = t[3]; \
            if (DELTA) { f32x4 x = *(const f32x4*)(spr + OFF_KB + q * (LPR * 4) + ks * 4); kb1[q * 4] = x[0]; kb1[q * 4 + 1] = x[1]; kb1[q * 4 + 2] = x[2]; kb1[q * 4 + 3] = x[3]; } } } \
        float vt = vtv[cs]; \
        if (WSCALAR) vt *= vsv[cs]; \
        if (DELTA) { \
          float sa0 = 0.f, sa1 = 0.f, sa2 = 0.f, sa3 = 0.f; \
          _Pragma("unroll") for (int e = 0; e < KE; e += 2) { sa0 = fmaf(S[e], kav[cs][e], sa0); sa1 = fmaf(S[e + 1], kav[cs][e + 1], sa1); } \
          _Pragma("unroll") for (int e = 0; e < KE; e++) S[e] = fmaf(S[e], wv[cs][e], vt * kv[cs][e]); \
          float sa = (LPR == 8) ? red8((sa0 + sa1) + (sa2 + sa3)) : red4((sa0 + sa1) + (sa2 + sa3)); \
          _Pragma("unroll") for (int e = 0; e < KE; e++) S[e] = fmaf(sa, kb1[e], S[e]); \
        } else { \
          _Pragma("unroll") for (int e = 0; e < KE; e++) { \
            float w = WSCALAR ? wsv[cs] : wv[cs][e]; \
            float k = KFROMW ? (1.f - wv[cs][e]) : kv[cs][e]; \
            S[e] = fmaf(S[e], w, vt * k); } \
        } \
        float o0 = 0.f, o1 = 0.f, o2 = 0.f, o3 = 0.f; \
        _Pragma("unroll") for (int e = 0; e < KE; e += 2) { o0 = fmaf(S[e], rv1[e], o0); o1 = fmaf(S[e + 1], rv1[e + 1], o1); } \
        float o = (LPR == 8) ? red8((o0 + o1) + (o2 + o3)) : red4((o0 + o1) + (o2 + o3)); \
        if (ks == 0) obuf[(step_) * RB + vr] = o; }
#pragma unroll 1
      for (int step = 0; step < TB; step += 2) {
        LD_STEP(1, step + 1)
        DO_STEP(0, step)
        if (step + 2 < TB) LD_STEP(0, step + 2)
        DO_STEP(1, step + 1)
      }
    }
    __syncthreads();
    {
      const int row = blk * TB;
#pragma unroll
      for (int i = 0; i < TB * RB / 512; i++) { const int idx = (tid + 256 * i) * 2, step = idx / RB, v2 = idx % RB; *(unsigned*)(a.po + (size_t)(row + step) * a.so + v2) = pk2(obuf[idx], obuf[idx + 1]); }
    }
    if (blk + 1 < NBLK) STORE_BLK((blk & 1) ? buf0 : buf1)
    __syncthreads();
  }
  if (save)
#pragma unroll
  for (int q = 0; q < NQ; q++) { float4 t; t.x = S[q * 4]; t.y = S[q * 4 + 1]; t.z = S[q * 4 + 2]; t.w = S[q * 4 + 3]; *(float4*)(a.state + (size_t)vr * KD + q * (LPR * 4) + ks * 4) = t; }
}


__device__ __forceinline__ void rwkv_scan2(const ScanArgs& a, bool first, bool save, char* smem) {
  constexpr int OFF_R = 0, OFF_K = 64, OFF_W = 128, OFF_KA = 192, OFF_KB = 256, OFF_V = 320, STR = 388;
  float* buf0 = (float*)smem; float* buf1 = buf0 + TB * STR; float* obuf = buf1 + TB * STR;
  const int tid = tidx(), ks = tid & 7, vr = tid >> 3;
  const int sstep = tid >> 4, se4 = tid & 15;
  u32x2 gr, gk, gka, gkb, gv; f32x4 gw;
#define R2_LOAD(blk_) { const size_t rw_ = (size_t)((blk_) * TB + sstep); \
    gr = *(const u32x2*)(a.pr + rw_ * a.sr + se4 * 4); gk = *(const u32x2*)(a.pk + rw_ * a.sk + se4 * 4); \
    gw = *(const f32x4*)(a.pw + rw_ * a.sw + se4 * 4); \
    gka = *(const u32x2*)(a.pka + rw_ * a.sab + se4 * 4); gkb = *(const u32x2*)(a.pkb + rw_ * a.sab + se4 * 4); \
    gv = *(const u32x2*)(a.pv + rw_ * a.sv + se4 * 4); }
#define R2_STORE(buf_) { float* d_ = (buf_) + sstep * STR + se4 * 4; \
    *(f32x4*)(d_ + OFF_R) = cvt4(gr); *(f32x4*)(d_ + OFF_K) = cvt4(gk); *(f32x4*)(d_ + OFF_W) = gw; \
    *(f32x4*)(d_ + OFF_KA) = cvt4(gka); *(f32x4*)(d_ + OFF_KB) = cvt4(gkb); *(f32x4*)(d_ + OFF_V) = cvt4(gv); }
  float S0[8], S1[8];
#pragma unroll
  for (int q = 0; q < 2; q++) {
    f32x4 t0 = first ? f4z() : *(const f32x4*)(a.state + (size_t)vr * 64 + q * 32 + ks * 4);
    f32x4 t1 = first ? f4z() : *(const f32x4*)(a.state + (size_t)(vr + 32) * 64 + q * 32 + ks * 4);
#pragma unroll
    for (int j = 0; j < 4; j++) { S0[q * 4 + j] = t0[j]; S1[q * 4 + j] = t1[j]; }
  }
  R2_LOAD(0)
  __syncthreads();
  R2_STORE(buf0)
  __syncthreads();
  constexpr int NBLK = SL / TB;
#pragma unroll 1
  for (int blk = 0; blk < NBLK; blk++) {
    float* buf = (blk & 1) ? buf1 : buf0;
    if (blk + 1 < NBLK) R2_LOAD(blk + 1)
    {
      float rv1[8], kb1[8], kv[2][8], wv[2][8], kav[2][8], vt0[2], vt1[2];
#define R2_LD(slot, st_) { const float* sp = buf + (st_) * STR; \
        _Pragma("unroll") for (int q = 0; q < 2; q++) { \
          f32x4 u = *(const f32x4*)(sp + OFF_W + q * 32 + ks * 4); f32x4 x = *(const f32x4*)(sp + OFF_K + q * 32 + ks * 4); f32x4 y = *(const f32x4*)(sp + OFF_KA + q * 32 + ks * 4); \
          _Pragma("unroll") for (int j = 0; j < 4; j++) { wv[slot][q * 4 + j] = u[j]; kv[slot][q * 4 + j] = x[j]; kav[slot][q * 4 + j] = y[j]; } } \
        vt0[slot] = sp[OFF_V + vr]; vt1[slot] = sp[OFF_V + vr + 32]; }
#define R2_DO(cs, step_) { \
        { const float* spr = buf + (step_) * STR; _Pragma("unroll") for (int q = 0; q < 2; q++) { \
            f32x4 t = *(const f32x4*)(spr + OFF_R + q * 32 + ks * 4); f32x4 x = *(const f32x4*)(spr + OFF_KB + q * 32 + ks * 4); \
            _Pragma("unroll") for (int j = 0; j < 4; j++) { rv1[q * 4 + j] = t[j]; kb1[q * 4 + j] = x[j]; } } } \
        float a0 = 0.f, a1 = 0.f, b0 = 0.f, b1 = 0.f; \
        _Pragma("unroll") for (int e = 0; e < 8; e += 2) { a0 = fmaf(S0[e], kav[cs][e], a0); a1 = fmaf(S0[e + 1], kav[cs][e + 1], a1); \
                                                            b0 = fmaf(S1[e], kav[cs][e], b0); b1 = fmaf(S1[e + 1], kav[cs][e + 1], b1); } \
        const float v0 = vt0[cs], v1 = vt1[cs]; \
        _Pragma("unroll") for (int e = 0; e < 8; e++) { S0[e] = fmaf(S0[e], wv[cs][e], v0 * kv[cs][e]); S1[e] = fmaf(S1[e], wv[cs][e], v1 * kv[cs][e]); } \
        const float sa0 = red8(a0 + a1), sa1 = red8(b0 + b1); \
        _Pragma("unroll") for (int e = 0; e < 8; e++) { S0[e] = fmaf(sa0, kb1[e], S0[e]); S1[e] = fmaf(sa1, kb1[e], S1[e]); } \
        float c0 = 0.f, c1 = 0.f, d0 = 0.f, d1 = 0.f; \
        _Pragma("unroll") for (int e = 0; e < 8; e += 2) { c0 = fmaf(S0[e], rv1[e], c0); c1 = fmaf(S0[e + 1], rv1[e + 1], c1); \
                                                            d0 = fmaf(S1[e], rv1[e], d0); d1 = fmaf(S1[e + 1], rv1[e + 1], d1); } \
        const float o0 = red8(c0 + c1), o1 = red8(d0 + d1); \
        if (ks == 0) { obuf[(step_) * 64 + vr] = o0; obuf[(step_) * 64 + vr + 32] = o1; } }
      R2_LD(0, 0)
#pragma unroll 1
      for (int step = 0; step < TB; step += 2) {
        R2_LD(1, step + 1)
        R2_DO(0, step)
        if (step + 2 < TB) R2_LD(0, step + 2)
        R2_DO(1, step + 1)
      }
    }
    __syncthreads();
    {
      const int row = blk * TB;
#pragma unroll
      for (int i = 0; i < 2; i++) { const int idx = (tid + 256 * i) * 2, step = idx >> 6, v2 = idx & 63; *(unsigned*)(a.po + (size_t)(row + step) * a.so + v2) = pk2(obuf[idx], obuf[idx + 1]); }
    }
    if (blk + 1 < NBLK) R2_STORE((blk & 1) ? buf0 : buf1)
    __syncthreads();
  }
  if (save) {
#pragma unroll
    for (int q = 0; q < 2; q++) {
      f32x4 t0, t1;
#pragma unroll
      for (int j = 0; j < 4; j++) { t0[j] = S0[q * 4 + j]; t1[j] = S1[q * 4 + j]; }
      *(f32x4*)(a.state + (size_t)vr * 64 + q * 32 + ks * 4) = t0;
      *(f32x4*)(a.state + (size_t)(vr + 32) * 64 + q * 32 + ks * 4) = t1;
    }
  }
}

struct ChunkArgs { const u16 *q, *k, *v; const float* lf; u16* o; float* state; int ld, ldlf; float expA; };
#define QLD 136
#define KHLD 72
template <bool SSM>
__device__ __forceinline__ void chunk_task(const ChunkArgs& a, bool first, bool save, char* smem) {
  u16* QT = (u16*)smem;
  u16* KT = QT + 64 * QLD;
  u16* KH = KT + 64 * QLD;
  u16* VT = KH + 128 * KHLD;
  u16* ST = VT + 32 * KHLD;
  float* gam = (float*)(ST + 32 * QLD); float* em = gam + 128; float* cum = gam + 256; float* dts = gam + 512;
  const int tid = tidx(), lane = tid & 63, g = lane >> 4, c = lane & 15;
  const int w = __builtin_amdgcn_readfirstlane(tid >> 6);
  f32x4 accS[2][2];
#pragma unroll
  for (int i = 0; i < 2; i++)
#pragma unroll
    for (int j = 0; j < 2; j++)
      accS[i][j] = first ? (f32x4){0.f, 0.f, 0.f, 0.f} : *(const f32x4*)(a.state + (size_t)((i * 2 + j) * 256 + tid) * 4);
  float rcn[32]; u16 qan[32], kan[32]; u32x4 cqn[4], ckn[4], vvn; float dtn = 0.f;
#define CH_PREFETCH(chn_) { const int rp = (chn_) * 64; \
    if (!SSM) { const int d = tid & 127, half = tid >> 7; \
      const float* lfp = a.lf + (size_t)(rp + half * 32) * a.ldlf + d; \
      const u16* qp = a.q + (size_t)(rp + half * 32) * a.ld + d; const u16* kp = a.k + (size_t)(rp + half * 32) * a.ld + d; \
      _Pragma("unroll") for (int i = 0; i < 32; i++) rcn[i] = lfp[(size_t)i * a.ldlf]; \
      _Pragma("unroll") for (int i = 0; i < 32; i++) { qan[i] = qp[(size_t)i * a.ld]; kan[i] = kp[(size_t)i * a.ld]; } \
    } else { \
      _Pragma("unroll") for (int i = 0; i < 4; i++) { const int id = tid + 256 * i, s = id >> 4, cc = id & 15; \
        cqn[i] = *(const u32x4*)(a.q + (size_t)(rp + s) * a.ld + cc * 8); ckn[i] = *(const u32x4*)(a.k + (size_t)(rp + s) * a.ld + cc * 8); } \
      if (tid < 64) dtn = a.lf[(size_t)(rp + tid) * a.ldlf]; \
    } \
    { const int s = tid & 63, vg = tid >> 6; vvn = *(const u32x4*)(a.v + (size_t)(rp + s) * a.ld + vg * 8); } }
  CH_PREFETCH(0)
#pragma unroll 1
  for (int ch = 0; ch < SL / 64; ch++) {
    const int r0 = ch * 64;
    float rc[32]; float kf[32]; float rc63 = 0.f;
    if (!SSM) {
      const int d = tid & 127, half = tid >> 7;
#pragma unroll
      for (int i = 0; i < 32; i++) rc[i] = rcn[i];
      float tot = 0.f;
      if (half == 0) {
        float acc = 0.f;
#pragma unroll
        for (int i = 31; i >= 0; i--) { float l = rc[i]; tot += l; rc[i] = acc; acc -= l; }
        em[d] = __expf(tot);
      } else {
        float acc = 0.f;
#pragma unroll
        for (int i = 0; i < 32; i++) { acc += rc[i]; rc[i] = acc; }
        tot = acc;
      }
      cum[half * 128 + d] = tot;
#pragma unroll
      for (int i = 0; i < 32; i++) {
        const int s = half * 32 + i;
        float qv = bf2f(qan[i]); kf[i] = bf2f(kan[i]);
        float r = rc[i];
        QT[s * QLD + d] = f2bf(qv * __expf(fminf(r, 80.f)));
        KT[s * QLD + d] = f2bf(kf[i] * __expf(fminf(-r, 80.f)));
      }
    } else {
#pragma unroll
      for (int i = 0; i < 4; i++) {
        const int id = tid + 256 * i, s = id >> 4, cc = id & 15;
        *(u32x4*)(QT + s * QLD + cc * 8) = cqn[i];
        *(u32x4*)(KT + s * QLD + cc * 8) = ckn[i];
      }
      if (tid < 64) {
        float dtv = dtn;
        float x = -dtv * a.expA;
#pragma unroll
        for (int o = 1; o < 64; o <<= 1) { float y = __shfl_up(x, o); if (lane >= o) x += y; }
        cum[tid] = x; dts[tid] = dtv;
      }
    }
    {
      const int s = tid & 63, vg = tid >> 6;
      u32x4 vv = vvn;
#pragma unroll
      for (int j = 0; j < 4; j++) { VT[(vg * 8 + 2 * j) * KHLD + s] = (u16)(vv[j] & 0xffffu); VT[(vg * 8 + 2 * j + 1) * KHLD + s] = (u16)(vv[j] >> 16); }
    }
    __syncthreads();
#pragma unroll
    for (int dt2 = 0; dt2 < 2; dt2++) {
      const int d0 = (2 * w + dt2) * 16 + 4 * g;
      f32x4 e4 = (f32x4){1.f, 1.f, 1.f, 1.f};
      if (!SSM) e4 = *(const f32x4*)(em + d0);
#pragma unroll
      for (int vt = 0; vt < 2; vt++) {
        f32x4 sv = accS[dt2][vt] * e4;
        u32x2 pk; pk.x = pk2(sv[0], sv[1]); pk.y = pk2(sv[2], sv[3]);
        *(u32x2*)(ST + (16 * vt + c) * QLD + d0) = pk;
      }
    }
    if (!SSM) {
      const int d = tid & 127, half = tid >> 7;
      const float t0 = cum[d], t1 = cum[128 + d];
      rc63 = t1;
      if (half == 0) gam[d] = __expf(t0 + t1);
#pragma unroll
      for (int i = 0; i < 32; i++) KH[d * KHLD + half * 32 + i] = f2bf(kf[i] * __expf(rc63 - rc[i]));
    }
    if (SSM) {
      const int s = tid & 63, ng = tid >> 6;
      const float sc = __expf(cum[63] - cum[s]) * dts[s];
#pragma unroll
      for (int i = 0; i < 4; i++) {
        u32x4 kk = *(const u32x4*)(KT + s * QLD + ng * 32 + i * 8);
#pragma unroll
        for (int j = 0; j < 4; j++) {
          const int n = ng * 32 + i * 8 + 2 * j;
          KH[n * KHLD + s] = f2bf(__uint_as_float(kk[j] << 16) * sc);
          KH[(n + 1) * KHLD + s] = f2bf(__uint_as_float(kk[j] & 0xffff0000u) * sc);
        }
      }
    }
    __syncthreads();
    if (ch + 1 < SL / 64) CH_PREFETCH(ch + 1)
    {
      const int t = 16 * w + c;
      bf16x8 bq[4];
#pragma unroll
      for (int ks = 0; ks < 4; ks++) bq[ks] = *(const bf16x8*)(QT + t * QLD + ks * 32 + g * 8);
      f32x4 accp[4];
#pragma unroll
      for (int st = 0; st < 4; st++) {
        accp[st] = (f32x4){0.f, 0.f, 0.f, 0.f};
        if (st <= w) {
#pragma unroll
          for (int ks = 0; ks < 4; ks++) {
            bf16x8 ak = *(const bf16x8*)(KT + (16 * st + c) * QLD + ks * 32 + g * 8);
            accp[st] = __builtin_amdgcn_mfma_f32_16x16x32_bf16(ak, bq[ks], accp[st], 0, 0, 0);
          }
        }
      }
      float cumt = 0.f;
      if (SSM) cumt = cum[t];
#pragma unroll
      for (int st = 0; st < 4; st++)
#pragma unroll
        for (int r = 0; r < 4; r++) {
          const int s = 16 * st + 4 * g + r;
          float v = accp[st][r];
          if (SSM) v *= __expf(fminf(cumt - cum[s], 0.f)) * dts[s];
          accp[st][r] = (s <= t) ? v : 0.f;
        }
      bf16x8 bp[2];
#pragma unroll
      for (int a2 = 0; a2 < 2; a2++)
#pragma unroll
        for (int j = 0; j < 4; j++) { bp[a2][j] = (short)f2bf(accp[2 * a2][j]); bp[a2][4 + j] = (short)f2bf(accp[2 * a2 + 1][j]); }
      f32x4 acco[2], acco2[2];
#pragma unroll
      for (int vt = 0; vt < 2; vt++) {
        acco[vt] = (f32x4){0.f, 0.f, 0.f, 0.f}; acco2[vt] = (f32x4){0.f, 0.f, 0.f, 0.f};
#pragma unroll
        for (int a2 = 0; a2 < 2; a2++) {
          if (2 * a2 <= w) {
            const u16* vp = VT + (16 * vt + c) * KHLD + 32 * a2 + 4 * g;
            u32x2 lo = *(const u32x2*)vp, hi = *(const u32x2*)(vp + 16);
            u32x4 cmb; cmb.x = lo.x; cmb.y = lo.y; cmb.z = hi.x; cmb.w = hi.y;
            bf16x8 av = __builtin_bit_cast(bf16x8, cmb);
            acco[vt] = __builtin_amdgcn_mfma_f32_16x16x32_bf16(av, bp[a2], acco[vt], 0, 0, 0);
          }
        }
#pragma unroll
        for (int ks = 0; ks < 4; ks++) {
          bf16x8 as = *(const bf16x8*)(ST + (16 * vt + c) * QLD + ks * 32 + g * 8);
          if (SSM) acco2[vt] = __builtin_amdgcn_mfma_f32_16x16x32_bf16(as, bq[ks], acco2[vt], 0, 0, 0);
          else acco[vt] = __builtin_amdgcn_mfma_f32_16x16x32_bf16(as, bq[ks], acco[vt], 0, 0, 0);
        }
        f32x4 ov = acco[vt];
        if (SSM) ov += __expf(cumt) * acco2[vt];
        *(u32x2*)(a.o + (size_t)(r0 + t) * 4096 + 16 * vt + 4 * g) = pack4v(ov);
      }
#pragma unroll
      for (int dt2 = 0; dt2 < 2; dt2++) {
        const int d0 = (2 * w + dt2) * 16;
        f32x4 gm;
        if (SSM) { float gs = __expf(cum[63]); gm = (f32x4){gs, gs, gs, gs}; }
        else gm = *(const f32x4*)(gam + d0 + 4 * g);
#pragma unroll
        for (int vt = 0; vt < 2; vt++) accS[dt2][vt] *= gm;
#pragma unroll
        for (int a2 = 0; a2 < 2; a2++) {
          bf16x8 ak = *(const bf16x8*)(KH + (d0 + c) * KHLD + 32 * a2 + 8 * g);
#pragma unroll
          for (int vt = 0; vt < 2; vt++) {
            bf16x8 bv = *(const bf16x8*)(VT + (16 * vt + c) * KHLD + 32 * a2 + 8 * g);
            accS[dt2][vt] = __builtin_amdgcn_mfma_f32_16x16x32_bf16(ak, bv, accS[dt2][vt], 0, 0, 0);
          }
        }
      }
    }
    __syncthreads();
  }
  if (save)
#pragma unroll
  for (int i = 0; i < 2; i++)
#pragma unroll
    for (int j = 0; j < 2; j++) *(f32x4*)(a.state + (size_t)((i * 2 + j) * 256 + tid) * 4) = accS[i][j];
}

__device__ __forceinline__ void chunk_dispatch(PP p, int layer, int seg, int ct, bool first, bool save, char* smem) {
  u16* so = (u16*)(p->ws + O_SO);
  ChunkArgs a;
  if (ct < 256) {
    const int vs = ct & 3, h = (ct >> 2) & 7, b = ct >> 5;
    const size_t ro = (size_t)b * SL * 1024 + h * 128;
    a.q = (const u16*)(p->ws + O_HQ) + ro; a.k = (const u16*)(p->ws + O_HK) + ro; a.v = (const u16*)(p->ws + O_HV) + ro + vs * 32;
    a.lf = (const float*)(p->ws + O_HW) + ro; a.o = so + (size_t)b * SL * 4096 + 1024 + h * 128 + vs * 32;
    a.state = (float*)(p->ws + O_STHG) + (size_t)ct * 4096; a.ld = 1024; a.ldlf = 1024; a.expA = 0.f;
    chunk_task<false>(a, first, save, smem);
  } else {
    const int t2 = ct - 256, vs = t2 & 1, hd = (t2 >> 1) & 31, b = t2 >> 6, g = hd >> 3;
    const u16* x2 = (const u16*)(p->ws + ((seg & 1) ? O_SX22 : O_SX2)) + (size_t)b * SL * 3072;
    a.q = x2 + 2560 + g * 128; a.k = x2 + 2048 + g * 128; a.v = x2 + hd * 64 + vs * 32;
    a.lf = (const float*)(p->ws + O_SDT) + (size_t)b * SL * 32 + hd; a.o = so + (size_t)b * SL * 4096 + 2048 + hd * 64 + vs * 32;
    a.state = (float*)(p->ws + O_STSS) + (size_t)t2 * 4096; a.ld = 3072; a.ldlf = 32; a.expA = __expf(p->in[19][layer * 32 + hd]);
    chunk_task<true>(a, first, save, smem);
  }
}
__device__ __forceinline__ void rwkv_dispatch(PP p, int task, bool first, bool save, char* smem) {
  u16* so = (u16*)(p->ws + O_SO);
  ScanArgs a;
  const int h = task & 15, b = task >> 4;
  const size_t ro = (size_t)b * SL * 1024 + h * 64;
  a.pr = (const u16*)(p->ws + O_PR) + ro; a.pk = (const u16*)(p->ws + O_PK) + ro; a.pka = (const u16*)(p->ws + O_PKA) + ro; a.pkb = (const u16*)(p->ws + O_PKB) + ro;
  a.pv = (const u16*)(p->ws + O_PV) + ro; a.pw = (const float*)(p->ws + O_RWW) + ro; a.pvs = nullptr;
  a.po = so + (size_t)b * SL * 4096 + h * 64; a.state = (float*)(p->ws + O_STRW) + (size_t)(b * 16 + h) * 4096;
  a.sr = a.sk = a.sab = a.sv = a.sw = 1024; a.svs = 0; a.so = 4096;
  __builtin_amdgcn_s_setprio(3);
  rwkv_scan2(a, first, save, smem);
  __builtin_amdgcn_s_setprio(0);
}
template <int BR> __device__ __forceinline__ void merge_tile(PP p, int layer, int seg, int t, char* smem);
__device__ __forceinline__ void merge_item(PP p, int layer, int seg, int t, char* smem);
__device__ __forceinline__ void ph_scan(PP p, int layer, int seg, int bid, int nb, char* smem, volatile LAS unsigned* bw) {
  const bool first = (seg == 0);
  unsigned* ctr = (unsigned*)(p->ws + O_BAR) + 3520;
  const unsigned base = (unsigned)(layer * NSEG + seg) * (unsigned)(1024 + nb);
  {
    u16* urw = (u16*)(p->ws + O_URW);
    const int gt = bid * NTHR + tidx(), gs = nb * NTHR;
    for (int idx = gt; idx < 8 * 3456; idx += gs) { int b = idx / 3456, c = idx - b * 3456; urw[(size_t)(b * 513) * 3456 + c] = urw[(size_t)(b * 513 + 512) * 3456 + c]; }
  }
  if (bid < 128) { rwkv_dispatch(p, bid, first, true, smem); __syncthreads(); }
#pragma unroll 1
  for (;;) {
    if (tidx() == 0) *bw = __hip_atomic_fetch_add(ctr, 1u, __ATOMIC_RELAXED, __HIP_MEMORY_SCOPE_AGENT);
    __syncthreads();
    const unsigned it = *bw - base;
    __syncthreads();
    if (it >= 1024u) break;
    if (it < 256u) { if (seg > 0) merge_item(p, layer, seg - 1, (int)it, smem); }
    else chunk_dispatch(p, layer, seg, (int)it - 256, first, true, smem);
    __syncthreads();
  }
}

__device__ __forceinline__ void ph_post(PP p, int layer, int seg, int bid, int nb) {
  const u16* so = (const u16*)(p->ws + O_SO); u16* y = (u16*)(p->ws + O_Y);
  const int lane = tidx() & 63, wv = tidx() >> 6;
  const u16* pv = (const u16*)(p->ws + O_PV); const u16* rwg = (const u16*)(p->ws + O_RWG); const float* bonus = (const float*)(p->ws + O_BONUS);
  const float* gnw = p->in[12] + layer * 1024; const float* gnb = p->in[13] + layer * 1024;
  const u16* hg = (const u16*)(p->ws + ((seg & 1) ? O_HG2 : O_HG)); const float* hgn = p->in[15] + layer * 1024;
  const u16* sx2 = (const u16*)(p->ws + ((seg & 1) ? O_SX22 : O_SX2)); const u16* sz = (const u16*)(p->ws + ((seg & 1) ? O_SZ2 : O_SZ));
  const float* dsk = p->in[20] + layer * 32; const float* sgn = p->in[21] + layer * 2048;
#pragma unroll 1
  for (int task = bid * 4 + wv; task < RS * 12; task += nb * 4) {
    const int r = task / 12, s = task - r * 12;
    if (s < 4) {
      const int col = s * 256 + lane * 4;
      f32x4 o = cvt4(*(const u32x2*)(so + (size_t)r * 4096 + col));
      const float mean = red16(o[0] + o[1] + o[2] + o[3]) * (1.f / 64.f);
      f32x4 d = o - mean;
      const float var = red16(d[0] * d[0] + d[1] * d[1] + d[2] * d[2] + d[3] * d[3]) * (1.f / 64.f);
      f32x4 on = d * rsqrtf(var + 64e-5f) * *(const f32x4*)(gnw + col) + *(const f32x4*)(gnb + col);
      on += bonus[r * 16 + (col >> 6)] * cvt4(*(const u32x2*)(pv + (size_t)r * 1024 + col));
      on *= cvt4(*(const u32x2*)(rwg + (size_t)r * 1024 + col));
      *(u32x2*)(y + (size_t)r * 4096 + col) = pack4(on[0], on[1], on[2], on[3]);
    } else if (s < 8) {
      const int c = (s - 4) * 256 + lane * 4;
      f32x4 o = cvt4(*(const u32x2*)(so + (size_t)r * 4096 + 1024 + c));
      float ss = red16(o[0] * o[0] + o[1] * o[1] + o[2] * o[2] + o[3] * o[3]);
      ss += __shfl_xor(ss, 16);
      const float rstd = rsqrtf(ss * (1.f / 128.f) + 1e-5f);
      f32x4 on = o * rstd * *(const f32x4*)(hgn + c) * cvt4(*(const u32x2*)(hg + (size_t)r * 1024 + c));
      *(u32x2*)(y + (size_t)r * 4096 + 1024 + c) = pack4(on[0], on[1], on[2], on[3]);
    } else {
      const int g = s - 8, ch = g * 512 + lane * 8;
      const u32x4 orw = *(const u32x4*)(so + (size_t)r * 4096 + 2048 + ch);
      u32x2 oa; oa.x = orw.x; oa.y = orw.y; u32x2 ob; ob.x = orw.z; ob.y = orw.w;
      f32x4 o0 = cvt4(oa), o1 = cvt4(ob);
      u32x4 xr = *(const u32x4*)(sx2 + (size_t)r * 3072 + ch), zr = *(const u32x4*)(sz + (size_t)r * 2048 + ch);
      u32x2 t0; t0.x = xr.x; t0.y = xr.y; u32x2 t1; t1.x = xr.z; t1.y = xr.w;
      u32x2 z0; z0.x = zr.x; z0.y = zr.y; u32x2 z1; z1.x = zr.z; z1.y = zr.w;
      const float dk = dsk[ch >> 6];
      f32x4 y0 = (o0 + dk * cvt4(t0)) * cvt4(z0), y1 = (o1 + dk * cvt4(t1)) * cvt4(z1);
      float ss = y0[0] * y0[0] + y0[1] * y0[1] + y0[2] * y0[2] + y0[3] * y0[3] + y1[0] * y1[0] + y1[1] * y1[1] + y1[2] * y1[2] + y1[3] * y1[3];
      ss = red16(ss); ss += __shfl_xor(ss, 16); ss += __shfl_xor(ss, 32);
      const float rstd = rsqrtf(ss * (1.f / 512.f) + 1e-5f);
      y0 = y0 * rstd * *(const f32x4*)(sgn + ch); y1 = y1 * rstd * *(const f32x4*)(sgn + ch + 4);
      u32x4 ov; ov.x = pk2(y0[0], y0[1]); ov.y = pk2(y0[2], y0[3]); ov.z = pk2(y1[0], y1[1]); ov.w = pk2(y1[2], y1[3]);
      *(u32x4*)(y + (size_t)r * 4096 + 2048 + ch) = ov;
    }
  }
}

#define MT_ROW(row) ((size_t)(((row) >> 9) * 515 + 3 + ((row) & 511)) * 1536)
template <int BR>
__device__ __forceinline__ void merge_tile(PP p, int layer, int seg, int t, char* smem) {
  const u16* W = (const u16*)(p->ws + O_W) + WBR;
  const u16* Y = (const u16*)(p->ws + O_Y); const u16* gp = (const u16*)(p->ws + ((seg & 1) ? O_GATES2 : O_GATES)) + BR * 1024; u16* mg = (u16*)(p->ws + O_MERGED);
  float* mt = (float*)(p->ws + O_SXBC);
  constexpr int k0 = BR * 1024, nkt = BR == 2 ? 64 : 32;
  const int m0 = (t & 31) * 128, n0 = (t >> 5) * 128;
  f32x4 acc[4][4]; ACC_ZERO(acc);
  gemm_kloop(Y + (size_t)m0 * 4096 + k0, 4096, W + (size_t)n0 * 4096 + k0, 4096, nkt, acc, smem);
  EPI_LOOP2({ l0[j] = cvt4(*(const u32x2*)(gp + (size_t)row * 3072 + col)); if (BR > 0) l1[j] = *(const f32x4*)(mt + MT_ROW(row) + col); else l1[j] = f4z(); },
            { const f32x4 gsum = l1[j] + l0[j] * v; if (BR < 2) *(f32x4*)(mt + MT_ROW(row) + col) = gsum; else *(u32x2*)(mg + (size_t)row * 1024 + col) = pack4v(gsum); })
}
__device__ __forceinline__ void merge_item(PP p, int layer, int seg, int t, char* smem) {
  merge_tile<0>(p, layer, seg, t, smem);
  merge_tile<1>(p, layer, seg, t, smem);
  merge_tile<2>(p, layer, seg, t, smem);
}
__device__ __forceinline__ void ph_merge(PP p, int layer, int seg, int bid, int nb, char* smem) {
#pragma unroll 1
  for (int t = bid; t < 256; t += nb) merge_item(p, layer, seg, t, smem);
}
__device__ __forceinline__ void ph_out(PP p, int layer, int seg, int bid, int nb, char* smem) {
  const u16* W = (const u16*)(p->ws + O_W) + WOUT;
  const u16* mg = (const u16*)(p->ws + O_MERGED);
  const float* xs = layer == 0 ? p->in[0] : p->out;
  for (int t = bid; t < 256; t += nb) {
    const int m0 = (t & 31) * 128, n0 = (t >> 5) * 128;
    f32x4 acc[4][4]; ACC_ZERO(acc);
    gemm_kloop(mg + (size_t)m0 * 1024, 1024, W + (size_t)n0 * 1024, 1024, 32, acc, smem);
    EPI_LOOP2({ size_t gr = (size_t)(row >> 9) * SEQ + seg * SL + (row & 511); l0[j] = *(const f32x4*)(xs + gr * 1024 + col); },
              { size_t gr = (size_t)(row >> 9) * SEQ + seg * SL + (row & 511); *(f32x4*)(p->out + gr * 1024 + col) = l0[j] + v; })
  }
}
__device__ __forceinline__ void ph_ffi(PP p, int layer, int bid, int nb, char* smem) {
  const u16* W = (const u16*)(p->ws + O_W) + WFFI;
  const u16* H2 = (const u16*)(p->ws + O_H2); u16* hid = (u16*)(p->ws + O_HID);
  for (int t = bid; t < 128 * 44; t += nb) {
    const int m0 = (t & 127) * 256, n0 = (t >> 7) * 128;
    f32x4 acc[8][4]; ACC_ZERO(acc);
    gemm_kloop(H2 + (size_t)m0 * 1024, 1024, W + (size_t)n0 * 1024, 1024, 32, acc, smem);
    const int lane = tidx() & 63, wave = tidx() >> 6, wm = wave >> 1, wn = wave & 1;
#pragma unroll
    for (int i = 0; i < 8; i++)
#pragma unroll
      for (int j = 0; j < 4; j += 2) {
        const int row = m0 + wm * 128 + i * 16 + (lane & 15);
        const int ng = n0 + wn * 64 + j * 16 + (lane >> 4) * 4;
        const int hc = (ng >> 5) * 16 + (ng & 15);
        const f32x4 g = acc[i][j], u = acc[i][j + 1];
        *(u32x2*)(hid + (size_t)row * 2816 + hc) = pack4v(g * sigm4(g) * u);
      }
  }
}
__device__ __forceinline__ void ph_ffo(PP p, int layer, int bid, int nb, char* smem) {
  const u16* W = (const u16*)(p->ws + O_W) + WFFO;
  const u16* hid = (const u16*)(p->ws + O_HID);
  for (int t = bid; t < 128 * 8; t += nb) {
    const int m0 = (t & 127) * 256, n0 = (t >> 7) * 128;
    f32x4 acc[8][4]; ACC_ZERO(acc);
    gemm_kloop(hid + (size_t)m0 * 2816, 2816, W + (size_t)n0 * 2816, 2816, 88, acc, smem);
    float* outp = p->out;
    EPI_LOOP2({ l0[j] = *(const f32x4*)(outp + (size_t)row * 1024 + col); }, { *(f32x4*)(outp + (size_t)row * 1024 + col) = l0[j] + v; })
  }
}

__device__ __forceinline__ void ph_norm1(PP p, int layer, int seg, int bid, int nb) {
  if (seg == 0) {
    u16* urw = (u16*)(p->ws + O_URW); u16* sxbc = (u16*)(p->ws + O_SXBC);
    const int gt = bid * NTHR + tidx(), gs = nb * NTHR;
    for (int idx = gt; idx < 8 * 3456; idx += gs) { int b = idx / 3456, c = idx - b * 3456; urw[(size_t)(b * 513) * 3456 + c] = 0; }
    for (int idx = gt; idx < 8 * 9216; idx += gs) { int b = idx / 9216, c = idx - b * 9216; sxbc[(size_t)(b * 515) * 3072 + c] = 0; }
  }
  rmsnorm_rows(layer == 0 ? p->in[0] : p->out, p->in[1] + layer * 1024, (u16*)(p->ws + O_H), nullptr, RS, 0, seg, bid, nb);
}

#define XB_TMO      128
#define XB_XCNT(j)  (256  + 64 * (j))
#define XB_XSUB(j)  (1280 + 64 * (j))
#define XB_XGEN(j)  (2304 + 64 * (j))
#define XB_TOP      3328
#define XB_TOPGEN   3392
#define XCD_BAR_WORDS 3456
#define XB_SPIN_CAP (1u << 22)
__device__ __forceinline__ unsigned xb_ld(unsigned* p)              { return __hip_atomic_load(p, __ATOMIC_RELAXED, __HIP_MEMORY_SCOPE_AGENT); }
__device__ __forceinline__ unsigned xb_add(unsigned* p, unsigned v) { return __hip_atomic_fetch_add(p, v, __ATOMIC_RELAXED, __HIP_MEMORY_SCOPE_AGENT); }
__device__ __forceinline__ unsigned xb_xcc_id() { return (unsigned)__builtin_amdgcn_s_getreg((3 << 11) | 20) & 0xFu; }
#define XB_SPIN(cond, bar) do { unsigned _sp = 0; while (cond) { __builtin_amdgcn_s_sleep(1); \
    if ((++_sp & 255u) == 0u) { if (xb_ld(&(bar)[XB_TMO])) break; if (_sp > XB_SPIN_CAP) { atomicAdd(&(bar)[XB_TMO], 1u); break; } } } } while (0)
struct XcdBarrier { unsigned* bar; unsigned x; volatile LAS unsigned* st; };
__device__ __forceinline__ XcdBarrier xcd_barrier_post(unsigned* bar, volatile LAS unsigned* st) {
  XcdBarrier b; b.bar = bar; b.x = xb_xcc_id(); b.st = st;
  if (threadIdx.x == 0) (void)xb_add(&bar[XB_XCNT(b.x)], 1u);
  return b;
}
__device__ __forceinline__ void xcd_barrier_complete(unsigned* bar, unsigned x, unsigned& nloc, unsigned& nx) {
  const unsigned G = gridDim.x * gridDim.y * gridDim.z;
  unsigned sum, cnt, mine, sp = 0u;
  for (;;) {
    sum = 0u; cnt = 0u; mine = 0u;
#pragma unroll
    for (unsigned j = 0; j < 16; ++j) { const unsigned c = xb_ld(&bar[XB_XCNT(j)]); sum += c; cnt += (c > 0u) ? 1u : 0u; mine = (j == x) ? c : mine; }
    if (sum == G) break;
    __builtin_amdgcn_s_sleep(1);
    if ((++sp & 255u) == 0u) { if (xb_ld(&bar[XB_TMO])) break; if (sp > XB_SPIN_CAP) { atomicAdd(&bar[XB_TMO], 1u); break; } }
  }
  nloc = mine > 0u ? mine : 1u; nx = cnt > 0u ? cnt : 1u;
}
__device__ __forceinline__ void xcd_barrier(const XcdBarrier& b) {
  asm volatile("s_waitcnt vmcnt(0)" ::: "memory");
  __syncthreads();
  if (threadIdx.x == 0) {
    unsigned* bar = b.bar;
    __builtin_amdgcn_s_waitcnt(0);
    unsigned nloc = b.st[0], nx = b.st[1];
    if (nloc == 0u) { xcd_barrier_complete(bar, b.x, nloc, nx); b.st[0] = nloc; b.st[1] = nx; }
    const unsigned old = xb_add(&bar[XB_XSUB(b.x)], 1u);
    const unsigned gen = old / nloc;
    if (old + 1u == (gen + 1u) * nloc) {
      __builtin_amdgcn_fence(__ATOMIC_RELEASE, "agent");
      asm volatile("s_waitcnt vmcnt(0)" ::: "memory");
      const unsigned og = xb_add(&bar[XB_TOP], 1u);
      const unsigned tg = og / nx;
      if (og + 1u == (tg + 1u) * nx) xb_add(&bar[XB_TOPGEN], 1u);
      else XB_SPIN(xb_ld(&bar[XB_TOPGEN]) == tg, bar);
      __builtin_amdgcn_fence(__ATOMIC_ACQUIRE, "agent");
      xb_add(&bar[XB_XGEN(b.x)], 1u);
      asm volatile("s_waitcnt vmcnt(0)" ::: "memory");
    } else {
      XB_SPIN(xb_ld(&bar[XB_XGEN(b.x)]) == gen, bar);
      __builtin_amdgcn_fence(__ATOMIC_ACQUIRE, "agent");
      asm volatile("s_waitcnt vmcnt(0)" ::: "memory");
    }
  }
  __syncthreads();
}

#define SMEM_BYTES 73728
#ifndef SCANPROBE
#define SCANPROBE 0
#endif
#ifndef PHMASK
#define PHMASK 0xFFFF
#endif
#ifndef DBLMASK
#define DBLMASK 0
#endif
#define RUN(idx, call) { if ((PHMASK >> (idx)) & 1) { if ((DBLMASK >> (idx)) & 1) { call; __syncthreads(); } call; } }
__global__ void __launch_bounds__(NTHR, 2) mega(Params p_) {
  __shared__ __attribute__((aligned(1024))) char smem[SMEM_BYTES + 16];
  uint4& xb_words = *(uint4*)(smem + SMEM_BYTES);
  cg::grid_group grid = cg::this_grid();
  if (threadIdx.x == 0) xb_words = make_uint4(0u, 0u, 0u, 0u);
  __syncthreads();
  XcdBarrier xb = xcd_barrier_post((unsigned*)(p_.ws + O_BAR), (volatile LAS unsigned*)&xb_words);
  {
    PP p = (PP)__builtin_amdgcn_kernarg_segment_ptr();
    RUN(0, ph_wconv(p, 0, blockIdx.x, gridDim.x, smem))
  }
  if (p_.out == nullptr) grid.sync();
  xcd_barrier(xb);
#pragma unroll 1
  for (int pc = 0; pc < 151; pc++) {
    PP p = (PP)__builtin_amdgcn_kernarg_segment_ptr();
    asm volatile("" : "+s"(p));
    int bid = blockIdx.x, nb = gridDim.x;
    asm volatile("" : "+s"(bid), "+s"(nb));
    const int l = pc / 75, q = pc - l * 75;
    bool did = true;
    if (pc == 150) {
      RUN(13, rmsnorm_rows(p->out, p->in[27], nullptr, p->out, TTOK, 2, 0, bid, nb))
      did = false;
    } else if (q >= 72) {
      if (q == 72) RUN(10, rmsnorm_rows(p->out, p->in[24] + l * 1024, (u16*)(p->ws + O_H2), nullptr, TTOK, 1, 0, bid, nb))
      else if (q == 73) RUN(11, ph_ffi(p, l, bid, nb, smem))
      else RUN(12, ph_ffo(p, l, bid, nb, smem))
    } else {
      const int sg = q / 9, st = q - sg * 9;
      switch (st) {
        case 0: if (sg == 0) { if (l > 0) RUN(0, ph_wconv(p, l, bid, nb, smem)) RUN(1, ph_norm1(p, l, 0, bid, nb)) } else did = false; break;
        case 1:
          if (bid * 2 < nb) { if (sg > 0) RUN(7, ph_post(p, l, sg - 1, bid, nb)) RUN(2, ph_inproj(p, l, sg, bid, nb, smem)) }
          else { RUN(2, ph_inproj(p, l, sg, bid, nb, smem)) if (sg > 0) RUN(7, ph_post(p, l, sg - 1, bid, nb)) }
          if (sg > 1) RUN(9, ph_out(p, l, sg - 2, bid, nb, smem))
          break;
        case 2: RUN(3, ph_elem(p, l, sg, bid, nb)) if (sg + 1 < NSEG) RUN(1, ph_norm1(p, l, sg + 1, bid, nb)) break;
        case 3: RUN(4, ph_lora(p, l, bid, nb, smem)) break;
        case 4: RUN(5, ph_rprep(p, l, bid, nb)) break;
        case 5: ph_scan(p, l, sg, bid, nb, smem, ((volatile LAS unsigned*)&xb_words) + 2); break;
        case 6: if (sg == NSEG - 1) { RUN(7, ph_post(p, l, sg, bid, nb)) RUN(9, ph_out(p, l, sg - 1, bid, nb, smem)) } else did = false; break;
        case 7: if (sg == NSEG - 1) RUN(8, ph_merge(p, l, sg, bid, nb, smem)) else did = false; break;
        default: if (sg == NSEG - 1) RUN(9, ph_out(p, l, sg, bid, nb, smem)) else did = false; break;
      }
    }
    if (did) xcd_barrier(xb);
  }
}

extern "C" void kernel_launch(void* const* d_in, const int* in_sizes, int n_in, void* d_out, int out_size, void* d_ws,
                              size_t ws_size, hipStream_t stream) {
  Params p{};
  for (int i = 0; i < 28; i++) p.in[i] = (const float*)d_in[i];
  p.out = (float*)d_out; p.ws = (char*)d_ws;
  static int grid_blocks = 0;
  if (!grid_blocks) {
    int dev = 0, cus = 0, per_cu = 0;
    hipGetDevice(&dev);
    hipDeviceGetAttribute(&cus, hipDeviceAttributeMultiprocessorCount, dev);
    hipOccupancyMaxActiveBlocksPerMultiprocessor(&per_cu, mega, NTHR, 0);
    if (per_cu > 2) per_cu = 2;
    if (per_cu < 1) per_cu = 1;
    grid_blocks = cus * per_cu;
  }
  hipMemsetAsync((char*)d_ws + O_BAR, 0, 16384, stream);
  void* args[] = {&p};
  hipError_t e = hipLaunchCooperativeKernel((void*)mega, dim3(grid_blocks), dim3(NTHR), args, 0, stream);
  if (e != hipSuccess) fprintf(stderr, "cooperative launch failed: %s (grid %d)\n", hipGetErrorString(e), grid_blocks);
}
```
